# Optimizing an MI355X kernel written in HIP

```python
import math
import jax, jax.numpy as jnp
from jax import lax
import numpy as np

D_MODEL = 1024
BATCH = 16
SEQ = 2048
DEPTH = 1

D_SSM = D_MODEL // 2
SSM_GROUP = 16
N_SSM_GROUPS = D_SSM // SSM_GROUP
SSM_STATE = 64
DT_MIN = 0.001
DT_MAX = 0.1
D_CONV = D_MODEL // 2
CONV_WIDTH = 31
N_BRANCH = 2
SPLITS = [D_SSM, D_SSM + D_CONV, D_SSM + 2 * D_CONV, D_SSM + 2 * D_CONV + D_MODEL]
D_IN = D_SSM + 2 * D_CONV + N_BRANCH * D_MODEL
N_GROUPS = 4
N_EXP_PER_GROUP = 8
N_EXPERTS = N_GROUPS * N_EXP_PER_GROUP
TOP_K_INNER = 2
D_FF_EXPERT = D_MODEL // 4
ROW_BLOCK = 128
LN_EPS = 1e-5
ALPHA = (2.0 * DEPTH) ** 0.25
BETA = (8.0 * DEPTH) ** -0.25

kernel_name = "hybrid_s5_conformer_hmoe_deepnorm"


def _layer_norm(x, g, b):
    xf = x.astype(jnp.float32)
    mu = jnp.mean(xf, axis=-1, keepdims=True)
    var = jnp.mean(jnp.square(xf - mu), axis=-1, keepdims=True)
    return ((xf - mu) * lax.rsqrt(var + LN_EPS)).astype(x.dtype) * g + b


def _s5_combine(e1, e2):
    a1r, a1i, b1r, b1i = e1
    a2r, a2i, b2r, b2i = e2
    return (a2r * a1r - a2i * a1i,
            a2r * a1i + a2i * a1r,
            a2r * b1r - a2i * b1i + b2r,
            a2r * b1i + a2i * b1r + b2i)


def _s5_mixer(u, lam_re, lam_im, log_dt, b_re, b_im, c_re, c_im, d_skip):
    bsz, seq, _ = u.shape
    f32 = jnp.float32
    lr, li = lam_re.astype(f32), lam_im.astype(f32)
    dt = jnp.exp(log_dt.astype(f32))[:, None]
    mag = jnp.exp(lr * dt)
    ar, ai = mag * jnp.cos(li * dt), mag * jnp.sin(li * dt)
    den = lr * lr + li * li
    fr = ((ar - 1.0) * lr + ai * li) / den
    fi = (ai * lr - (ar - 1.0) * li) / den
    br, bi = b_re.astype(f32), b_im.astype(f32)
    bbar_re = fr[..., None] * br - fi[..., None] * bi
    bbar_im = fr[..., None] * bi + fi[..., None] * br
    ug = u.astype(f32).reshape(bsz, seq, N_SSM_GROUPS, SSM_GROUP)
    bu_re = jnp.einsum('blgh,gph->blgp', ug, bbar_re)
    bu_im = jnp.einsum('blgh,gph->blgp', ug, bbar_im)
    a_shape = (1, seq, N_SSM_GROUPS, SSM_STATE)
    a_re = jnp.broadcast_to(ar[None, None], a_shape)
    a_im = jnp.broadcast_to(ai[None, None], a_shape)
    _, _, s_re, s_im = lax.associative_scan(_s5_combine, (a_re, a_im, bu_re, bu_im), axis=1)
    y = (jnp.einsum('blgp,ghp->blgh', s_re, c_re.astype(f32))
         - jnp.einsum('blgp,ghp->blgh', s_im, c_im.astype(f32)))
    y = y.reshape(bsz, seq, D_SSM).astype(u.dtype)
    return y + d_skip * u


def _conv_mixer(ca, cb, conv_w, conv_b, ln_g, ln_b, w_cout, b_cout):
    v = ca * jax.nn.sigmoid(cb)
    vp = jnp.pad(v, ((0, 0), (CONV_WIDTH - 1, 0), (0, 0)))
    c = lax.conv_general_dilated(vp, conv_w, window_strides=(1,), padding='VALID',
                                 dimension_numbers=('NWC', 'WIO', 'NWC'),
                                 feature_group_count=D_CONV) + conv_b
    c = jax.nn.silu(_layer_norm(c, ln_g, ln_b))
    return c @ w_cout + b_cout


def _hier_moe(h, w_rg, b_rg, w_re, b_re, w_gate, w_up, w_down):
    bsz, seq, d = h.shape
    xt = h.reshape(bsz * seq, d)
    n_tok = xt.shape[0]
    zg = (xt @ w_rg + b_rg).astype(jnp.float32)
    pg = jax.nn.softmax(zg, axis=-1)
    _, gsel = lax.top_k(zg, 1)
    p_group = jnp.take_along_axis(pg, gsel, axis=-1)
    ze = (xt @ w_re + b_re).astype(jnp.float32).reshape(n_tok, N_GROUPS, N_EXP_PER_GROUP)
    ze = jnp.take_along_axis(ze, gsel[:, :, None], axis=1)[:, 0]
    top_v, top_i = lax.top_k(ze, TOP_K_INNER)
    gate = (p_group * jax.nn.softmax(top_v, axis=-1)).astype(h.dtype)
    eid = (gsel * N_EXP_PER_GROUP + top_i).reshape(-1)
    wts = gate.reshape(-1)
    tok = jnp.repeat(jnp.arange(n_tok, dtype=jnp.int32), TOP_K_INNER)
    n_assign = n_tok * TOP_K_INNER
    order = jnp.argsort(eid)
    s_eid, s_tok, s_w = eid[order], tok[order], wts[order]
    counts = jnp.bincount(eid, length=N_EXPERTS)
    start = jnp.cumsum(counts) - counts
    pcounts = (counts + ROW_BLOCK - 1) // ROW_BLOCK * ROW_BLOCK
    pend = jnp.cumsum(pcounts)
    dest = (pend - pcounts)[s_eid] + jnp.arange(n_assign, dtype=jnp.int32) - start[s_eid]
    n_blocks = -(-n_assign // ROW_BLOCK) + N_EXPERTS
    n_rows = n_blocks * ROW_BLOCK
    tok_buf = jnp.zeros((n_rows,), jnp.int32).at[dest].set(s_tok)
    w_buf = jnp.zeros((n_rows,), h.dtype).at[dest].set(s_w)
    blk_start = jnp.arange(n_blocks, dtype=jnp.int32) * ROW_BLOCK
    blk_eid = jnp.minimum(jnp.sum(blk_start[:, None] >= pend[None, :], axis=1), N_EXPERTS - 1)

    def expert_block(args):
        idx, e = args
        xb = xt[idx]
        hid = jax.nn.silu(xb @ w_gate[e]) * (xb @ w_up[e])
        return hid @ w_down[e]

    y_buf = lax.map(expert_block, (tok_buf.reshape(n_blocks, ROW_BLOCK), blk_eid))
    y = jax.ops.segment_sum(y_buf.reshape(n_rows, d) * w_buf[:, None], tok_buf, num_segments=n_tok)
    return y.reshape(bsz, seq, d)


def _layer(x, w_in, b_in, lam_re, lam_im, log_dt, ssm_b_re, ssm_b_im, ssm_c_re, ssm_c_im,
           ssm_d, w_glu, b_glu, conv_w, conv_b, ln_c_g, ln_c_b, w_cout, b_cout, w_out, b_out,
           ln1_g, ln1_b, w_route_group, b_route_group, w_route_expert, b_route_expert,
           w_gate, w_up, w_down, ln2_g, ln2_b):
    proj = x @ w_in + b_in
    u, ca, cb, gs, gc = jnp.split(proj, SPLITS, axis=-1)
    y = jax.nn.gelu(_s5_mixer(u, lam_re, lam_im, log_dt, ssm_b_re, ssm_b_im,
                              ssm_c_re, ssm_c_im, ssm_d))
    glu = y @ w_glu + b_glu
    s_out = glu[..., :D_MODEL] * jax.nn.sigmoid(glu[..., D_MODEL:])
    c_out = _conv_mixer(ca, cb, conv_w, conv_b, ln_c_g, ln_c_b, w_cout, b_cout)
    merged = jax.nn.sigmoid(gs) * s_out + jax.nn.sigmoid(gc) * c_out
    mix = merged @ w_out + b_out
    h = _layer_norm(ALPHA * x + mix, ln1_g, ln1_b)
    moe = _hier_moe(h, w_route_group, b_route_group, w_route_expert, b_route_expert,
                    w_gate, w_up, w_down)
    return _layer_norm(ALPHA * h + moe, ln2_g, ln2_b)


def _nrm(k, shape, scale):
    return scale * jax.random.normal(k, shape, jnp.float32)


def setup_inputs(seed: int = 0) -> dict:
    key = jax.random.key(seed)
    ks = jax.random.split(key, 32)
    L = DEPTH
    G, P, H = N_SSM_GROUPS, SSM_STATE, SSM_GROUP
    lam_im = jnp.pi * jnp.arange(P, dtype=jnp.float32)
    return {
        'x': _nrm(ks[0], (BATCH, SEQ, D_MODEL), 1.0),
        'w_in': _nrm(ks[1], (L, D_MODEL, D_IN), D_MODEL ** -0.5),
        'b_in': _nrm(ks[2], (L, D_IN), 0.01),
        'lam_re': -0.5 + _nrm(ks[3], (L, G, P), 0.01),
        'lam_im': lam_im + _nrm(ks[4], (L, G, P), 0.01),
        'log_dt': jax.random.uniform(ks[5], (L, G), jnp.float32, math.log(DT_MIN), math.log(DT_MAX)),
        'ssm_b_re': _nrm(ks[6], (L, G, P, H), (2.0 * H) ** -0.5),
        'ssm_b_im': _nrm(ks[7], (L, G, P, H), (2.0 * H) ** -0.5),
        'ssm_c_re': _nrm(ks[8], (L, G, H, P), (2.0 * P) ** -0.5),
        'ssm_c_im': _nrm(ks[9], (L, G, H, P), (2.0 * P) ** -0.5),
        'ssm_d': _nrm(ks[10], (L, D_SSM), 1.0),
        'w_glu': _nrm(ks[11], (L, D_SSM, 2 * D_MODEL), D_SSM ** -0.5),
        'b_glu': _nrm(ks[12], (L, 2 * D_MODEL), 0.01),
        'conv_w': _nrm(ks[13], (L, CONV_WIDTH, 1, D_CONV), CONV_WIDTH ** -0.5),
        'conv_b': _nrm(ks[14], (L, D_CONV), 0.01),
        'ln_c_g': 1.0 + _nrm(ks[15], (L, D_CONV), 0.01),
        'ln_c_b': _nrm(ks[16], (L, D_CONV), 0.01),
        'w_cout': _nrm(ks[17], (L, D_CONV, D_MODEL), D_CONV ** -0.5),
        'b_cout': _nrm(ks[18], (L, D_MODEL), 0.01),
        'w_out': _nrm(ks[19], (L, D_MODEL, D_MODEL), BETA * D_MODEL ** -0.5),
        'b_out': _nrm(ks[20], (L, D_MODEL), 0.01),
        'ln1_g': 1.0 + _nrm(ks[21], (L, D_MODEL), 0.01),
        'ln1_b': _nrm(ks[22], (L, D_MODEL), 0.01),
        'w_route_group': _nrm(ks[23], (L, D_MODEL, N_GROUPS), D_MODEL ** -0.5),
        'b_route_group': _nrm(ks[24], (L, N_GROUPS), 0.01),
        'w_route_expert': _nrm(ks[25], (L, D_MODEL, N_EXPERTS), D_MODEL ** -0.5),
        'b_route_expert': _nrm(ks[26], (L, N_EXPERTS), 0.01),
        'w_gate': _nrm(ks[27], (L, N_EXPERTS, D_MODEL, D_FF_EXPERT), D_MODEL ** -0.5),
        'w_up': _nrm(ks[28], (L, N_EXPERTS, D_MODEL, D_FF_EXPERT), D_MODEL ** -0.5),
        'w_down': _nrm(ks[29], (L, N_EXPERTS, D_FF_EXPERT, D_MODEL), BETA * D_FF_EXPERT ** -0.5),
        'ln2_g': 1.0 + _nrm(ks[30], (L, D_MODEL), 0.01),
        'ln2_b': _nrm(ks[31], (L, D_MODEL), 0.01),
    }


def reference(x, w_in, b_in, lam_re, lam_im, log_dt, ssm_b_re, ssm_b_im, ssm_c_re, ssm_c_im,
              ssm_d, w_glu, b_glu, conv_w, conv_b, ln_c_g, ln_c_b, w_cout, b_cout, w_out, b_out,
              ln1_g, ln1_b, w_route_group, b_route_group, w_route_expert, b_route_expert,
              w_gate, w_up, w_down, ln2_g, ln2_b):
    params = (w_in, b_in, lam_re, lam_im, log_dt, ssm_b_re, ssm_b_im, ssm_c_re, ssm_c_im,
              ssm_d, w_glu, b_glu, conv_w, conv_b, ln_c_g, ln_c_b, w_cout, b_cout, w_out, b_out,
              ln1_g, ln1_b, w_route_group, b_route_group, w_route_expert, b_route_expert,
              w_gate, w_up, w_down, ln2_g, ln2_b)
    h = x
    for i in range(DEPTH):
        h = _layer(h, *[p[i] for p in params])
    return h
```

```cpp
#include <hip/hip_runtime.h>
#include <hip/hip_cooperative_groups.h>
#include <cstdio>
#include <cstdint>
namespace cg = cooperative_groups;

#ifndef ONE_LAUNCH
#define ONE_LAUNCH 1
#endif

typedef unsigned short bf16;
typedef short bf16x8 __attribute__((ext_vector_type(8)));
typedef float f32x4 __attribute__((ext_vector_type(4)));
typedef float f32x16 __attribute__((ext_vector_type(16)));
typedef unsigned u32x2 __attribute__((ext_vector_type(2)));
typedef unsigned u32x4 __attribute__((ext_vector_type(4)));

constexpr int T = 32768, D = 1024, SEQ = 2048, NB = 16;
constexpr int DIN = 3584, DSSM = 512, NGRP = 32, NST = 64, NH = 16, DCONV = 512, CW = 31;
constexpr int NEXP = 32, DFF = 256;
constexpr float LN_EPS = 1e-5f;
constexpr float ALPHA = 1.189207115002721f;
constexpr int NPHASE = 12;
constexpr int NTHREADS = 512;
constexpr int LDS_BYTES = 131072 + 2048, LDS_MISC = 131072;
constexpr int CTL_BAR = 4096;
constexpr size_t CTL_ZERO_BYTES = 65536;

constexpr size_t MiB = 1u << 20;
constexpr size_t WS_CTL = 0;
constexpr size_t WS_TAB = 1 * MiB;
constexpr size_t TAB_BINP = 0, TAB_BGLUP = 16384, TAB_A = 32768, TAB_BB = 65536, TAB_CM = 65536 + 131072;
constexpr size_t WS_WIN = 2 * MiB, WS_WGLU = 9 * MiB, WS_WCOUT = 11 * MiB, WS_WOUT = 12 * MiB, WS_WR = 14 * MiB;
constexpr size_t WS_WGU = 16 * MiB, WS_WD = 48 * MiB;
constexpr size_t WS_M1 = 64 * MiB, WS_PREB = 256 * MiB;
constexpr size_t WS_XB = 64 * MiB, WS_U = 128 * MiB, WS_V = 160 * MiB, WS_YM = 64 * MiB;
constexpr size_t WS_SGS = 192 * MiB, WS_HB = 192 * MiB, WS_SGC = 256 * MiB;
constexpr size_t WS_YG = 320 * MiB, WS_CV = 352 * MiB, WS_MERGED = 384 * MiB;
constexpr size_t WS_HID = 448 * MiB, WS_Z = 488 * MiB, WS_TOK = 496 * MiB, WS_GATE = 500 * MiB, WS_END = 501 * MiB;

struct Params {
    const float* in[32];
    float* out;
    unsigned char* ws;
    int ph_lo, ph_hi;
};

typedef float f32x2_t __attribute__((ext_vector_type(2)));
typedef _Float16 h2_t __attribute__((ext_vector_type(2)));
typedef _Float16 h8_t __attribute__((ext_vector_type(8)));
__device__ __forceinline__ unsigned pk2(float lo, float hi) { const f32x2_t v = {lo, hi}; const h2_t h = __builtin_convertvector(v, h2_t); return __builtin_bit_cast(unsigned, h); }
__device__ __forceinline__ unsigned f2bf(float f) { return pk2(f, 0.f) & 0xffffu; }
__device__ __forceinline__ float bflo(unsigned w) { return (float)__builtin_bit_cast(h2_t, w).x; }
__device__ __forceinline__ float bfhi(unsigned w) { return (float)__builtin_bit_cast(h2_t, w).y; }
__device__ __forceinline__ float bf2f(bf16 b) { return (float)__builtin_bit_cast(_Float16, b); }
__device__ __forceinline__ f32x4 mfma16_h(bf16x8 a, bf16x8 b, f32x4 c, int, int, int) { return __builtin_amdgcn_mfma_f32_16x16x32_f16(__builtin_bit_cast(h8_t, a), __builtin_bit_cast(h8_t, b), c, 0, 0, 0); }
__device__ __forceinline__ f32x16 mfma32_h(bf16x8 a, bf16x8 b, f32x16 c, int, int, int) { return __builtin_amdgcn_mfma_f32_32x32x16_f16(__builtin_bit_cast(h8_t, a), __builtin_bit_cast(h8_t, b), c, 0, 0, 0); }
__device__ __forceinline__ float sigmoidf_(float z) { return __builtin_amdgcn_rcpf(1.0f + __expf(-z)); }
__device__ __forceinline__ float siluf_(float z) { return z * sigmoidf_(z); }
__device__ __forceinline__ float geluf_(float x) { const float z = 1.5957691216057308f * (x + 0.044715f * x * x * x); return x * sigmoidf_(z); }
__device__ __forceinline__ float wave_sum(float v) {
    v += __builtin_bit_cast(float, __builtin_amdgcn_update_dpp(0, __builtin_bit_cast(int, v), 0xB1, 0xF, 0xF, true));
    v += __builtin_bit_cast(float, __builtin_amdgcn_update_dpp(0, __builtin_bit_cast(int, v), 0x4E, 0xF, 0xF, true));
    v += __builtin_bit_cast(float, __builtin_amdgcn_update_dpp(0, __builtin_bit_cast(int, v), 0x141, 0xF, 0xF, true));
    v += __builtin_bit_cast(float, __builtin_amdgcn_update_dpp(0, __builtin_bit_cast(int, v), 0x140, 0xF, 0xF, true));
    const int iv = __builtin_bit_cast(int, v);
    const float r0 = __builtin_bit_cast(float, __builtin_amdgcn_readlane(iv, 0)), r1 = __builtin_bit_cast(float, __builtin_amdgcn_readlane(iv, 16));
    const float r2 = __builtin_bit_cast(float, __builtin_amdgcn_readlane(iv, 32)), r3 = __builtin_bit_cast(float, __builtin_amdgcn_readlane(iv, 48));
    return (r0 + r1) + (r2 + r3);
}
__device__ __forceinline__ void glds16(const void* g, void* l) {
    __builtin_amdgcn_global_load_lds((const __attribute__((address_space(1))) unsigned*)g, (__attribute__((address_space(3))) unsigned*)l, 16, 0, 0);
}

namespace pg8 {
#define PG8_LAS __attribute__((address_space(3)))
typedef unsigned short bf16_t;
typedef short bf16x8 __attribute__((ext_vector_type(8)));
typedef float f32x4 __attribute__((ext_vector_type(4)));
typedef unsigned u32x4 __attribute__((ext_vector_type(4)));
constexpr int BM = 256, BK = 64, HALF = 128, HTB = HALF * BK * 2  , STAGE_BYTES = 8 * HTB, NXCD = 8, WGM = 8;

__host__ __device__ __forceinline__ int lds_byte(int r, int c) { const int st = (r >> 4) * 2 + (c >> 5), rr = r & 15, cc = c & 31, ob = rr * 64 + cc * 2; return st * 1024 + (ob ^ (((ob >> 9) & 1) << 5)); }
__host__ __device__ __forceinline__ void stage_rc(int b, int& R, int& C) { const int st = b / 1024, sb = b % 1024, swz = sb ^ (((sb >> 9) & 1) << 5); R = (st >> 1) * 16 + swz / 64; C = (st & 1) * 32 + (swz % 64) / 2; }
__host__ __device__ __forceinline__ int perm32(int rho) { const int n = rho >> 4, i = rho & 15; return 8 * (i >> 2) + 4 * n + (i & 3); }

struct Unit { int pm, pn; };
struct Gemm { const bf16_t* A; const bf16_t* Bt; int M, N, K; };

struct StaticOrder {
    int nM, nN, nwg, G, c;
    __host__ __device__ void init(int M, int N, int G_, int c_) { nM = M / BM; nN = N / BM; nwg = nM * nN; G = G_; c = c_; }
    __host__ __device__ bool next(int i, Unit& u) const {
        const long L = (long)i * G + c; if (L >= nwg) return false;
        int wgid = (int)L; { const int q = nwg / NXCD, r = nwg % NXCD, xcd = wgid % NXCD, off = wgid / NXCD; wgid = (xcd < r ? xcd * (q + 1) : r * (q + 1) + (xcd - r) * q) + off; }
        const int nig = WGM * nN, gid = wgid / nig, fm = gid * WGM, gsz = (nM - fm) < WGM ? (nM - fm) : WGM;
        u.pm = fm + ((wgid % nig) % gsz); u.pn = (wgid % nig) / gsz; return true;
    }
    __device__ __forceinline__ void a_ready(const Unit&) const {}
    __device__ __forceinline__ void done(const Unit&) const {}
};

__device__ __forceinline__ unsigned pk2_(float lo, float hi) { return ::pk2(lo, hi); }
__device__ __forceinline__ float sg_(float z) { return __builtin_amdgcn_rcpf(1.0f + __expf(-z)); }
__device__ __forceinline__ float lo_(unsigned w) { return ::bflo(w); }
__device__ __forceinline__ float hi_(unsigned w) { return ::bfhi(w); }
typedef unsigned u32x2 __attribute__((ext_vector_type(2)));
struct EpiProj {
    static constexpr bool PERM = true, AFTER_DRAIN = false;
    const float* binp; bf16_t* U; bf16_t* V; bf16_t* SGS; bf16_t* SGC;
    __device__ __forceinline__ void operator()(const f32x4 (&acc)[2][2][4][2], const Unit& u, int wr, int wc, int fr, int fq) const {
        const int row0 = u.pm * BM + wr * 64 + fr, colt = u.pn * BM, c0 = colt + wc * 32 + 8 * fq;
        f32x4 bv[2][2];
#pragma unroll
        for (int bj = 0; bj < 2; ++bj)
#pragma unroll
            for (int n = 0; n < 2; ++n) bv[bj][n] = *(const f32x4*)(binp + c0 + bj * HALF + 4 * n);
#pragma unroll
        for (int ai = 0; ai < 2; ++ai)
#pragma unroll
            for (int m = 0; m < 4; ++m) {
                const size_t row = (size_t)(row0 + ai * HALF + m * 16);
#pragma unroll
                for (int bj = 0; bj < 2; ++bj) {
                    const int c8 = c0 + bj * HALF;
                    const f32x4 v0 = acc[ai][bj][m][0] + bv[bj][0], v1 = acc[ai][bj][m][1] + bv[bj][1];
                    if (colt < 512) {
                        u32x4 w; w.x = pk2_(v0.x, v0.y); w.y = pk2_(v0.z, v0.w); w.z = pk2_(v1.x, v1.y); w.w = pk2_(v1.z, v1.w);
                        *(u32x4*)(U + row * 512 + c8) = w;
                    } else if (colt < 1536) {
                        if (bj == 0) {
                            const f32x4 g0 = acc[ai][1][m][0] + bv[1][0], g1 = acc[ai][1][m][1] + bv[1][1];
                            u32x4 w; w.x = pk2_(v0.x * sg_(g0.x), v0.y * sg_(g0.y)); w.y = pk2_(v0.z * sg_(g0.z), v0.w * sg_(g0.w));
                            w.z = pk2_(v1.x * sg_(g1.x), v1.y * sg_(g1.y)); w.w = pk2_(v1.z * sg_(g1.z), v1.w * sg_(g1.w));
                            *(u32x4*)(V + row * 512 + ((colt - 512) >> 1) + wc * 32 + 8 * fq) = w;
                        }
                    } else {
                        u32x4 w; w.x = pk2_(sg_(v0.x), sg_(v0.y)); w.y = pk2_(sg_(v0.z), sg_(v0.w)); w.z = pk2_(sg_(v1.x), sg_(v1.y)); w.w = pk2_(sg_(v1.z), sg_(v1.w));
                        if (colt < 2560) *(u32x4*)(SGS + row * 1024 + (c8 - 1536)) = w; else *(u32x4*)(SGC + row * 1024 + (c8 - 2560)) = w;
                    }
                }
            }
    }
};
struct EpiCout {
    static constexpr bool PERM = true, AFTER_DRAIN = false;
    const float* bias; const bf16_t* SGC; bf16_t* M1;
    __device__ __forceinline__ void operator()(const f32x4 (&acc)[2][2][4][2], const Unit& u, int wr, int wc, int fr, int fq) const {
        const int row0 = u.pm * BM + wr * 64 + fr, c0 = u.pn * BM + wc * 32 + 8 * fq;
        f32x4 bv[2][2];
#pragma unroll
        for (int bj = 0; bj < 2; ++bj)
#pragma unroll
            for (int n = 0; n < 2; ++n) bv[bj][n] = *(const f32x4*)(bias + c0 + bj * HALF + 4 * n);
#pragma unroll
        for (int ai = 0; ai < 2; ++ai)
#pragma unroll
            for (int m = 0; m < 4; ++m) {
                const size_t row = (size_t)(row0 + ai * HALF + m * 16);
#pragma unroll
                for (int bj = 0; bj < 2; ++bj) {
                    const int c8 = c0 + bj * HALF;
                    const f32x4 v0 = acc[ai][bj][m][0] + bv[bj][0], v1 = acc[ai][bj][m][1] + bv[bj][1];
                    const u32x4 g = *(const u32x4*)(SGC + row * 1024 + c8);
                    u32x4 w; w.x = pk2_(v0.x * lo_(g.x), v0.y * hi_(g.x)); w.y = pk2_(v0.z * lo_(g.y), v0.w * hi_(g.y));
                    w.z = pk2_(v1.x * lo_(g.z), v1.y * hi_(g.z)); w.w = pk2_(v1.z * lo_(g.w), v1.w * hi_(g.w));
                    *(u32x4*)(M1 + row * 1024 + c8) = w;
                }
            }
    }
};
struct EpiGlu {
    static constexpr bool PERM = true, AFTER_DRAIN = false;
    const float* bglup; const bf16_t* SGS; const bf16_t* M1; bf16_t* MERGED;
    __device__ __forceinline__ void operator()(const f32x4 (&acc)[2][2][4][2], const Unit& u, int wr, int wc, int fr, int fq) const {
        const int row0 = u.pm * BM + wr * 64 + fr, c0 = u.pn * BM + wc * 32 + 8 * fq, mc = u.pn * HALF + wc * 32 + 8 * fq;
        f32x4 bv[2][2];
#pragma unroll
        for (int bj = 0; bj < 2; ++bj)
#pragma unroll
            for (int n = 0; n < 2; ++n) bv[bj][n] = *(const f32x4*)(bglup + c0 + bj * HALF + 4 * n);
#pragma unroll
        for (int ai = 0; ai < 2; ++ai)
#pragma unroll
            for (int m = 0; m < 4; ++m) {
                const size_t off = (size_t)(row0 + ai * HALF + m * 16) * 1024 + mc;
                const f32x4 a0 = acc[ai][0][m][0] + bv[0][0], a1 = acc[ai][0][m][1] + bv[0][1];
                const f32x4 b0 = acc[ai][1][m][0] + bv[1][0], b1 = acc[ai][1][m][1] + bv[1][1];
                const u32x4 g = *(const u32x4*)(SGS + off);
                const u32x4 q = *(const u32x4*)(M1 + off);
                u32x4 w;
                w.x = pk2_(lo_(q.x) + lo_(g.x) * (a0.x * sg_(b0.x)), hi_(q.x) + hi_(g.x) * (a0.y * sg_(b0.y)));
                w.y = pk2_(lo_(q.y) + lo_(g.y) * (a0.z * sg_(b0.z)), hi_(q.y) + hi_(g.y) * (a0.w * sg_(b0.w)));
                w.z = pk2_(lo_(q.z) + lo_(g.z) * (a1.x * sg_(b1.x)), hi_(q.z) + hi_(g.z) * (a1.y * sg_(b1.y)));
                w.w = pk2_(lo_(q.w) + lo_(g.w) * (a1.z * sg_(b1.z)), hi_(q.w) + hi_(g.w) * (a1.w * sg_(b1.w)));
                *(u32x4*)(MERGED + off) = w;
            }
    }
};
struct TripleOrder {
    StaticOrder so;
    __device__ __forceinline__ bool next(int i, Unit& u) const {
        const int tr = i / 3, sub = i - tr * 3; Unit v;
        if (!so.next(tr, v)) return false;
        if (sub == 0) { u.pm = 128 + v.pm; u.pn = 8 + v.pn; } else { u.pm = v.pm; u.pn = 2 * v.pn + sub - 1; }
        return true;
    }
    __device__ __forceinline__ void a_ready(const Unit&) const {}
    __device__ __forceinline__ void done(const Unit&) const {}
};
struct EpiCG {
    static constexpr bool PERM = true, AFTER_DRAIN = false;
    EpiCout c; EpiGlu g;
    __device__ __forceinline__ void operator()(const f32x4 (&acc)[2][2][4][2], const Unit& u, int wr, int wc, int fr, int fq) const {
        if (u.pm >= 128) { const Unit v{u.pm - 128, u.pn - 8}; c(acc, v, wr, wc, fr, fq); }
        else g(acc, u, wr, wc, fr, fq);
    }
};
struct EpiOut {
    static constexpr bool PERM = true, AFTER_DRAIN = false;
    const float* bias; const float* X; bf16_t* PREB; float alpha;
    __device__ __forceinline__ void operator()(const f32x4 (&acc)[2][2][4][2], const Unit& u, int wr, int wc, int fr, int fq) const {
        const int row0 = u.pm * BM + wr * 64 + fr, c0 = u.pn * BM + wc * 32 + 8 * fq;
        f32x4 bv[2][2];
#pragma unroll
        for (int bj = 0; bj < 2; ++bj)
#pragma unroll
            for (int n = 0; n < 2; ++n) bv[bj][n] = *(const f32x4*)(bias + c0 + bj * HALF + 4 * n);
#pragma unroll
        for (int ai = 0; ai < 2; ++ai)
#pragma unroll
            for (int m = 0; m < 4; ++m) {
                const size_t off = (size_t)(row0 + ai * HALF + m * 16) * 1024 + c0;
#pragma unroll
                for (int bj = 0; bj < 2; ++bj) {
                    const f32x4 x0 = *(const f32x4*)(X + off + bj * HALF), x1 = *(const f32x4*)(X + off + bj * HALF + 4);
                    const f32x4 v0 = acc[ai][bj][m][0] + bv[bj][0] + x0 * alpha, v1 = acc[ai][bj][m][1] + bv[bj][1] + x1 * alpha;
                    u32x4 w; w.x = pk2_(v0.x, v0.y); w.y = pk2_(v0.z, v0.w); w.z = pk2_(v1.x, v1.y); w.w = pk2_(v1.z, v1.w);
                    *(u32x4*)(PREB + off + bj * HALF) = w;
                }
            }
    }
};

struct MoeOrder {
    const PG8_LAS int* tab; int G, c, sh;
    __device__ __forceinline__ bool next(int i, Unit& u) const {
        const int L = i * G + c;
        if (L >= __builtin_amdgcn_readfirstlane(tab[32])) return false;
        int e = 0;
#pragma unroll 1
        while (L >= __builtin_amdgcn_readfirstlane(tab[e + 1])) ++e;
        const int ll = L - __builtin_amdgcn_readfirstlane(tab[e]);
        u.pm = __builtin_amdgcn_readfirstlane(tab[64 + e]) + (ll >> sh); u.pn = (e << sh) + (ll & ((1 << sh) - 1)); return true;
    }
    __device__ __forceinline__ void a_ready(const Unit&) const {}
    __device__ __forceinline__ void done(const Unit&) const {}
};
struct EpiDownP {
    static constexpr bool PERM = true, AFTER_DRAIN = false;
    const PG8_LAS int* tab; const int* TOK; const float* GATE; bf16_t* YM; bf16_t* dump; int Ttok;
    __device__ __forceinline__ void operator()(const f32x4 (&acc)[2][2][4][2], const Unit& u, int wr, int wc, int fr, int fq) const {
        const int e = u.pn >> 2, j = u.pn & 3;
        const int cnt = __builtin_amdgcn_readfirstlane(tab[128 + e]), idx0 = (u.pm - __builtin_amdgcn_readfirstlane(tab[64 + e])) * BM + wr * 64 + fr;
        const int* tl = TOK + (size_t)e * Ttok;
        const int c0 = j * BM + wc * 32 + 8 * fq;
#pragma unroll
        for (int ai = 0; ai < 2; ++ai)
#pragma unroll
            for (int m = 0; m < 4; ++m) {
                const int idx = idx0 + ai * HALF + m * 16;
                const bool ok = idx < cnt;
                const int ent = tl[ok ? idx : 0];
                const float g = GATE[ent];
                bf16_t* const dst = (ok ? YM + (size_t)ent * 1024 : dump) + c0;
#pragma unroll
                for (int bj = 0; bj < 2; ++bj) {
                    const f32x4 v0 = acc[ai][bj][m][0] * g, v1 = acc[ai][bj][m][1] * g;
                    u32x4 w; w.x = pk2_(v0.x, v0.y); w.y = pk2_(v0.z, v0.w); w.z = pk2_(v1.x, v1.y); w.w = pk2_(v1.z, v1.w);
                    *(u32x4*)(dst + bj * HALF) = w;
                }
                asm volatile("" ::: "memory");
            }
    }
};

struct MoeRows {
    const PG8_LAS int* tab; const int* TOK; int Ttok; unsigned rowbytes;
    __device__ __forceinline__ unsigned rowoff(const Unit& u, int h, int R) const {
        const int e = u.pn >> 1;
        const int idx = (u.pm - __builtin_amdgcn_readfirstlane(tab[64 + e])) * BM + h * HALF + R;
        const int tok = idx < __builtin_amdgcn_readfirstlane(tab[128 + e]) ? (TOK[(size_t)e * Ttok + idx] >> 1) : 0;
        return (unsigned)tok * rowbytes;
    }
};
struct EpiGUP {
    static constexpr bool PERM = true, AFTER_DRAIN = false;
    bf16_t* HID;
    __device__ __forceinline__ void operator()(const f32x4 (&acc)[2][2][4][2], const Unit& u, int wr, int wc, int fr, int fq) const {
        const int row0 = u.pm * BM + wr * 64 + fr, hc = (u.pn & 1) * HALF + wc * 32 + 8 * fq;
#pragma unroll
        for (int ai = 0; ai < 2; ++ai)
#pragma unroll
            for (int m = 0; m < 4; ++m) {
                const size_t row = (size_t)(row0 + ai * HALF + m * 16);
                const f32x4 g0 = acc[ai][0][m][0], g1 = acc[ai][0][m][1], u0 = acc[ai][1][m][0], u1 = acc[ai][1][m][1];
                u32x4 w; w.x = pk2_(g0.x * sg_(g0.x) * u0.x, g0.y * sg_(g0.y) * u0.y); w.y = pk2_(g0.z * sg_(g0.z) * u0.z, g0.w * sg_(g0.w) * u0.w);
                w.z = pk2_(g1.x * sg_(g1.x) * u1.x, g1.y * sg_(g1.y) * u1.y); w.w = pk2_(g1.z * sg_(g1.z) * u1.z, g1.w * sg_(g1.w) * u1.w);
                *(u32x4*)(HID + row * 256 + hc) = w;
            }
    }
};

template <class Epi, class Sched, bool ALIGN_EPI = false, bool SP2 = false>
__device__ __forceinline__ void gemm_phase(PG8_LAS unsigned char* lds, const Gemm g, const Sched& S, const Epi& E) {
    int tid_ = threadIdx.x; asm volatile("" : "+v"(tid_));
    const int tid = tid_, wid = __builtin_amdgcn_readfirstlane(tid >> 6), lane = tid & 63, wr = wid >> 2, wc = wid & 3, fr = lane & 15, fq = lane >> 4;
    const int K = g.K, nt = K / BK;
    unsigned voffA[2], voffB[2];
#pragma unroll
    for (int i = 0; i < 2; ++i) { int R, C; stage_rc(tid * 16 + i * 8192, R, C); const int Rb = Epi::PERM ? ((R & ~31) + perm32(R & 31)) : R;
        voffA[i] = (unsigned)(R * K + C) * 2u; voffB[i] = (unsigned)(Rb * K + C) * 2u; }
    const size_t kstep = (size_t)(BK * 2);
    const size_t hstep = (size_t)HALF * K * 2;
    const size_t tstep = 2 * hstep;
    const unsigned ldsw = (unsigned)wid * 1024u;
    const int aoff = lds_byte(wr * 64 + fr, fq * 8), boff = lds_byte(wc * 32 + fr, fq * 8);
#define PG8_SA(b, h) (((b) * 2 + (h)) * HTB)
#define PG8_SB(b, h) ((4 + (b) * 2 + (h)) * HTB)
#define PG8_STAGE(bufoff, gbase, voff) do { _Pragma("unroll") for (int _i = 0; _i < 2; ++_i) \
        __builtin_amdgcn_global_load_lds((const unsigned*)((const char*)(gbase) + (voff)[_i]), (PG8_LAS unsigned*)(lds + (bufoff) + ldsw + _i * 8192), 16, 0, 0); } while (0)
#define PG8_LDA(dst, b, h) do { _Pragma("unroll") for (int m = 0; m < 4; ++m) _Pragma("unroll") for (int k = 0; k < 2; ++k) dst[m][k] = *(const PG8_LAS bf16x8*)(lds + PG8_SA(b, h) + aoff + m * 2048 + k * 1024); } while (0)
#define PG8_LDB(dst, b, h) do { _Pragma("unroll") for (int n = 0; n < 2; ++n) _Pragma("unroll") for (int k = 0; k < 2; ++k) dst[n][k] = *(const PG8_LAS bf16x8*)(lds + PG8_SB(b, h) + boff + n * 2048 + k * 1024); } while (0)
#define PG8_MMA(ai, bj, At, Bt) do { __builtin_amdgcn_s_setprio(1); _Pragma("unroll") for (int m = 0; m < 4; ++m) _Pragma("unroll") for (int n = 0; n < 2; ++n) _Pragma("unroll") for (int k = 0; k < 2; ++k) \
        acc[ai][bj][m][n] = mfma16_h(Bt[n][k], At[m][k], acc[ai][bj][m][n], 0, 0, 0); __builtin_amdgcn_s_setprio(0); } while (0)
#define PG8_WAIT_V(n) asm volatile("s_waitcnt vmcnt(" #n ")" ::: "memory")
#define PG8_WAIT_L(n) asm volatile("s_waitcnt lgkmcnt(" #n ")" ::: "memory")
#define PG8_BAR __builtin_amdgcn_s_barrier()
#define PG8_SCHED __builtin_amdgcn_sched_barrier(0)
    Unit cur, nxt; int ui = 0;
    if (!S.next(0, cur)) return;
    f32x4 acc[2][2][4][2];
#pragma unroll
    for (int a = 0; a < 2; ++a)
#pragma unroll
        for (int b = 0; b < 2; ++b)
#pragma unroll
            for (int m = 0; m < 4; ++m)
#pragma unroll
                for (int n = 0; n < 2; ++n) acc[a][b][m][n] = (f32x4){0.f, 0.f, 0.f, 0.f};
    bf16x8 At[4][2], B0[2][2], B1[2][2];
    const char* cA = (const char*)g.A + (size_t)cur.pm * tstep; const char* cB = (const char*)g.Bt + (size_t)cur.pn * tstep;
    S.a_ready(cur);
    if constexpr (SP2) {
        PG8_STAGE(PG8_SB(0, 0), cB, voffB); PG8_STAGE(PG8_SB(0, 1), cB + hstep, voffB); PG8_STAGE(PG8_SA(0, 0), cA, voffA); PG8_STAGE(PG8_SA(0, 1), cA + hstep, voffA);
        if (wr == 1) PG8_BAR;
        PG8_WAIT_V(2); PG8_BAR;
        PG8_STAGE(PG8_SB(1, 0), cB + kstep, voffB); PG8_STAGE(PG8_SA(1, 0), cA + kstep, voffA); PG8_STAGE(PG8_SB(1, 1), cB + hstep + kstep, voffB);
        PG8_WAIT_V(6); PG8_BAR;
    } else {
        PG8_STAGE(PG8_SB(0, 0), cB, voffB); PG8_STAGE(PG8_SA(0, 0), cA, voffA); PG8_STAGE(PG8_SB(0, 1), cB + hstep, voffB); PG8_STAGE(PG8_SA(0, 1), cA + hstep, voffA);
        if (wr == 1) PG8_BAR;
        PG8_WAIT_V(4); PG8_BAR;
        PG8_STAGE(PG8_SB(1, 0), cB + kstep, voffB); PG8_STAGE(PG8_SA(1, 0), cA + kstep, voffA); PG8_STAGE(PG8_SB(1, 1), cB + hstep + kstep, voffB);
        PG8_WAIT_V(6); PG8_BAR;
    }
    for (;;) {
        const bool has_next = S.next(ui + 1, nxt);
        const char* nA = has_next ? (const char*)g.A + (size_t)nxt.pm * tstep : cA; const char* nB = has_next ? (const char*)g.Bt + (size_t)nxt.pn * tstep : cB;
        for (int t = 0; t < nt; t += 2) {
            const bool last = (t == nt - 2);
            const char* a1 = cA + (size_t)(t + 1) * kstep;
            const char* a2 = last ? nA : cA + (size_t)(t + 2) * kstep; const char* b2 = last ? nB : cB + (size_t)(t + 2) * kstep;
            const char* a3 = a2 + kstep; const char* b3 = b2 + kstep;
            if (last && has_next) S.a_ready(nxt);
            if constexpr (SP2) {
            PG8_LDB(B0, 0, 0); PG8_LDB(B1, 0, 1); PG8_SCHED; PG8_LDA(At, 0, 0); PG8_STAGE(PG8_SA(1, 1), a1 + hstep, voffA);
            PG8_WAIT_V(8); PG8_WAIT_L(0); PG8_BAR; PG8_MMA(0, 0, At, B0); PG8_MMA(0, 1, At, B1); PG8_BAR; PG8_SCHED;
            PG8_LDA(At, 0, 1); PG8_STAGE(PG8_SB(0, 0), b2, voffB); PG8_STAGE(PG8_SB(0, 1), b2 + hstep, voffB); PG8_STAGE(PG8_SA(0, 0), a2, voffA);
            PG8_WAIT_V(8); PG8_WAIT_L(0); PG8_BAR; PG8_MMA(1, 0, At, B0); PG8_MMA(1, 1, At, B1); PG8_BAR; PG8_SCHED;
            PG8_LDB(B0, 1, 0); PG8_LDB(B1, 1, 1); PG8_SCHED; PG8_LDA(At, 1, 0); PG8_STAGE(PG8_SA(0, 1), a2 + hstep, voffA);
            PG8_WAIT_V(8); PG8_WAIT_L(0); PG8_BAR; PG8_MMA(0, 0, At, B0); PG8_MMA(0, 1, At, B1); PG8_BAR; PG8_SCHED;
            PG8_LDA(At, 1, 1); PG8_STAGE(PG8_SB(1, 0), b3, voffB); PG8_STAGE(PG8_SB(1, 1), b3 + hstep, voffB); PG8_STAGE(PG8_SA(1, 0), a3, voffA);
            PG8_WAIT_V(8); PG8_WAIT_L(0); PG8_BAR; PG8_MMA(1, 0, At, B0); PG8_MMA(1, 1, At, B1); PG8_BAR; PG8_SCHED;
            } else {
            PG8_LDB(B0, 0, 0); PG8_SCHED; PG8_LDA(At, 0, 0); PG8_STAGE(PG8_SA(1, 1), a1 + hstep, voffA);
            PG8_WAIT_L(8); PG8_BAR; PG8_WAIT_L(0); PG8_MMA(0, 0, At, B0); PG8_BAR; PG8_SCHED;
            PG8_LDB(B1, 0, 1); PG8_STAGE(PG8_SB(0, 0), b2, voffB);
            PG8_BAR; PG8_WAIT_L(0); PG8_MMA(0, 1, At, B1); PG8_BAR;
            PG8_LDA(At, 0, 1); PG8_STAGE(PG8_SA(0, 0), a2, voffA);
            PG8_BAR; PG8_WAIT_L(0); PG8_MMA(1, 0, At, B0); PG8_BAR; PG8_SCHED;
            PG8_STAGE(PG8_SB(0, 1), b2 + hstep, voffB);
            PG8_WAIT_V(6); PG8_BAR; PG8_MMA(1, 1, At, B1); PG8_BAR;
            PG8_LDB(B0, 1, 0); PG8_SCHED; PG8_LDA(At, 1, 0); PG8_STAGE(PG8_SA(0, 1), a2 + hstep, voffA);
            PG8_WAIT_L(8); PG8_BAR; PG8_WAIT_L(0); PG8_MMA(0, 0, At, B0); PG8_BAR; PG8_SCHED;
            PG8_LDB(B1, 1, 1); PG8_STAGE(PG8_SB(1, 0), b3, voffB);
            PG8_BAR; PG8_WAIT_L(0); PG8_MMA(0, 1, At, B1); PG8_BAR;
            PG8_LDA(At, 1, 1); PG8_STAGE(PG8_SA(1, 0), a3, voffA);
            PG8_BAR; PG8_WAIT_L(0); PG8_MMA(1, 0, At, B0); PG8_BAR; PG8_SCHED;
            PG8_STAGE(PG8_SB(1, 1), b3 + hstep, voffB);
            PG8_WAIT_V(6); PG8_BAR; PG8_MMA(1, 1, At, B1); PG8_BAR;
            }
        }
        if constexpr (ALIGN_EPI) { if (wr == 0) PG8_BAR; }
        if constexpr (!Epi::AFTER_DRAIN) { E(acc, cur, wr, wc, fr, fq); S.done(cur); }
        if (!has_next) break;
#pragma unroll
        for (int a = 0; a < 2; ++a)
#pragma unroll
            for (int b = 0; b < 2; ++b)
#pragma unroll
                for (int m = 0; m < 4; ++m)
#pragma unroll
                    for (int n = 0; n < 2; ++n) acc[a][b][m][n] = (f32x4){0.f, 0.f, 0.f, 0.f};
        cur = nxt; cA = nA; cB = nB; ++ui;
        if constexpr (ALIGN_EPI) { if (wr == 1) PG8_BAR; }
    }
    PG8_WAIT_V(0);
    if constexpr (!ALIGN_EPI) { if (wr == 0) PG8_BAR; }
    PG8_BAR;
    if constexpr (Epi::AFTER_DRAIN) { E.fused(acc, cur, wr, wc, fr, fq, lds, wid, lane); S.done(cur); }
#undef PG8_SA
#undef PG8_SB
#undef PG8_STAGE
#undef PG8_LDA
#undef PG8_LDB
#undef PG8_MMA
#undef PG8_WAIT_V
#undef PG8_WAIT_L
#undef PG8_BAR
#undef PG8_SCHED
}
template <class Epi, class Sched, class Rows>
__device__ __forceinline__ void gemm_phase_gather(PG8_LAS unsigned char* lds, const Gemm g, const Sched& S, const Epi& E, const Rows& rows) {
    constexpr bool ALIGN_EPI = true, SP2 = true;
    int tid_ = threadIdx.x; asm volatile("" : "+v"(tid_));
    const int tid = tid_, wid = __builtin_amdgcn_readfirstlane(tid >> 6), lane = tid & 63, wr = wid >> 2, wc = wid & 3, fr = lane & 15, fq = lane >> 4;
    const int K = g.K, nt = K / BK;
    unsigned voffB[2], cofs[2]; int RA[2];
#pragma unroll
    for (int i = 0; i < 2; ++i) { int R, C; stage_rc(tid * 16 + i * 8192, R, C); const int Rb = Epi::PERM ? ((R & ~31) + perm32(R & 31)) : R;
        RA[i] = R; cofs[i] = (unsigned)C * 2u; voffB[i] = (unsigned)(Rb * K + C) * 2u; }
    unsigned vC[2][2], vN[2][2];
#define PG8_LOADOFFS(v, un) do { _Pragma("unroll") for (int _h = 0; _h < 2; ++_h) _Pragma("unroll") for (int _i = 0; _i < 2; ++_i) (v)[_h][_i] = rows.rowoff((un), _h, RA[_i]) + cofs[_i]; } while (0)
    const size_t kstep = (size_t)(BK * 2);
    const size_t hstep = (size_t)HALF * K * 2;
    const size_t tstep = 2 * hstep;
    const unsigned ldsw = (unsigned)wid * 1024u;
    const int aoff = lds_byte(wr * 64 + fr, fq * 8), boff = lds_byte(wc * 32 + fr, fq * 8);
#define PG8_SA(b, h) (((b) * 2 + (h)) * HTB)
#define PG8_SB(b, h) ((4 + (b) * 2 + (h)) * HTB)
#define PG8_STAGE(bufoff, gbase, voff) do { _Pragma("unroll") for (int _i = 0; _i < 2; ++_i) \
        __builtin_amdgcn_global_load_lds((const unsigned*)((const char*)(gbase) + (voff)[_i]), (PG8_LAS unsigned*)(lds + (bufoff) + ldsw + _i * 8192), 16, 0, 0); } while (0)
#define PG8_LDA(dst, b, h) do { _Pragma("unroll") for (int m = 0; m < 4; ++m) _Pragma("unroll") for (int k = 0; k < 2; ++k) dst[m][k] = *(const PG8_LAS bf16x8*)(lds + PG8_SA(b, h) + aoff + m * 2048 + k * 1024); } while (0)
#define PG8_LDB(dst, b, h) do { _Pragma("unroll") for (int n = 0; n < 2; ++n) _Pragma("unroll") for (int k = 0; k < 2; ++k) dst[n][k] = *(const PG8_LAS bf16x8*)(lds + PG8_SB(b, h) + boff + n * 2048 + k * 1024); } while (0)
#define PG8_MMA(ai, bj, At, Bt) do { __builtin_amdgcn_s_setprio(1); _Pragma("unroll") for (int m = 0; m < 4; ++m) _Pragma("unroll") for (int n = 0; n < 2; ++n) _Pragma("unroll") for (int k = 0; k < 2; ++k) \
        acc[ai][bj][m][n] = mfma16_h(Bt[n][k], At[m][k], acc[ai][bj][m][n], 0, 0, 0); __builtin_amdgcn_s_setprio(0); } while (0)
#define PG8_WAIT_V(n) asm volatile("s_waitcnt vmcnt(" #n ")" ::: "memory")
#define PG8_WAIT_L(n) asm volatile("s_waitcnt lgkmcnt(" #n ")" ::: "memory")
#define PG8_BAR __builtin_amdgcn_s_barrier()
#define PG8_SCHED __builtin_amdgcn_sched_barrier(0)
    Unit cur, nxt; int ui = 0;
    if (!S.next(0, cur)) return;
    f32x4 acc[2][2][4][2];
#pragma unroll
    for (int a = 0; a < 2; ++a)
#pragma unroll
        for (int b = 0; b < 2; ++b)
#pragma unroll
            for (int m = 0; m < 4; ++m)
#pragma unroll
                for (int n = 0; n < 2; ++n) acc[a][b][m][n] = (f32x4){0.f, 0.f, 0.f, 0.f};
    bf16x8 At[4][2], B0[2][2], B1[2][2];
    const char* const Ab = (const char*)g.A; const char* cB = (const char*)g.Bt + (size_t)cur.pn * tstep;
    PG8_LOADOFFS(vC, cur);
    S.a_ready(cur);
    if constexpr (SP2) {
        PG8_STAGE(PG8_SB(0, 0), cB, voffB); PG8_STAGE(PG8_SB(0, 1), cB + hstep, voffB); PG8_STAGE(PG8_SA(0, 0), Ab, vC[0]); PG8_STAGE(PG8_SA(0, 1), Ab, vC[1]);
        if (wr == 1) PG8_BAR;
        PG8_WAIT_V(2); PG8_BAR;
        PG8_STAGE(PG8_SB(1, 0), cB + kstep, voffB); PG8_STAGE(PG8_SA(1, 0), Ab + kstep, vC[0]); PG8_STAGE(PG8_SB(1, 1), cB + hstep + kstep, voffB);
        PG8_WAIT_V(6); PG8_BAR;
    }
    for (;;) {
        const bool has_next = S.next(ui + 1, nxt);
        const char* nB = has_next ? (const char*)g.Bt + (size_t)nxt.pn * tstep : cB;
        if (has_next) { PG8_LOADOFFS(vN, nxt); } else { vN[0][0] = vC[0][0]; vN[0][1] = vC[0][1]; vN[1][0] = vC[1][0]; vN[1][1] = vC[1][1]; }
        for (int t = 0; t < nt; t += 2) {
            const bool last = (t == nt - 2);
            const char* a1 = Ab + (size_t)(t + 1) * kstep;
            const char* a2 = last ? Ab : Ab + (size_t)(t + 2) * kstep; const char* b2 = last ? nB : cB + (size_t)(t + 2) * kstep;
            const char* a3 = a2 + kstep; const char* b3 = b2 + kstep;
            unsigned s2h0[2], s2h1[2]; s2h0[0] = last ? vN[0][0] : vC[0][0]; s2h0[1] = last ? vN[0][1] : vC[0][1]; s2h1[0] = last ? vN[1][0] : vC[1][0]; s2h1[1] = last ? vN[1][1] : vC[1][1];
            if (last && has_next) S.a_ready(nxt);
            if constexpr (SP2) {
            PG8_LDB(B0, 0, 0); PG8_LDB(B1, 0, 1); PG8_SCHED; PG8_LDA(At, 0, 0); PG8_STAGE(PG8_SA(1, 1), a1, vC[1]);
            PG8_WAIT_V(8); PG8_WAIT_L(0); PG8_BAR; PG8_MMA(0, 0, At, B0); PG8_MMA(0, 1, At, B1); PG8_BAR; PG8_SCHED;
            PG8_LDA(At, 0, 1); PG8_STAGE(PG8_SB(0, 0), b2, voffB); PG8_STAGE(PG8_SB(0, 1), b2 + hstep, voffB); PG8_STAGE(PG8_SA(0, 0), a2, s2h0);
            PG8_WAIT_V(8); PG8_WAIT_L(0); PG8_BAR; PG8_MMA(1, 0, At, B0); PG8_MMA(1, 1, At, B1); PG8_BAR; PG8_SCHED;
            PG8_LDB(B0, 1, 0); PG8_LDB(B1, 1, 1); PG8_SCHED; PG8_LDA(At, 1, 0); PG8_STAGE(PG8_SA(0, 1), a2, s2h1);
            PG8_WAIT_V(8); PG8_WAIT_L(0); PG8_BAR; PG8_MMA(0, 0, At, B0); PG8_MMA(0, 1, At, B1); PG8_BAR; PG8_SCHED;
            PG8_LDA(At, 1, 1); PG8_STAGE(PG8_SB(1, 0), b3, voffB); PG8_STAGE(PG8_SB(1, 1), b3 + hstep, voffB); PG8_STAGE(PG8_SA(1, 0), a3, s2h0);
            PG8_WAIT_V(8); PG8_WAIT_L(0); PG8_BAR; PG8_MMA(1, 0, At, B0); PG8_MMA(1, 1, At, B1); PG8_BAR; PG8_SCHED;
            }
        }
        if constexpr (ALIGN_EPI) { if (wr == 0) PG8_BAR; }
        if constexpr (!Epi::AFTER_DRAIN) { E(acc, cur, wr, wc, fr, fq); S.done(cur); }
        if (!has_next) break;
#pragma unroll
        for (int a = 0; a < 2; ++a)
#pragma unroll
            for (int b = 0; b < 2; ++b)
#pragma unroll
                for (int m = 0; m < 4; ++m)
#pragma unroll
                    for (int n = 0; n < 2; ++n) acc[a][b][m][n] = (f32x4){0.f, 0.f, 0.f, 0.f};
        cur = nxt; cB = nB; ++ui; vC[0][0] = vN[0][0]; vC[0][1] = vN[0][1]; vC[1][0] = vN[1][0]; vC[1][1] = vN[1][1];
        if constexpr (ALIGN_EPI) { if (wr == 1) PG8_BAR; }
    }
    PG8_WAIT_V(0);
    if constexpr (!ALIGN_EPI) { if (wr == 0) PG8_BAR; }
    PG8_BAR;
    if constexpr (Epi::AFTER_DRAIN) { E.fused(acc, cur, wr, wc, fr, fq, lds, wid, lane); S.done(cur); }
#undef PG8_LOADOFFS
#undef PG8_SA
#undef PG8_SB
#undef PG8_STAGE
#undef PG8_LDA
#undef PG8_LDB
#undef PG8_MMA
#undef PG8_WAIT_V
#undef PG8_WAIT_L
#undef PG8_BAR
#undef PG8_SCHED
}
}

template <int NI, class RowPtr, class Epi>
__device__ __forceinline__ void gemm_tile(unsigned char* lds, const RowPtr& rowptr, const bf16* Bt, const int K, const Epi& epi) {
    const int tid = threadIdx.x, lane = tid & 63, wave = tid >> 6, wm = wave >> 2, wn = wave & 3, fr = lane & 15, fq = lane >> 4;
    const int sr = tid >> 3, cp = tid & 7;
    const int sw = (cp ^ (sr & 7)) << 3;
    const bf16* ap0 = rowptr(sr) + sw;
    const bf16* ap1 = rowptr(sr + 64) + sw;
    const bf16* bp = Bt + (size_t)sr * K + sw;
    const size_t bstep = (size_t)64 * K;
    f32x4 acc[4][NI];
#pragma unroll
    for (int i = 0; i < 4; ++i)
#pragma unroll
        for (int j = 0; j < NI; ++j) acc[i][j] = (f32x4){0.f, 0.f, 0.f, 0.f};
    const int nt = K >> 6;
    {
        unsigned char* Ab = lds; unsigned char* Bb = lds + 16384;
        glds16(ap0, Ab + tid * 16); glds16(ap1, Ab + 8192 + tid * 16);
#pragma unroll
        for (int i = 0; i < NI; ++i) glds16(bp + i * bstep, Bb + i * 8192 + tid * 16);
    }
    const int aoff = (wm * 64 + fr) * 128, boff = (wn * 16 * NI + fr) * 128;
    for (int kt = 0; kt < nt; ++kt) {
        asm volatile("s_waitcnt vmcnt(0)" ::: "memory");
        __syncthreads();
        if (kt + 1 < nt) {
            unsigned char* Ab = lds + ((kt + 1) & 1) * 49152; unsigned char* Bb = Ab + 16384;
            const int ko = (kt + 1) * 64;
            glds16(ap0 + ko, Ab + tid * 16); glds16(ap1 + ko, Ab + 8192 + tid * 16);
#pragma unroll
            for (int i = 0; i < NI; ++i) glds16(bp + i * bstep + ko, Bb + i * 8192 + tid * 16);
        }
        const unsigned char* Ab = lds + (kt & 1) * 49152; const unsigned char* Bb = Ab + 16384;
#pragma unroll
        for (int ks = 0; ks < 2; ++ks) {
            const int so = ((ks * 4 + fq) ^ (fr & 7)) << 4;
            bf16x8 af[4], bfr[NI];
#pragma unroll
            for (int i = 0; i < 4; ++i) af[i] = *(const bf16x8*)(Ab + aoff + i * 2048 + so);
#pragma unroll
            for (int i = 0; i < NI; ++i) bfr[i] = *(const bf16x8*)(Bb + boff + i * 2048 + so);
#pragma unroll
            for (int mi = 0; mi < 4; ++mi)
#pragma unroll
                for (int ni = 0; ni < NI; ++ni) acc[mi][ni] = mfma16_h(bfr[ni], af[mi], acc[mi][ni], 0, 0, 0);
        }
    }
    __syncthreads();
    epi(acc, wm * 64 + fr, wn * 16 * NI + 4 * fq);
}

template <class F>
__device__ __forceinline__ void transpose_item(const float* W, int K, int N, bf16* WT, float* scr, int item, int lane, const F& rowmap) {
    const int nblk = N / 32, kb = item / nblk, nb = item % nblk, k0 = 64 * kb, n0 = 32 * nb;
    float wv[32];
#pragma unroll
    for (int i = 0; i < 32; ++i) wv[i] = W[(size_t)(k0 + 2 * i + (lane >> 5)) * N + n0 + (lane & 31)];
#pragma unroll
    for (int i = 0; i < 32; ++i) scr[(2 * i + (lane >> 5)) * 33 + (lane & 31)] = wv[i];
    asm volatile("s_waitcnt lgkmcnt(0)" ::: "memory");
    const int c = lane & 7;
#pragma unroll
    for (int j = 0; j < 4; ++j) {
        const int n = (lane >> 3) + 8 * j; const float* s = scr + (8 * c) * 33 + n;
        u32x4 o; o.x = pk2(s[0 * 33], s[1 * 33]); o.y = pk2(s[2 * 33], s[3 * 33]); o.z = pk2(s[4 * 33], s[5 * 33]); o.w = pk2(s[6 * 33], s[7 * 33]);
        *(u32x4*)(WT + (size_t)rowmap(n0 + n) * K + k0 + 8 * c) = o;
    }
    asm volatile("s_waitcnt lgkmcnt(0)" ::: "memory");
}

__device__ __forceinline__ void sincos_d(double x, double& s, double& c) {
    const double k = rint(x * 0.63661977236758134308);
    const double r = (x - k * 1.57079632679489655800) - k * 6.123233995736766036e-17;
    const double r2 = r * r;
    double sp = 1.0 / 121645100408832000.0;
    sp = sp * r2 * (-1.0) + 1.0 / 355687428096000.0;
    sp = sp * r2 * (-1.0) + 1.0 / 1307674368000.0;
    sp = sp * r2 * (-1.0) + 1.0 / 6227020800.0;
    sp = sp * r2 * (-1.0) + 1.0 / 39916800.0;
    sp = sp * r2 * (-1.0) + 1.0 / 362880.0;
    sp = sp * r2 * (-1.0) + 1.0 / 5040.0;
    sp = sp * r2 * (-1.0) + 1.0 / 120.0;
    sp = sp * r2 * (-1.0) + 1.0 / 6.0;
    sp = sp * r2 * (-1.0) + 1.0;
    const double sr = sp * r;
    double cpn = 1.0 / 6402373705728000.0;
    cpn = cpn * r2 * (-1.0) + 1.0 / 20922789888000.0;
    cpn = cpn * r2 * (-1.0) + 1.0 / 87178291200.0;
    cpn = cpn * r2 * (-1.0) + 1.0 / 479001600.0;
    cpn = cpn * r2 * (-1.0) + 1.0 / 3628800.0;
    cpn = cpn * r2 * (-1.0) + 1.0 / 40320.0;
    cpn = cpn * r2 * (-1.0) + 1.0 / 720.0;
    cpn = cpn * r2 * (-1.0) + 1.0 / 24.0;
    cpn = cpn * r2 * (-1.0) + 0.5;
    const double cr = 1.0 - cpn * r2;
    const int q = ((int)k) & 3;
    s = (q == 0) ? sr : (q == 1) ? cr : (q == 2) ? -sr : -cr;
    c = (q == 0) ? cr : (q == 1) ? -sr : (q == 2) ? -cr : sr;
}
__device__ __forceinline__ double exp_small_d(double x) {
    const double y = x * 0.125;
    double p = 1.0 / 479001600.0;
    p = p * y + 1.0 / 39916800.0; p = p * y + 1.0 / 3628800.0; p = p * y + 1.0 / 362880.0; p = p * y + 1.0 / 40320.0;
    p = p * y + 1.0 / 5040.0; p = p * y + 1.0 / 720.0; p = p * y + 1.0 / 120.0; p = p * y + 1.0 / 24.0;
    p = p * y + 1.0 / 6.0; p = p * y + 0.5; p = p * y + 1.0; p = p * y + 1.0;
    p = p * p; p = p * p; p = p * p;
    return p;
}

__device__ __forceinline__ void phase_prep(const Params& P, unsigned char* lds) {
    int tid_ = threadIdx.x; asm volatile("" : "+v"(tid_));
    const int tid = tid_, lane = tid & 63, wave = tid >> 6;
    const int G = gridDim.x;
    const int gw = blockIdx.x * 8 + wave, NGW = G * 8;
    const size_t gtid = (size_t)blockIdx.x * NTHREADS + tid, NGT = (size_t)G * NTHREADS;
    unsigned char* ws = P.ws;
    if (blockIdx.x == 0 && tid < 64) ((int*)(ws + WS_CTL))[tid] = 0;
    {
        const f32x4* x4 = (const f32x4*)P.in[0]; u32x2* o = (u32x2*)(ws + WS_XB);
        const size_t n4 = (size_t)T * D / 4;
        for (size_t i = gtid; i < n4; i += 8 * NGT) {
            f32x4 v[8];
#pragma unroll
            for (int j = 0; j < 8; ++j) { const size_t idx = i + j * NGT; v[j] = x4[idx < n4 ? idx : i]; }
#pragma unroll
            for (int j = 0; j < 8; ++j) { const size_t idx = i + j * NGT; if (idx < n4) { u32x2 w; w.x = pk2(v[j].x, v[j].y); w.y = pk2(v[j].z, v[j].w); o[idx] = w; } }
        }
    }
    {
        float* scr = (float*)(lds + wave * 8704);
        constexpr int I_IN = 16 * 112, I_GLU = 8 * 64, I_COUT = 8 * 32, I_OUT = 16 * 32, I_RG = 16 * 1  , I_G = 16 * 8, I_D = 4 * 32;
        (void)I_RG;
        constexpr int TOTAL = I_IN + I_GLU + I_COUT + I_OUT + NEXP * (2 * I_G + I_D) + 16  ;
        for (int it = gw; it < TOTAL; it += NGW) {
            int r = it;
            if (r < I_IN) {
                transpose_item(P.in[1], D, DIN, (bf16*)(ws + WS_WIN), scr, r, lane,
                               [](int c) { return c < 512 ? c : (c < 1024 ? 512 + (((c - 512) >> 7) << 8) + ((c - 512) & 127) : (c < 1536 ? 512 + (((c - 1024) >> 7) << 8) + 128 + ((c - 1024) & 127) : c)); });
                continue;
            }
            r -= I_IN;
            if (r < I_GLU) { transpose_item(P.in[11], DSSM, 2 * D, (bf16*)(ws + WS_WGLU), scr, r, lane, [](int c) { return c < 1024 ? ((c >> 7) << 8) + (c & 127) : (((c - 1024) >> 7) << 8) + 128 + ((c - 1024) & 127); }); continue; }
            r -= I_GLU;
            if (r < I_COUT) { transpose_item(P.in[17], DCONV, D, (bf16*)(ws + WS_WCOUT), scr, r, lane, [](int c) { return c; }); continue; }
            r -= I_COUT;
            if (r < I_OUT) { transpose_item(P.in[19], D, D, (bf16*)(ws + WS_WOUT), scr, r, lane, [](int c) { return c; }); continue; }
            r -= I_OUT;
            if (r < NEXP * I_G) { const int e = r / I_G; transpose_item(P.in[27] + (size_t)e * D * DFF, D, DFF, (bf16*)(ws + WS_WGU) + (size_t)e * 512 * D, scr, r % I_G, lane, [](int c) { return ((c >> 7) << 8) + (c & 127); }); continue; }
            r -= NEXP * I_G;
            if (r < NEXP * I_G) { const int e = r / I_G; transpose_item(P.in[28] + (size_t)e * D * DFF, D, DFF, (bf16*)(ws + WS_WGU) + (size_t)e * 512 * D, scr, r % I_G, lane, [](int c) { return ((c >> 7) << 8) + 128 + (c & 127); }); continue; }
            r -= NEXP * I_G;
            if (r < NEXP * I_D) { const int e = r / I_D; transpose_item(P.in[29] + (size_t)e * DFF * D, DFF, D, (bf16*)(ws + WS_WD) + (size_t)e * D * DFF, scr, r % I_D, lane, [](int c) { return c; }); continue; }
            r -= NEXP * I_D;
            transpose_item(P.in[25], D, NEXP, (bf16*)(ws + WS_WR), scr, r, lane, [](int c) { return 4 + c; });
        }
    }
    {
        bf16* wr = (bf16*)(ws + WS_WR);
        for (size_t i = gtid; i < (size_t)4 * D; i += NGT) { const int n = (int)(i / D), k = (int)(i % D); wr[(size_t)n * D + k] = (bf16)f2bf(P.in[23][(size_t)k * 4 + n]); }
        for (size_t i = gtid; i < (size_t)(256 - 36) * D / 2; i += NGT) ((unsigned*)(wr + (size_t)36 * D))[i] = 0u;
    }
    {
        float* binp = (float*)(ws + WS_TAB + TAB_BINP); float* bglup = (float*)(ws + WS_TAB + TAB_BGLUP);
        for (size_t i = gtid; i < (size_t)DIN; i += NGT) { const int c = (int)i; const int r = c < 512 ? c : (c < 1024 ? 512 + (((c - 512) >> 7) << 8) + ((c - 512) & 127) : (c < 1536 ? 512 + (((c - 1024) >> 7) << 8) + 128 + ((c - 1024) & 127) : c)); binp[r] = P.in[2][c]; }
        for (size_t i = gtid; i < (size_t)2 * D; i += NGT) { const int c = (int)i; const int r = c < 1024 ? ((c >> 7) << 8) + (c & 127) : (((c - 1024) >> 7) << 8) + 128 + ((c - 1024) & 127); bglup[r] = P.in[12][c]; }
    }
    if (gtid < (size_t)NGRP * NST) {
        const int g = (int)gtid >> 6, p = (int)gtid & 63;
        const double lr = (double)P.in[3][g * 64 + p], li = (double)P.in[4][g * 64 + p];
        const double dt = (double)expf(P.in[5][g]);
        const double mag = exp_small_d(lr * dt);
        double sn, cs; sincos_d(li * dt, sn, cs);
        const double ar = mag * cs, ai = mag * sn;
        const double den = lr * lr + li * li;
        const double fr_ = ((ar - 1.0) * lr + ai * li) / den, fi_ = (ai * lr - (ar - 1.0) * li) / den;
        float* atab = (float*)(ws + WS_TAB + TAB_A);
        atab[(g * 64 + p) * 2 + 0] = (float)ar; atab[(g * 64 + p) * 2 + 1] = (float)ai;
        bf16* bb = (bf16*)(ws + WS_TAB + TAB_BB); bf16* cm = (bf16*)(ws + WS_TAB + TAB_CM);
        const int sh = p >> 5, p32 = p & 31;
        for (int h = 0; h < NH; ++h) {
            const double bre = (double)P.in[6][(g * 64 + p) * 16 + h], bim = (double)P.in[7][(g * 64 + p) * 16 + h];
            const double vre = fr_ * bre - fi_ * bim, vim = fr_ * bim + fi_ * bre;
            const int ln = p32 + 32 * (h >> 3), j = h & 7;
            bb[(((size_t)g * 4 + sh * 2 + 0) * 64 + ln) * 8 + j] = (bf16)f2bf((float)vre);
            bb[(((size_t)g * 4 + sh * 2 + 1) * 64 + ln) * 8 + j] = (bf16)f2bf((float)vim);
        }
        for (int ho = 0; ho < NH; ++ho) {
            const float cre = P.in[8][g * 1024 + ho * 64 + p], cim = P.in[9][g * 1024 + ho * 64 + p];
#pragma unroll
            for (int ri = 0; ri < 2; ++ri) {
                const int k = 2 * p + ri, ks = k >> 5, kk = k & 31, ln = ho + 16 * (kk >> 3), j = kk & 7;
                cm[(((size_t)g * 4 + ks) * 64 + ln) * 8 + j] = (bf16)f2bf(ri == 0 ? cre : -cim);
            }
        }
    }
}

struct EpiProj {
    const float* binp; bf16* U; bf16* V; bf16* SGS; bf16* SGC; int row0, col0;
    __device__ __forceinline__ void operator()(const f32x4 (&acc)[4][4], int r_in, int c_in) const {
#pragma unroll
        for (int mi = 0; mi < 4; ++mi) {
            const size_t row = (size_t)(row0 + r_in + mi * 16);
#pragma unroll
            for (int ni = 0; ni < 4; ++ni) {
                const int col = col0 + c_in + ni * 16;
                const f32x4 b = *(const f32x4*)(binp + col);
                const f32x4 v = acc[mi][ni] + b;
                if (col0 < 512) {
                    u32x2 w; w.x = pk2(v.x, v.y); w.y = pk2(v.z, v.w); *(u32x2*)(U + row * 512 + col) = w;
                } else if (col0 < 1536) {
                    const float v0 = v.x * sigmoidf_(v.y), v1 = v.z * sigmoidf_(v.w);
                    *(unsigned*)(V + row * 512 + ((col - 512) >> 1)) = pk2(v0, v1);
                } else if (col0 < 2560) {
                    u32x2 w; w.x = pk2(sigmoidf_(v.x), sigmoidf_(v.y)); w.y = pk2(sigmoidf_(v.z), sigmoidf_(v.w)); *(u32x2*)(SGS + row * 1024 + (col - 1536)) = w;
                } else {
                    u32x2 w; w.x = pk2(sigmoidf_(v.x), sigmoidf_(v.y)); w.y = pk2(sigmoidf_(v.z), sigmoidf_(v.w)); *(u32x2*)(SGC + row * 1024 + (col - 2560)) = w;
                }
            }
        }
    }
};
struct EpiCout {
    const float* bias; const bf16* SGC; bf16* MERGED; int row0, col0;
    __device__ __forceinline__ void operator()(const f32x4 (&acc)[4][4], int r_in, int c_in) const {
#pragma unroll
        for (int mi = 0; mi < 4; ++mi) {
            const size_t row = (size_t)(row0 + r_in + mi * 16);
#pragma unroll
            for (int ni = 0; ni < 4; ++ni) {
                const int col = col0 + c_in + ni * 16;
                const f32x4 v = acc[mi][ni] + *(const f32x4*)(bias + col);
                const u32x2 g = *(const u32x2*)(SGC + row * 1024 + col);
                u32x2 w; w.x = pk2(v.x * bflo(g.x), v.y * bfhi(g.x)); w.y = pk2(v.z * bflo(g.y), v.w * bfhi(g.y));
                *(u32x2*)(MERGED + row * 1024 + col) = w;
            }
        }
    }
};
struct EpiGlu {
    const float* bglup; const bf16* SGS; bf16* MERGED; int row0, col0;
    __device__ __forceinline__ void operator()(const f32x4 (&acc)[4][4], int r_in, int c_in) const {
#pragma unroll
        for (int mi = 0; mi < 4; ++mi) {
            const size_t row = (size_t)(row0 + r_in + mi * 16);
#pragma unroll
            for (int ni = 0; ni < 4; ++ni) {
                const int col = col0 + c_in + ni * 16;
                const f32x4 v = acc[mi][ni] + *(const f32x4*)(bglup + col);
                const int mc = col >> 1;
                const float s0 = v.x * sigmoidf_(v.y), s1 = v.z * sigmoidf_(v.w);
                const unsigned g = *(const unsigned*)(SGS + row * 1024 + mc);
                const unsigned m = *(const unsigned*)(MERGED + row * 1024 + mc);
                *(unsigned*)(MERGED + row * 1024 + mc) = pk2(bflo(m) + bflo(g) * s0, bfhi(m) + bfhi(g) * s1);
            }
        }
    }
};
struct EpiOut {
    const float* bias; const float* X; float* PRE; int row0, col0;
    __device__ __forceinline__ void operator()(const f32x4 (&acc)[4][4], int r_in, int c_in) const {
#pragma unroll
        for (int mi = 0; mi < 4; ++mi) {
            const size_t row = (size_t)(row0 + r_in + mi * 16);
#pragma unroll
            for (int ni = 0; ni < 4; ++ni) {
                const int col = col0 + c_in + ni * 16;
                const f32x4 xv = *(const f32x4*)(X + row * 1024 + col);
                *(f32x4*)(PRE + row * 1024 + col) = acc[mi][ni] + *(const f32x4*)(bias + col) + xv * ALPHA;
            }
        }
    }
};
struct EpiZ {
    float* Z; int row0;
    __device__ __forceinline__ void operator()(const f32x4 (&acc)[4][1], int r_in, int c_in) const {
#pragma unroll
        for (int mi = 0; mi < 4; ++mi) *(f32x4*)(Z + (size_t)(row0 + r_in + mi * 16) * 64 + c_in) = acc[mi][0];
    }
};
struct EpiGU {
    bf16* HID; int prow0, col0;
    __device__ __forceinline__ void operator()(const f32x4 (&acc)[4][4], int r_in, int c_in) const {
#pragma unroll
        for (int mi = 0; mi < 4; ++mi) {
            const size_t row = (size_t)(prow0 + r_in + mi * 16);
#pragma unroll
            for (int ni = 0; ni < 4; ++ni) {
                const int col = col0 + c_in + ni * 16;
                const f32x4 v = acc[mi][ni];
                *(unsigned*)(HID + row * 256 + (col >> 1)) = pk2(siluf_(v.x) * v.y, siluf_(v.z) * v.w);
            }
        }
    }
};
struct EpiDown {
    bf16* YM; const int* toklist; const float* GATE; int idx0, cnt, col0;
    __device__ __forceinline__ void operator()(const f32x4 (&acc)[4][4], int r_in, int c_in) const {
#pragma unroll
        for (int mi = 0; mi < 4; ++mi) {
            const int idx = idx0 + r_in + mi * 16;
            if (idx < cnt) {
                const int ent = toklist[idx];
                const float g = GATE[ent];
#pragma unroll
                for (int ni = 0; ni < 4; ++ni) {
                    const int col = col0 + c_in + ni * 16;
                    const f32x4 v = acc[mi][ni] * g;
                    u32x2 w; w.x = pk2(v.x, v.y); w.y = pk2(v.z, v.w);
                    *(u32x2*)(YM + (size_t)ent * 1024 + col) = w;
                }
            }
        }
    }
};

struct RowsDense { const bf16* base; size_t ld; __device__ __forceinline__ const bf16* operator()(int r) const { return base + (size_t)r * ld; } };
struct RowsGather {
    const bf16* HB; const int* toklist; int idx0, cnt;
    __device__ __forceinline__ const bf16* operator()(int r) const { const int idx = idx0 + r; const int tok = idx < cnt ? (toklist[idx] >> 1) : 0; return HB + (size_t)tok * 1024; }
};

constexpr int S5_WREG = 10752, S5_LBUF = 8 * S5_WREG;
__device__ __forceinline__ void s5_block_item(const Params& P, unsigned char* lds, int item) {
    unsigned char* ws = P.ws;
    int tid_ = threadIdx.x; asm volatile("" : "+v"(tid_));
    const int tid = tid_, lane = tid & 63, wave = __builtin_amdgcn_readfirstlane(tid >> 6);
    unsigned char* sbuf = lds + wave * S5_WREG; unsigned char* ubuf = sbuf + 8704; unsigned char* ybuf = sbuf + 9728;
    f32x4* Lbuf = (f32x4*)(lds + S5_LBUF);
    const int g = item & 31, bp = item >> 5;
    const int p32 = lane & 31, hf = lane >> 5;
    const float* atab = (const float*)(ws + WS_TAB + TAB_A);
    const float ar0 = atab[(g * 64 + p32) * 2], ai0 = atab[(g * 64 + p32) * 2 + 1];
    const float ar1 = atab[(g * 64 + p32 + 32) * 2], ai1 = atab[(g * 64 + p32 + 32) * 2 + 1];
    bf16x8 bb[4], cm[4];
#pragma unroll
    for (int q = 0; q < 4; ++q) {
        bb[q] = *(const bf16x8*)(ws + WS_TAB + TAB_BB + (((size_t)g * 4 + q) * 64 + lane) * 16);
        cm[q] = *(const bf16x8*)(ws + WS_TAB + TAB_CM + (((size_t)g * 4 + q) * 64 + lane) * 16);
    }
    const bf16* U = (const bf16*)(ws + WS_U);
    bf16* YG = (bf16*)(ws + WS_YG);
    const int a_seq = (p32 >> 2) & 1, a_ti = (p32 & 3) + 4 * (p32 >> 3);
    const int tbase = wave * 256;
    const bf16* ua = U + ((size_t)(2 * bp + a_seq) * SEQ + tbase + a_ti) * 512 + g * 16 + 8 * hf;
    const int ho = lane & 15, i4 = 4 * (lane >> 4);
    const float dsk = P.in[10][g * 16 + ho];
    const f32x16 z16 = {0.f, 0.f, 0.f, 0.f, 0.f, 0.f, 0.f, 0.f, 0.f, 0.f, 0.f, 0.f, 0.f, 0.f, 0.f, 0.f};
    float s0r = 0.f, s0i = 0.f, s1r = 0.f, s1i = 0.f;
    {
        bf16x8 afr[16];
#pragma unroll
        for (int blk = 0; blk < 16; ++blk) afr[blk] = *(const bf16x8*)(ua + (size_t)(blk * 16) * 512);
#pragma unroll
        for (int blk = 0; blk < 16; ++blk) {
            const bf16x8 af = afr[blk];
            const f32x16 b0r = mfma32_h(af, bb[0], z16, 0, 0, 0);
            const f32x16 b0i = mfma32_h(af, bb[1], z16, 0, 0, 0);
            const f32x16 b1r = mfma32_h(af, bb[2], z16, 0, 0, 0);
            const f32x16 b1i = mfma32_h(af, bb[3], z16, 0, 0, 0);
#pragma unroll
            for (int i = 0; i < 16; ++i) {
                float n0r = __builtin_fmaf(ar0, s0r, __builtin_fmaf(-ai0, s0i, b0r[i])); asm volatile("" : "+v"(n0r));
                float n0i = __builtin_fmaf(ar0, s0i, __builtin_fmaf(ai0, s0r, b0i[i]));  asm volatile("" : "+v"(n0i));
                float n1r = __builtin_fmaf(ar1, s1r, __builtin_fmaf(-ai1, s1i, b1r[i])); asm volatile("" : "+v"(n1r));
                float n1i = __builtin_fmaf(ar1, s1i, __builtin_fmaf(ai1, s1r, b1i[i]));  asm volatile("" : "+v"(n1i));
                s0r = n0r; s0i = n0i; s1r = n1r; s1i = n1i;
            }
        }
    }
    Lbuf[wave * 64 + lane] = (f32x4){s0r, s0i, s1r, s1i};
    __syncthreads();
    {
        float pr0 = ar0, pi0 = ai0, pr1 = ar1, pi1 = ai1;
#pragma unroll
        for (int i = 0; i < 8; ++i) {
            const float t0r = pr0 * pr0 - pi0 * pi0, t0i = 2.0f * pr0 * pi0, t1r = pr1 * pr1 - pi1 * pi1, t1i = 2.0f * pr1 * pi1;
            pr0 = t0r; pi0 = t0i; pr1 = t1r; pi1 = t1i;
        }
        s0r = 0.f; s0i = 0.f; s1r = 0.f; s1i = 0.f;
        for (int j = 0; j < wave; ++j) {
            const f32x4 L = Lbuf[j * 64 + lane];
            const float n0r = pr0 * s0r - pi0 * s0i + L.x, n0i = pr0 * s0i + pi0 * s0r + L.y;
            const float n1r = pr1 * s1r - pi1 * s1i + L.z, n1i = pr1 * s1i + pi1 * s1r + L.w;
            s0r = n0r; s0i = n0i; s1r = n1r; s1i = n1i;
        }
    }
    {
        bf16x8 af = *(const bf16x8*)ua;
        unsigned char* wrow = sbuf + (hf * 16) * 272 + 4 * p32;
        unsigned char* uw = ubuf + (a_seq * 16 + a_ti) * 32 + hf * 16;
        const int orow = lane >> 1, ohalf = lane & 1;
        bf16* yg_out = YG + ((size_t)(2 * bp + (orow >> 4)) * SEQ + tbase + (orow & 15)) * 512 + g * 16 + ohalf * 8;
        for (int blk = 0; blk < 16; ++blk) {
            const bf16x8 afn = *(const bf16x8*)(ua + (size_t)((blk < 15 ? blk + 1 : blk) * 16) * 512);
            *(bf16x8*)uw = af;
            const f32x16 b0r = mfma32_h(af, bb[0], z16, 0, 0, 0);
            const f32x16 b0i = mfma32_h(af, bb[1], z16, 0, 0, 0);
            const f32x16 b1r = mfma32_h(af, bb[2], z16, 0, 0, 0);
            const f32x16 b1i = mfma32_h(af, bb[3], z16, 0, 0, 0);
#pragma unroll
            for (int i = 0; i < 16; ++i) {
                float n0r = __builtin_fmaf(ar0, s0r, __builtin_fmaf(-ai0, s0i, b0r[i])); asm volatile("" : "+v"(n0r));
                float n0i = __builtin_fmaf(ar0, s0i, __builtin_fmaf(ai0, s0r, b0i[i]));  asm volatile("" : "+v"(n0i));
                float n1r = __builtin_fmaf(ar1, s1r, __builtin_fmaf(-ai1, s1i, b1r[i])); asm volatile("" : "+v"(n1r));
                float n1i = __builtin_fmaf(ar1, s1i, __builtin_fmaf(ai1, s1r, b1i[i]));  asm volatile("" : "+v"(n1i));
                s0r = n0r; s0i = n0i; s1r = n1r; s1i = n1i;
                *(unsigned*)(wrow + i * 272) = pk2(s0r, s0i);
                *(unsigned*)(wrow + i * 272 + 128) = pk2(s1r, s1i);
            }
            asm volatile("s_waitcnt lgkmcnt(0)" ::: "memory");
#pragma unroll
            for (int mb = 0; mb < 2; ++mb) {
                f32x4 y = {0.f, 0.f, 0.f, 0.f};
#pragma unroll
                for (int ks = 0; ks < 4; ++ks) {
                    const bf16x8 sf = *(const bf16x8*)(sbuf + (mb * 16 + (lane & 15)) * 272 + ks * 64 + (lane >> 4) * 16);
                    y = mfma16_h(sf, cm[ks], y, 0, 0, 0);
                }
#pragma unroll
                for (int r = 0; r < 4; ++r) {
                    const int ro = ((mb * 16 + i4 + r) * 32 + ho * 2);
                    const float yv = y[r] + dsk * bf2f(*(const bf16*)(ubuf + ro));
                    *(bf16*)(ybuf + ro) = (bf16)(pk2(geluf_(yv), 0.f) & 0xffffu);
                }
            }
            asm volatile("s_waitcnt lgkmcnt(0)" ::: "memory");
            const u32x4 yo = *(const u32x4*)(ybuf + orow * 32 + ohalf * 16);
            *(u32x4*)(yg_out + (size_t)(blk * 16) * 512) = yo;
            asm volatile("s_waitcnt lgkmcnt(0)" ::: "memory");
            af = afn;
        }
    }
    __syncthreads();
}

__device__ __forceinline__ void conv_phase(const Params& P, unsigned char* lds) {
    unsigned char* ws = P.ws;
    int tid_ = threadIdx.x; asm volatile("" : "+v"(tid_));
    const int tid = tid_, lane = tid & 63, wave = tid >> 6;
    const bf16* V = (const bf16*)(ws + WS_V);
    bf16* CV = (bf16*)(ws + WS_CV);
    unsigned char* vt = lds;
    float* ct = (float*)(lds + 63488);
    const int G = gridDim.x, nitems = T / 32;
    const int ch = tid;
    float w0[CW];
#pragma unroll
    for (int k = 0; k < CW; ++k) w0[k] = P.in[13][k * 512 + ch];
    const float cb0 = P.in[14][ch];
    const f32x4 g0 = *(const f32x4*)(P.in[15] + lane * 4), g1 = *(const f32x4*)(P.in[15] + 256 + lane * 4);
    const f32x4 b0 = *(const f32x4*)(P.in[16] + lane * 4), b1 = *(const f32x4*)(P.in[16] + 256 + lane * 4);
    u32x4 pf[8];
#define CONV_FETCH(item_) do { const int tokb_ = (item_) * 32, tloc_ = tokb_ & (SEQ - 1); \
        _Pragma("unroll") for (int n = 0; n < 8; ++n) { const int q = tid + n * NTHREADS; const int r = q >> 6, c16 = q & 63; \
            pf[n] = (u32x4){0u, 0u, 0u, 0u}; \
            if (q < 62 * 64 && tloc_ - 30 + r >= 0) pf[n] = *(const u32x4*)(V + (size_t)(tokb_ - 30 + r) * 512 + c16 * 8); } } while (0)
    int item = blockIdx.x;
    if (item < nitems) CONV_FETCH(item);
    for (; item < nitems; item += G) {
        const int tokb = item * 32;
#pragma unroll
        for (int n = 0; n < 8; ++n) { if (n < 7 || tid < 62 * 64 - 7 * NTHREADS) *(u32x4*)(vt + tid * 16 + n * (NTHREADS * 16)) = pf[n]; }
        __syncthreads();
        if (item + G < nitems) CONV_FETCH(item + G);
#pragma unroll 1
        for (int jc = 0; jc < 4; ++jc) {
            const int base = jc * 8;
            float a0[8];
#pragma unroll
            for (int j = 0; j < 8; ++j) a0[j] = cb0;
#pragma unroll
            for (int r = 0; r < 38; ++r) {
                const float x0 = bf2f(*(const bf16*)(vt + (base + r) * 1024 + ch * 2));
#pragma unroll
                for (int j = 0; j < 8; ++j) {
                    const int k = r - j;
                    if (k >= 0 && k < CW) a0[j] += w0[k] * x0;
                }
            }
#pragma unroll
            for (int j = 0; j < 8; ++j) ct[(base + j) * 512 + ch] = a0[j];
        }
        __syncthreads();
#pragma unroll
        for (int rr = 0; rr < 4; ++rr) {
            const int row = wave * 4 + rr;
            const f32x4 c0 = *(const f32x4*)(ct + row * 512 + lane * 4), c1 = *(const f32x4*)(ct + row * 512 + 256 + lane * 4);
            const float mean = wave_sum((c0.x + c0.y) + (c0.z + c0.w) + (c1.x + c1.y) + (c1.z + c1.w)) * (1.0f / 512.0f);
            const f32x4 d0 = c0 - mean, d1 = c1 - mean;
            const float var = wave_sum((d0.x * d0.x + d0.y * d0.y) + (d0.z * d0.z + d0.w * d0.w) + (d1.x * d1.x + d1.y * d1.y) + (d1.z * d1.z + d1.w * d1.w)) * (1.0f / 512.0f);
            const float rstd = 1.0f / sqrtf(var + LN_EPS);
            const f32x4 y0 = d0 * rstd * g0 + b0, y1 = d1 * rstd * g1 + b1;
            u32x2 o0, o1;
            o0.x = pk2(siluf_(y0.x), siluf_(y0.y)); o0.y = pk2(siluf_(y0.z), siluf_(y0.w));
            o1.x = pk2(siluf_(y1.x), siluf_(y1.y)); o1.y = pk2(siluf_(y1.z), siluf_(y1.w));
            bf16* orow = CV + (size_t)(tokb + row) * 512;
            *(u32x2*)(orow + lane * 4) = o0; *(u32x2*)(orow + 256 + lane * 4) = o1;
        }
        __syncthreads();
    }
#undef CONV_FETCH
}

__device__ __forceinline__ void ln1_rows(const Params& P) {
    const int tid = threadIdx.x, lane = tid & 63, wave = tid >> 6;
    const int gw = blockIdx.x * 8 + wave, NGW = gridDim.x * 8;
    const float* PRE = P.out; bf16* HB = (bf16*)(P.ws + WS_HB);
    const float* lg = P.in[21]; const float* lb = P.in[22];
    f32x4 g[4], b[4];
#pragma unroll
    for (int j = 0; j < 4; ++j) { g[j] = *(const f32x4*)(lg + j * 256 + lane * 4); b[j] = *(const f32x4*)(lb + j * 256 + lane * 4); }
    for (int row = gw; row < T; row += NGW) {
        const float* xr = PRE + (size_t)row * 1024;
        f32x4 v[4]; float s = 0.f;
#pragma unroll
        for (int j = 0; j < 4; ++j) { v[j] = *(const f32x4*)(xr + j * 256 + lane * 4); s += (v[j].x + v[j].y) + (v[j].z + v[j].w); }
        const float mean = wave_sum(s) * (1.0f / 1024.0f); float s2 = 0.f;
#pragma unroll
        for (int j = 0; j < 4; ++j) { v[j] = v[j] - mean; s2 += (v[j].x * v[j].x + v[j].y * v[j].y) + (v[j].z * v[j].z + v[j].w * v[j].w); }
        const float rstd = 1.0f / sqrtf(wave_sum(s2) * (1.0f / 1024.0f) + LN_EPS);
        bf16* orow = HB + (size_t)row * 1024;
#pragma unroll
        for (int j = 0; j < 4; ++j) {
            const f32x4 y = v[j] * rstd * g[j] + b[j];
            u32x2 w; w.x = pk2(y.x, y.y); w.y = pk2(y.z, y.w);
            *(u32x2*)(orow + j * 256 + lane * 4) = w;
        }
    }
}
__device__ __forceinline__ void final_rows(const Params& P) {
    int tid_ = threadIdx.x; asm volatile("" : "+v"(tid_));
    const int tid = tid_, lane = tid & 63, wave = tid >> 6;
    const int gw = blockIdx.x * 8 + wave, NGW = gridDim.x * 8;
    const bf16* HB = (const bf16*)(P.ws + WS_HB); const bf16* YM = (const bf16*)(P.ws + WS_YM);
    const float* lg = P.in[30]; const float* lb = P.in[31];
    f32x4 g[4], b[4];
#pragma unroll
    for (int j = 0; j < 4; ++j) { g[j] = *(const f32x4*)(lg + j * 256 + lane * 4); b[j] = *(const f32x4*)(lb + j * 256 + lane * 4); }
#pragma unroll 2
    for (int row = gw; row < T; row += NGW) {
        f32x4 v[4]; float s = 0.f;
#pragma unroll
        for (int j = 0; j < 4; ++j) {
            const u32x2 h = *(const u32x2*)(HB + (size_t)row * 1024 + j * 256 + lane * 4);
            const u32x2 y0 = *(const u32x2*)(YM + (size_t)(2 * row) * 1024 + j * 256 + lane * 4);
            const u32x2 y1 = *(const u32x2*)(YM + (size_t)(2 * row + 1) * 1024 + j * 256 + lane * 4);
            v[j].x = ALPHA * bflo(h.x) + bflo(y0.x) + bflo(y1.x); v[j].y = ALPHA * bfhi(h.x) + bfhi(y0.x) + bfhi(y1.x);
            v[j].z = ALPHA * bflo(h.y) + bflo(y0.y) + bflo(y1.y); v[j].w = ALPHA * bfhi(h.y) + bfhi(y0.y) + bfhi(y1.y);
            s += (v[j].x + v[j].y) + (v[j].z + v[j].w);
        }
        const float mean = wave_sum(s) * (1.0f / 1024.0f); float s2 = 0.f;
#pragma unroll
        for (int j = 0; j < 4; ++j) { v[j] = v[j] - mean; s2 += (v[j].x * v[j].x + v[j].y * v[j].y) + (v[j].z * v[j].z + v[j].w * v[j].w); }
        const float rstd = 1.0f / sqrtf(wave_sum(s2) * (1.0f / 1024.0f) + LN_EPS);
        float* orow = P.out + (size_t)row * 1024;
#pragma unroll
        for (int j = 0; j < 4; ++j) *(f32x4*)(orow + j * 256 + lane * 4) = v[j] * rstd * g[j] + b[j];
    }
}
struct EpiZlds {
    float* Zs;
    __device__ __forceinline__ void operator()(const f32x4 (&acc)[4][4], int r_in, int c_in) const {
        if (c_in >= 64) return;
#pragma unroll
        for (int mi = 0; mi < 4; ++mi)
#pragma unroll
            for (int ni = 0; ni < 3; ++ni) {
                const int c = c_in + ni * 16;
                if (c < 40) *(f32x4*)(Zs + (r_in + mi * 16) * 40 + c) = acc[mi][ni];
            }
    }
};
__device__ __forceinline__ void ln_route_phase(const Params& P, unsigned char* lds) {
    unsigned char* ws = P.ws;
    int tid_ = threadIdx.x; asm volatile("" : "+v"(tid_));
    const int tid = tid_, lane = tid & 63, wave = tid >> 6, r = lane & 15, q = lane >> 4;
    const bf16* PREB = (const bf16*)(ws + WS_PREB); bf16* HB = (bf16*)(ws + WS_HB);
    int* CNT = (int*)(ws + WS_CTL); int* TOK = (int*)(ws + WS_TOK); float* GATE = (float*)(ws + WS_GATE);
    const float* lg = P.in[21]; const float* lb = P.in[22];
    const float* brg = P.in[24]; const float* bre = P.in[26];
    unsigned char* wl = lds;
    float* gl = (float*)(lds + 74304);
    float* zt = (float*)(lds + 82496 + wave * 3328);
    int* hist = (int*)(lds + 109120); int* base = hist + 32;
    for (int t = blockIdx.x; t < T / 128; t += gridDim.x) {
        asm volatile("" ::: "memory");
        int q8 = q * 8, ro = r * 1024 + q * 8;
        asm volatile("" : "+v"(q8), "+v"(ro));
#pragma unroll
        for (int i = 0; i < 9; ++i) {
            const int h = i * 8 + wave, wrow = h >> 1, half = h & 1;
            glds16((const bf16*)(ws + WS_WR) + wrow * 1024 + half * 512 + lane * 8, wl + wrow * 2064 + half * 1024 + lane * 16);
        }
        glds16(tid < 256 ? lg + tid * 4 : lb + (tid - 256) * 4, (unsigned char*)gl + tid * 16);
        const unsigned char* wrp0 = wl + (ro >> 10) * 2064 + q8 * 2;
        const unsigned char* wrp2 = wl + (32 + ((ro >> 10) & 3)) * 2064 + q8 * 2;
        const float* lgq = gl + q8; const float* lbq = gl + 1024 + q8;
        if (tid < 32) hist[tid] = 0;
        const size_t row = (size_t)t * 128 + wave * 16 + r;
        const bf16* prow = PREB + row * 1024 + q8;
        u32x4 pv[32];
#pragma unroll
        for (int s = 0; s < 32; ++s) pv[s] = *(const u32x4*)(prow + s * 32);
        float sm = 0.f;
#pragma unroll
        for (int s = 0; s < 32; ++s)
            sm += ((bflo(pv[s].x) + bfhi(pv[s].x)) + (bflo(pv[s].y) + bfhi(pv[s].y))) + ((bflo(pv[s].z) + bfhi(pv[s].z)) + (bflo(pv[s].w) + bfhi(pv[s].w)));
        sm += __shfl_xor(sm, 16); sm += __shfl_xor(sm, 32);
        const float mean = sm * (1.0f / 1024.0f);
#pragma unroll
        for (int s = 0; s < 32; ++s) asm volatile("" : "+v"(pv[s]));
        float s2 = 0.f;
#pragma unroll
        for (int s = 0; s < 32; ++s) {
            const float d0 = bflo(pv[s].x) - mean, d1 = bfhi(pv[s].x) - mean, d2 = bflo(pv[s].y) - mean, d3 = bfhi(pv[s].y) - mean;
            const float d4 = bflo(pv[s].z) - mean, d5 = bfhi(pv[s].z) - mean, d6 = bflo(pv[s].w) - mean, d7 = bfhi(pv[s].w) - mean;
            s2 += ((d0 * d0 + d1 * d1) + (d2 * d2 + d3 * d3)) + ((d4 * d4 + d5 * d5) + (d6 * d6 + d7 * d7));
        }
        s2 += __shfl_xor(s2, 16); s2 += __shfl_xor(s2, 32);
        const float rstd = 1.0f / sqrtf(s2 * (1.0f / 1024.0f) + LN_EPS);
#pragma unroll
        for (int s = 0; s < 32; ++s) asm volatile("" : "+v"(pv[s]));
        asm volatile("s_waitcnt vmcnt(0)" ::: "memory");
        __syncthreads();
        f32x4 acc[3];
#pragma unroll
        for (int i = 0; i < 3; ++i) acc[i] = (f32x4){0.f, 0.f, 0.f, 0.f};
        bf16* hrow = HB + row * 1024 + q8;
#pragma unroll
        for (int s = 0; s < 32; ++s) {
            const f32x4 g0 = *(const f32x4*)(lgq + s * 32), g1 = *(const f32x4*)(lgq + s * 32 + 4);
            const f32x4 b0 = *(const f32x4*)(lbq + s * 32), b1 = *(const f32x4*)(lbq + s * 32 + 4);
            const f32x4 v0 = {bflo(pv[s].x), bfhi(pv[s].x), bflo(pv[s].y), bfhi(pv[s].y)}, v1 = {bflo(pv[s].z), bfhi(pv[s].z), bflo(pv[s].w), bfhi(pv[s].w)};
            const f32x4 y0 = (v0 - mean) * rstd * g0 + b0, y1 = (v1 - mean) * rstd * g1 + b1;
            u32x4 w; w.x = pk2(y0.x, y0.y); w.y = pk2(y0.z, y0.w); w.z = pk2(y1.x, y1.y); w.w = pk2(y1.z, y1.w);
            *(u32x4*)(hrow + s * 32) = w;
            const bf16x8 a = __builtin_bit_cast(bf16x8, w);
            acc[0] = mfma16_h(*(const bf16x8*)(wrp0 + s * 64), a, acc[0], 0, 0, 0);
            acc[1] = mfma16_h(*(const bf16x8*)(wrp0 + 16 * 2064 + s * 64), a, acc[1], 0, 0, 0);
            acc[2] = mfma16_h(*(const bf16x8*)(wrp2 + s * 64), a, acc[2], 0, 0, 0);
        }
#pragma unroll
        for (int nt = 0; nt < 3; ++nt) *(f32x4*)(zt + r * 52 + nt * 16 + 4 * q) = acc[nt];
        __syncthreads();
        const size_t tok = (size_t)t * 128 + wave * 16 + lane;
        int e0 = 0, e1 = 0, r0 = 0, r1 = 0;
        if (lane < 16) {
            const float* z = zt + lane * 52;
            float zg[4];
#pragma unroll
            for (int i = 0; i < 4; ++i) zg[i] = z[i] + brg[i];
            int gs = 0; float mx = zg[0];
#pragma unroll
            for (int i = 1; i < 4; ++i) if (zg[i] > mx) { mx = zg[i]; gs = i; }
            float den = 0.f;
#pragma unroll
            for (int i = 0; i < 4; ++i) den += __expf(zg[i] - mx);
            const float pgrp = 1.0f / den;
            float ze[8];
#pragma unroll
            for (int i = 0; i < 8; ++i) ze[i] = z[4 + gs * 8 + i] + bre[gs * 8 + i];
            int i0 = 0; float v0 = ze[0];
#pragma unroll
            for (int i = 1; i < 8; ++i) if (ze[i] > v0) { v0 = ze[i]; i0 = i; }
            int i1 = -1; float v1 = -3.0e38f;
#pragma unroll
            for (int i = 0; i < 8; ++i) if (i != i0 && ze[i] > v1) { v1 = ze[i]; i1 = i; }
            const float sx = __expf(v1 - v0);
            const float g0 = pgrp / (1.0f + sx), g1 = pgrp * sx / (1.0f + sx);
            e0 = gs * 8 + i0; e1 = gs * 8 + i1;
            GATE[tok * 2] = g0; GATE[tok * 2 + 1] = g1;
            r0 = atomicAdd(&hist[e0], 1); r1 = atomicAdd(&hist[e1], 1);
        }
        __syncthreads();
        if (tid < 32) base[tid] = atomicAdd(&CNT[tid], hist[tid]);
        __syncthreads();
        if (lane < 16) {
            TOK[(size_t)e0 * T + base[e0] + r0] = (int)(tok * 2);
            TOK[(size_t)e1 * T + base[e1] + r1] = (int)(tok * 2 + 1);
        }
        __syncthreads();
    }
}

#define LAS __attribute__((address_space(3)))
#define XB_TMO      128
#define XB_XCNT(j)  (256  + 64 * (j))
#define XB_XSUB(j)  (1280 + 64 * (j))
#define XB_XGEN(j)  (2304 + 64 * (j))
#define XB_TOP      3328
#define XB_TOPGEN   3392
#define XCD_BAR_WORDS 3456
#define XB_SPIN_CAP (1u << 20)
__device__ __forceinline__ unsigned xb_ld(unsigned* p)              { return __hip_atomic_load(p, __ATOMIC_RELAXED, __HIP_MEMORY_SCOPE_AGENT); }
__device__ __forceinline__ unsigned xb_add(unsigned* p, unsigned v) { return __hip_atomic_fetch_add(p, v, __ATOMIC_RELAXED, __HIP_MEMORY_SCOPE_AGENT); }
__device__ __forceinline__ unsigned xb_xcc_id() { return (unsigned)__builtin_amdgcn_s_getreg((3 << 11) | 20) & 0xFu; }
#define XB_SPIN(cond, bar) do { unsigned _sp = 0; while (cond) { __builtin_amdgcn_s_sleep(1); \
    if ((++_sp & 255u) == 0u) { if (xb_ld(&(bar)[XB_TMO])) break; if (_sp > XB_SPIN_CAP) { atomicAdd(&(bar)[XB_TMO], 1u); break; } } } } while (0)
struct XcdBarrier { unsigned* bar; unsigned x; volatile LAS unsigned* st; };
__device__ __forceinline__ XcdBarrier xcd_barrier_post(unsigned* bar, volatile LAS unsigned* st) {
    XcdBarrier b; b.bar = bar; b.x = xb_xcc_id(); b.st = st;
    if (threadIdx.x == 0) (void)xb_add(&bar[XB_XCNT(b.x)], 1u);
    return b;
}
__device__ __forceinline__ void xcd_barrier_complete(unsigned* bar, unsigned x, unsigned& nloc, unsigned& nx) {
    const unsigned G = gridDim.x * gridDim.y * gridDim.z;
    unsigned sum, cnt, mine, sp = 0u;
    for (;;) {
        sum = 0u; cnt = 0u; mine = 0u;
#pragma unroll
        for (unsigned j = 0; j < 16; ++j) { const unsigned c = xb_ld(&bar[XB_XCNT(j)]); sum += c; cnt += (c > 0u) ? 1u : 0u; mine = (j == x) ? c : mine; }
        if (sum == G) break;
        __builtin_amdgcn_s_sleep(1);
        if ((++sp & 255u) == 0u) { if (xb_ld(&bar[XB_TMO])) break; if (sp > XB_SPIN_CAP) { atomicAdd(&bar[XB_TMO], 1u); break; } }
    }
    nloc = mine > 0u ? mine : 1u; nx = cnt > 0u ? cnt : 1u;
}
__device__ __forceinline__ void xcd_barrier(const XcdBarrier& b) {
    asm volatile("s_waitcnt vmcnt(0)" ::: "memory");
    __syncthreads();
    if (threadIdx.x == 0) {
        unsigned* bar = b.bar;
        __builtin_amdgcn_s_waitcnt(0);
        unsigned nloc = b.st[0], nx = b.st[1];
        if (nloc == 0u) { xcd_barrier_complete(bar, b.x, nloc, nx); b.st[0] = nloc; b.st[1] = nx; }
        const unsigned old = xb_add(&bar[XB_XSUB(b.x)], 1u);
        const unsigned gen = old / nloc;
        if (old + 1u == (gen + 1u) * nloc) {
            __builtin_amdgcn_fence(__ATOMIC_RELEASE, "agent");
            asm volatile("s_waitcnt vmcnt(0)" ::: "memory");
            const unsigned og = xb_add(&bar[XB_TOP], 1u);
            const unsigned tg = og / nx;
            if (og + 1u == (tg + 1u) * nx) xb_add(&bar[XB_TOPGEN], 1u);
            else XB_SPIN(xb_ld(&bar[XB_TOPGEN]) == tg, bar);
            __builtin_amdgcn_fence(__ATOMIC_ACQUIRE, "agent");
            xb_add(&bar[XB_XGEN(b.x)], 1u);
            asm volatile("s_waitcnt vmcnt(0)" ::: "memory");
        } else {
            XB_SPIN(xb_ld(&bar[XB_XGEN(b.x)]) == gen, bar);
            __builtin_amdgcn_fence(__ATOMIC_ACQUIRE, "agent");
            asm volatile("s_waitcnt vmcnt(0)" ::: "memory");
        }
    }
    __syncthreads();
}

__device__ __forceinline__ void run_phase(const Params& P, unsigned char* lds, int ph) {
    unsigned char* ws = P.ws;
    const int G = gridDim.x, bid = blockIdx.x;
    switch (ph) {
    case 0: phase_prep(P, lds); break;
    case 1: {
        pg8::Gemm g{(const pg8::bf16_t*)(ws + WS_XB), (const pg8::bf16_t*)(ws + WS_WIN), T, DIN, D};
        pg8::StaticOrder S; S.init(T, DIN, G, bid);
        pg8::EpiProj E{(const float*)(ws + WS_TAB + TAB_BINP), (bf16*)(ws + WS_U), (bf16*)(ws + WS_V), (bf16*)(ws + WS_SGS), (bf16*)(ws + WS_SGC)};
        pg8::gemm_phase<pg8::EpiProj, pg8::StaticOrder, true, true>((PG8_LAS unsigned char*)lds, g, S, E);
    } break;
    case 2: {
        for (int it = bid; it < 256; it += G) s5_block_item(P, lds, it);
        conv_phase(P, lds);
    } break;
    case 3: {
        static_assert(WS_CV == WS_YG + (size_t)T * DSSM * 2 && WS_WCOUT == WS_WGLU + (size_t)2 * D * DSSM * 2 && DSSM == DCONV && T / 256 == 128, "virtual operands must be contiguous");
        pg8::Gemm g{(const pg8::bf16_t*)(ws + WS_YG), (const pg8::bf16_t*)(ws + WS_WGLU), 2 * T, 3 * D, DSSM};
        pg8::TripleOrder S; S.so.init(T, D, G, bid);
        pg8::EpiCG E{{P.in[18], (const bf16*)(ws + WS_SGC), (bf16*)(ws + WS_M1)},
                     {(const float*)(ws + WS_TAB + TAB_BGLUP), (const bf16*)(ws + WS_SGS), (const bf16*)(ws + WS_M1), (bf16*)(ws + WS_MERGED)}};
        pg8::gemm_phase<pg8::EpiCG, pg8::TripleOrder, true, true>((PG8_LAS unsigned char*)lds, g, S, E);
    } break;
    case 5: {
        pg8::Gemm g{(const pg8::bf16_t*)(ws + WS_MERGED), (const pg8::bf16_t*)(ws + WS_WOUT), T, D, D};
        pg8::StaticOrder S; S.init(T, D, G, bid);
        pg8::EpiOut E{P.in[20], P.in[0], (bf16*)(ws + WS_PREB), ALPHA};
        pg8::gemm_phase<pg8::EpiOut, pg8::StaticOrder, true, true>((PG8_LAS unsigned char*)lds, g, S, E);
    } break;
    case 6: ln_route_phase(P, lds); break;
    case 9: {
        const int* CNT = (const int*)(ws + WS_CTL);
        PG8_LAS int* tab = (PG8_LAS int*)((PG8_LAS unsigned char*)lds + LDS_MISC + 64);
        if (threadIdx.x == 0) {
            int up = 0, bp = 0;
            for (int e = 0; e < NEXP; ++e) { const int cnt = CNT[e], nb = (cnt + 255) >> 8; tab[e] = up; tab[64 + e] = bp; tab[128 + e] = cnt; up += nb * 2; bp += nb; }
            tab[32] = up; tab[96] = bp;
        }
        __syncthreads();
        pg8::Gemm g{(const pg8::bf16_t*)(ws + WS_HB), (const pg8::bf16_t*)(ws + WS_WGU), 0, NEXP * 512, D};
        pg8::MoeOrder S{tab, G, bid, 1};
        pg8::MoeRows R{tab, (const int*)(ws + WS_TOK), T, (unsigned)(D * 2)};
        pg8::EpiGUP E{(bf16*)(ws + WS_HID)};
        pg8::gemm_phase_gather<pg8::EpiGUP, pg8::MoeOrder, pg8::MoeRows>((PG8_LAS unsigned char*)lds, g, S, E, R);
        __syncthreads();
    } break;
    case 10: {
        const int* CNT = (const int*)(ws + WS_CTL);
        PG8_LAS int* tab = (PG8_LAS int*)((PG8_LAS unsigned char*)lds + LDS_MISC + 64);
        if (threadIdx.x == 0) {
            int up = 0, bp = 0;
            for (int e = 0; e < NEXP; ++e) { const int cnt = CNT[e], nb = (cnt + 255) >> 8; tab[e] = up; tab[64 + e] = bp; tab[128 + e] = cnt; up += nb * 4; bp += nb; }
            tab[32] = up; tab[96] = bp;
        }
        __syncthreads();
        pg8::Gemm g{(const pg8::bf16_t*)(ws + WS_HID), (const pg8::bf16_t*)(ws + WS_WD), 0, NEXP * D, DFF};
        pg8::MoeOrder S{tab, G, bid, 2};
        pg8::EpiDownP E{tab, (const int*)(ws + WS_TOK), (const float*)(ws + WS_GATE), (bf16*)(ws + WS_YM), (bf16*)(ws + WS_Z), T};
        pg8::gemm_phase<pg8::EpiDownP, pg8::MoeOrder, true, true>((PG8_LAS unsigned char*)lds, g, S, E);
    } break;
    case 11: final_rows(P); break;
    default: break;
    }
}

#if ONE_LAUNCH
__global__ void __launch_bounds__(NTHREADS) fwd_kernel(Params P) {
    extern __shared__ __attribute__((aligned(16))) unsigned char lds[];
    if (P.ph_hi < 0) cg::this_grid().sync();
    volatile LAS unsigned* misc = (volatile LAS unsigned*)(LAS unsigned char*)(lds + LDS_MISC);
    if (threadIdx.x < 4) misc[threadIdx.x] = 0u;
    __syncthreads();
    XcdBarrier bar = xcd_barrier_post((unsigned*)(P.ws + WS_CTL) + CTL_BAR, misc);
#define GSYNC() xcd_barrier(bar)
    run_phase(P, lds, 0); GSYNC();
    run_phase(P, lds, 1); GSYNC();
    run_phase(P, lds, 2); GSYNC();
    run_phase(P, lds, 3); GSYNC();
    run_phase(P, lds, 5); GSYNC();
    run_phase(P, lds, 6); GSYNC();
    run_phase(P, lds, 9); GSYNC();
    run_phase(P, lds, 10); GSYNC();
    run_phase(P, lds, 11);
}
#else
template <int PH>
__global__ void __launch_bounds__(NTHREADS) phase_kernel(Params P) {
    extern __shared__ __attribute__((aligned(16))) unsigned char lds[];
    run_phase(P, lds, PH);
}
template <int PH> static void launch_phase(int grid, const Params& p, hipStream_t stream) {
    static bool init = false;
    if (!init) { (void)hipFuncSetAttribute((const void*)phase_kernel<PH>, hipFuncAttributeMaxDynamicSharedMemorySize, LDS_BYTES); init = true; }
    hipLaunchKernelGGL(phase_kernel<PH>, dim3(grid), dim3(NTHREADS), LDS_BYTES, stream, p);
}
#endif

extern "C" void kernel_launch(void* const* d_in, const int* in_sizes, int n_in, void* d_out, int out_size, void* d_ws, size_t ws_size, hipStream_t stream) {
    static int grid = 0;
    if (grid == 0) {
        if (n_in != 32 || in_sizes[0] != T * D || out_size != T * D || ws_size < WS_END) {
            fprintf(stderr, "kernel_launch: unexpected shapes (n_in %d, in0 %d, out %d, ws %zu)\n", n_in, n_in > 0 ? in_sizes[0] : -1, out_size, ws_size);
            grid = -1; return;
        }
        int dev = 0, cus = 0, per_cu = 1;
        (void)hipGetDevice(&dev);
        (void)hipDeviceGetAttribute(&cus, hipDeviceAttributeMultiprocessorCount, dev);
#if ONE_LAUNCH
        (void)hipFuncSetAttribute((const void*)fwd_kernel, hipFuncAttributeMaxDynamicSharedMemorySize, LDS_BYTES);
        (void)hipOccupancyMaxActiveBlocksPerMultiprocessor(&per_cu, (const void*)fwd_kernel, NTHREADS, LDS_BYTES);
        if (per_cu < 1) per_cu = 1;
#endif
        grid = cus * per_cu;
        (void)hipGetLastError();
    }
    if (grid < 0) return;
    if (hipMemsetAsync((char*)d_ws + WS_CTL, 0, CTL_ZERO_BYTES, stream) != hipSuccess) { fprintf(stderr, "kernel_launch: memset failed\n"); return; }
    Params p{};
    for (int i = 0; i < 32; ++i) p.in[i] = (const float*)d_in[i];
    p.out = (float*)d_out; p.ws = (unsigned char*)d_ws;
#if ONE_LAUNCH
    p.ph_lo = 0; p.ph_hi = NPHASE;
    void* args[] = {&p};
    hipError_t e = hipLaunchCooperativeKernel((const void*)fwd_kernel, dim3(grid), dim3(NTHREADS), args, LDS_BYTES, stream);
    if (e != hipSuccess) fprintf(stderr, "cooperative launch failed: %s (grid %d)\n", hipGetErrorString(e), grid);
#else
    p.ph_lo = 0; p.ph_hi = NPHASE;
    launch_phase<0>(grid, p, stream); launch_phase<1>(grid, p, stream); launch_phase<2>(grid, p, stream); launch_phase<3>(grid, p, stream);
    launch_phase<4>(grid, p, stream); launch_phase<5>(grid, p, stream); launch_phase<6>(grid, p, stream); launch_phase<7>(grid, p, stream);
    launch_phase<8>(grid, p, stream); launch_phase<9>(grid, p, stream); launch_phase<10>(grid, p, stream); launch_phase<11>(grid, p, stream);
#endif
}
```

```cpp
#include <hip/hip_runtime.h>
#include <hip/hip_cooperative_groups.h>
#include <cstdio>
#include <cstdint>
namespace cg = cooperative_groups;

#ifndef ONE_LAUNCH
#define ONE_LAUNCH 1
#endif

typedef unsigned short bf16;
typedef short bf16x8 __attribute__((ext_vector_type(8)));
typedef float f32x4 __attribute__((ext_vector_type(4)));
typedef float f32x16 __attribute__((ext_vector_type(16)));
typedef unsigned u32x2 __attribute__((ext_vector_type(2)));
typedef unsigned u32x4 __attribute__((ext_vector_type(4)));

constexpr int T = 32768, D = 1024, SEQ = 2048, NB = 16;
constexpr int DIN = 3584, DSSM = 512, NGRP = 32, NST = 64, NH = 16, DCONV = 512, CW = 31;
constexpr int NEXP = 32, DFF = 256;
constexpr float LN_EPS = 1e-5f;
constexpr float ALPHA = 1.189207115002721f;
constexpr int NPHASE = 12;
constexpr int NTHREADS = 512;
constexpr int LDS_BYTES = 131072 + 2048, LDS_MISC = 131072;
constexpr int CTL_BAR = 4096;
constexpr size_t CTL_ZERO_BYTES = 65536;

constexpr size_t MiB = 1u << 20;
constexpr size_t WS_CTL = 0;
constexpr size_t WS_TAB = 1 * MiB;
constexpr size_t TAB_BINP = 0, TAB_BGLUP = 16384, TAB_A = 32768, TAB_BB = 65536, TAB_CM = 65536 + 131072;
constexpr size_t WS_WIN = 2 * MiB, WS_WGLU = 9 * MiB, WS_WCOUT = 11 * MiB, WS_WOUT = 12 * MiB, WS_WR = 14 * MiB;
constexpr size_t WS_WGU = 16 * MiB, WS_WD = 48 * MiB;
constexpr size_t WS_M1 = 64 * MiB, WS_PREB = 256 * MiB;
constexpr size_t WS_XB = 64 * MiB, WS_U = 128 * MiB, WS_V = 160 * MiB, WS_YM = 64 * MiB;
constexpr size_t WS_SGS = 192 * MiB, WS_HB = 192 * MiB, WS_SGC = 256 * MiB;
constexpr size_t WS_YG = 320 * MiB, WS_CV = 352 * MiB, WS_MERGED = 384 * MiB;
constexpr size_t WS_HID = 448 * MiB, WS_Z = 488 * MiB, WS_TOK = 496 * MiB, WS_GATE = 500 * MiB, WS_END = 501 * MiB;

struct Params {
    const float* in[32];
    float* out;
    unsigned char* ws;
    int ph_lo, ph_hi;
};

typedef float f32x2_t __attribute__((ext_vector_type(2)));
typedef _Float16 h2_t __attribute__((ext_vector_type(2)));
typedef _Float16 h8_t __attribute__((ext_vector_type(8)));
__device__ __forceinline__ unsigned pk2(float lo, float hi) { const f32x2_t v = {lo, hi}; const h2_t h = __builtin_convertvector(v, h2_t); return __builtin_bit_cast(unsigned, h); }
__device__ __forceinline__ unsigned f2bf(float f) { return pk2(f, 0.f) & 0xffffu; }
__device__ __forceinline__ float bflo(unsigned w) { return (float)__builtin_bit_cast(h2_t, w).x; }
__device__ __forceinline__ float bfhi(unsigned w) { return (float)__builtin_bit_cast(h2_t, w).y; }
__device__ __forceinline__ float bf2f(bf16 b) { return (float)__builtin_bit_cast(_Float16, b); }
__device__ __forceinline__ f32x4 mfma16_h(bf16x8 a, bf16x8 b, f32x4 c, int, int, int) { return __builtin_amdgcn_mfma_f32_16x16x32_f16(__builtin_bit_cast(h8_t, a), __builtin_bit_cast(h8_t, b), c, 0, 0, 0); }
__device__ __forceinline__ f32x16 mfma32_h(bf16x8 a, bf16x8 b, f32x16 c, int, int, int) { return __builtin_amdgcn_mfma_f32_32x32x16_f16(__builtin_bit_cast(h8_t, a), __builtin_bit_cast(h8_t, b), c, 0, 0, 0); }
__device__ __forceinline__ float sigmoidf_(float z) { return __builtin_amdgcn_rcpf(1.0f + __expf(-z)); }
__device__ __forceinline__ float siluf_(float z) { return z * sigmoidf_(z); }
__device__ __forceinline__ float geluf_(float x) { const float z = 1.5957691216057308f * (x + 0.044715f * x * x * x); return x * sigmoidf_(z); }
__device__ __forceinline__ float wave_sum(float v) {
    v += __builtin_bit_cast(float, __builtin_amdgcn_update_dpp(0, __builtin_bit_cast(int, v), 0xB1, 0xF, 0xF, true));
    v += __builtin_bit_cast(float, __builtin_amdgcn_update_dpp(0, __builtin_bit_cast(int, v), 0x4E, 0xF, 0xF, true));
    v += __builtin_bit_cast(float, __builtin_amdgcn_update_dpp(0, __builtin_bit_cast(int, v), 0x141, 0xF, 0xF, true));
    v += __builtin_bit_cast(float, __builtin_amdgcn_update_dpp(0, __builtin_bit_cast(int, v), 0x140, 0xF, 0xF, true));
    const int iv = __builtin_bit_cast(int, v);
    const float r0 = __builtin_bit_cast(float, __builtin_amdgcn_readlane(iv, 0)), r1 = __builtin_bit_cast(float, __builtin_amdgcn_readlane(iv, 16));
    const float r2 = __builtin_bit_cast(float, __builtin_amdgcn_readlane(iv, 32)), r3 = __builtin_bit_cast(float, __builtin_amdgcn_readlane(iv, 48));
    return (r0 + r1) + (r2 + r3);
}
__device__ __forceinline__ void glds16(const void* g, void* l) {
    __builtin_amdgcn_global_load_lds((const __attribute__((address_space(1))) unsigned*)g, (__attribute__((address_space(3))) unsigned*)l, 16, 0, 0);
}

namespace pg8 {
#define PG8_LAS __attribute__((address_space(3)))
typedef unsigned short bf16_t;
typedef short bf16x8 __attribute__((ext_vector_type(8)));
typedef float f32x4 __attribute__((ext_vector_type(4)));
typedef unsigned u32x4 __attribute__((ext_vector_type(4)));
constexpr int BM = 256, BK = 64, HALF = 128, HTB = HALF * BK * 2  , STAGE_BYTES = 8 * HTB, NXCD = 8, WGM = 8;

__host__ __device__ __forceinline__ int lds_byte(int r, int c) { const int st = (r >> 4) * 2 + (c >> 5), rr = r & 15, cc = c & 31, ob = rr * 64 + cc * 2; return st * 1024 + (ob ^ (((ob >> 9) & 1) << 5)); }
__host__ __device__ __forceinline__ void stage_rc(int b, int& R, int& C) { const int st = b / 1024, sb = b % 1024, swz = sb ^ (((sb >> 9) & 1) << 5); R = (st >> 1) * 16 + swz / 64; C = (st & 1) * 32 + (swz % 64) / 2; }
__host__ __device__ __forceinline__ int perm32(int rho) { const int n = rho >> 4, i = rho & 15; return 8 * (i >> 2) + 4 * n + (i & 3); }

struct Unit { int pm, pn; };
struct Gemm { const bf16_t* A; const bf16_t* Bt; int M, N, K; };

struct StaticOrder {
    int nM, nN, nwg, G, c;
    __host__ __device__ void init(int M, int N, int G_, int c_) { nM = M / BM; nN = N / BM; nwg = nM * nN; G = G_; c = c_; }
    __host__ __device__ bool next(int i, Unit& u) const {
        const long L = (long)i * G + c; if (L >= nwg) return false;
        int wgid = (int)L; { const int q = nwg / NXCD, r = nwg % NXCD, xcd = wgid % NXCD, off = wgid / NXCD; wgid = (xcd < r ? xcd * (q + 1) : r * (q + 1) + (xcd - r) * q) + off; }
        const int nig = WGM * nN, gid = wgid / nig, fm = gid * WGM, gsz = (nM - fm) < WGM ? (nM - fm) : WGM;
        u.pm = fm + ((wgid % nig) % gsz); u.pn = (wgid % nig) / gsz; return true;
    }
    __device__ __forceinline__ void a_ready(const Unit&) const {}
    __device__ __forceinline__ void done(const Unit&) const {}
};

__device__ __forceinline__ unsigned pk2_(float lo, float hi) { return ::pk2(lo, hi); }
__device__ __forceinline__ float sg_(float z) { return __builtin_amdgcn_rcpf(1.0f + __expf(-z)); }
__device__ __forceinline__ float lo_(unsigned w) { return ::bflo(w); }
__device__ __forceinline__ float hi_(unsigned w) { return ::bfhi(w); }
typedef unsigned u32x2 __attribute__((ext_vector_type(2)));
struct EpiProj {
    static constexpr bool PERM = true, AFTER_DRAIN = false;
    const float* binp; bf16_t* U; bf16_t* V; bf16_t* SGS; bf16_t* SGC;
    __device__ __forceinline__ void operator()(const f32x4 (&acc)[2][2][4][2], const Unit& u, int wr, int wc, int fr, int fq) const {
        const int row0 = u.pm * BM + wr * 64 + fr, colt = u.pn * BM, c0 = colt + wc * 32 + 8 * fq;
        f32x4 bv[2][2];
#pragma unroll
        for (int bj = 0; bj < 2; ++bj)
#pragma unroll
            for (int n = 0; n < 2; ++n) bv[bj][n] = *(const f32x4*)(binp + c0 + bj * HALF + 4 * n);
#pragma unroll
        for (int ai = 0; ai < 2; ++ai)
#pragma unroll
            for (int m = 0; m < 4; ++m) {
                const size_t row = (size_t)(row0 + ai * HALF + m * 16);
#pragma unroll
                for (int bj = 0; bj < 2; ++bj) {
                    const int c8 = c0 + bj * HALF;
                    const f32x4 v0 = acc[ai][bj][m][0] + bv[bj][0], v1 = acc[ai][bj][m][1] + bv[bj][1];
                    if (colt < 512) {
                        u32x4 w; w.x = pk2_(v0.x, v0.y); w.y = pk2_(v0.z, v0.w); w.z = pk2_(v1.x, v1.y); w.w = pk2_(v1.z, v1.w);
                        *(u32x4*)(U + row * 512 + c8) = w;
                    } else if (colt < 1536) {
                        if (bj == 0) {
                            const f32x4 g0 = acc[ai][1][m][0] + bv[1][0], g1 = acc[ai][1][m][1] + bv[1][1];
                            u32x4 w; w.x = pk2_(v0.x * sg_(g0.x), v0.y * sg_(g0.y)); w.y = pk2_(v0.z * sg_(g0.z), v0.w * sg_(g0.w));
                            w.z = pk2_(v1.x * sg_(g1.x), v1.y * sg_(g1.y)); w.w = pk2_(v1.z * sg_(g1.z), v1.w * sg_(g1.w));
                            *(u32x4*)(V + row * 512 + ((colt - 512) >> 1) + wc * 32 + 8 * fq) = w;
                        }
                    } else {
                        u32x4 w; w.x = pk2_(sg_(v0.x), sg_(v0.y)); w.y = pk2_(sg_(v0.z), sg_(v0.w)); w.z = pk2_(sg_(v1.x), sg_(v1.y)); w.w = pk2_(sg_(v1.z), sg_(v1.w));
                        if (colt < 2560) *(u32x4*)(SGS + row * 1024 + (c8 - 1536)) = w; else *(u32x4*)(SGC + row * 1024 + (c8 - 2560)) = w;
                    }
                }
            }
    }
};
struct EpiCout {
    static constexpr bool PERM = true, AFTER_DRAIN = false;
    const float* bias; const bf16_t* SGC; bf16_t* M1;
    __device__ __forceinline__ void operator()(const f32x4 (&acc)[2][2][4][2], const Unit& u, int wr, int wc, int fr, int fq) const {
        const int row0 = u.pm * BM + wr * 64 + fr, c0 = u.pn * BM + wc * 32 + 8 * fq;
        f32x4 bv[2][2];
#pragma unroll
        for (int bj = 0; bj < 2; ++bj)
#pragma unroll
            for (int n = 0; n < 2; ++n) bv[bj][n] = *(const f32x4*)(bias + c0 + bj * HALF + 4 * n);
#pragma unroll
        for (int ai = 0; ai < 2; ++ai) {
            u32x4 gv[4][2];
#pragma unroll
            for (int m = 0; m < 4; ++m)
#pragma unroll
                for (int bj = 0; bj < 2; ++bj) gv[m][bj] = *(const u32x4*)(SGC + (size_t)(row0 + ai * HALF + m * 16) * 1024 + c0 + bj * HALF);
            asm volatile("" ::: "memory");
#pragma unroll
            for (int m = 0; m < 4; ++m) {
                const size_t row = (size_t)(row0 + ai * HALF + m * 16);
#pragma unroll
                for (int bj = 0; bj < 2; ++bj) {
                    const int c8 = c0 + bj * HALF;
                    const f32x4 v0 = acc[ai][bj][m][0] + bv[bj][0], v1 = acc[ai][bj][m][1] + bv[bj][1];
                    const u32x4 g = gv[m][bj];
                    u32x4 w; w.x = pk2_(v0.x * lo_(g.x), v0.y * hi_(g.x)); w.y = pk2_(v0.z * lo_(g.y), v0.w * hi_(g.y));
                    w.z = pk2_(v1.x * lo_(g.z), v1.y * hi_(g.z)); w.w = pk2_(v1.z * lo_(g.w), v1.w * hi_(g.w));
                    *(u32x4*)(M1 + row * 1024 + c8) = w;
                }
            }
            asm volatile("" ::: "memory");
        }
    }
};
struct EpiGlu {
    static constexpr bool PERM = true, AFTER_DRAIN = false;
    const float* bglup; const bf16_t* SGS; const bf16_t* M1; bf16_t* MERGED;
    __device__ __forceinline__ void operator()(const f32x4 (&acc)[2][2][4][2], const Unit& u, int wr, int wc, int fr, int fq) const {
        const int row0 = u.pm * BM + wr * 64 + fr, c0 = u.pn * BM + wc * 32 + 8 * fq, mc = u.pn * HALF + wc * 32 + 8 * fq;
        f32x4 bv[2][2];
#pragma unroll
        for (int bj = 0; bj < 2; ++bj)
#pragma unroll
            for (int n = 0; n < 2; ++n) bv[bj][n] = *(const f32x4*)(bglup + c0 + bj * HALF + 4 * n);
#pragma unroll
        for (int ai = 0; ai < 2; ++ai) {
            u32x4 gv[4], qv[4];
#pragma unroll
            for (int m = 0; m < 4; ++m) {
                const size_t off = (size_t)(row0 + ai * HALF + m * 16) * 1024 + mc;
                gv[m] = *(const u32x4*)(SGS + off); qv[m] = *(const u32x4*)(M1 + off);
            }
            asm volatile("" ::: "memory");
#pragma unroll
            for (int m = 0; m < 4; ++m) {
                const size_t off = (size_t)(row0 + ai * HALF + m * 16) * 1024 + mc;
                const f32x4 a0 = acc[ai][0][m][0] + bv[0][0], a1 = acc[ai][0][m][1] + bv[0][1];
                const f32x4 b0 = acc[ai][1][m][0] + bv[1][0], b1 = acc[ai][1][m][1] + bv[1][1];
                const u32x4 g = gv[m], q = qv[m];
                u32x4 w;
                w.x = pk2_(lo_(q.x) + lo_(g.x) * (a0.x * sg_(b0.x)), hi_(q.x) + hi_(g.x) * (a0.y * sg_(b0.y)));
                w.y = pk2_(lo_(q.y) + lo_(g.y) * (a0.z * sg_(b0.z)), hi_(q.y) + hi_(g.y) * (a0.w * sg_(b0.w)));
                w.z = pk2_(lo_(q.z) + lo_(g.z) * (a1.x * sg_(b1.x)), hi_(q.z) + hi_(g.z) * (a1.y * sg_(b1.y)));
                w.w = pk2_(lo_(q.w) + lo_(g.w) * (a1.z * sg_(b1.z)), hi_(q.w) + hi_(g.w) * (a1.w * sg_(b1.w)));
                *(u32x4*)(MERGED + off) = w;
            }
            asm volatile("" ::: "memory");
        }
    }
};
struct TripleOrder {
    StaticOrder so;
    __device__ __forceinline__ bool next(int i, Unit& u) const {
        const int tr = i / 3, sub = i - tr * 3; Unit v;
        if (!so.next(tr, v)) return false;
        if (sub == 0) { u.pm = 128 + v.pm; u.pn = 8 + v.pn; } else { u.pm = v.pm; u.pn = 2 * v.pn + sub - 1; }
        return true;
    }
    __device__ __forceinline__ void a_ready(const Unit&) const {}
    __device__ __forceinline__ void done(const Unit&) const {}
};
struct EpiCG {
    static constexpr bool PERM = true, AFTER_DRAIN = false;
    EpiCout c; EpiGlu g;
    __device__ __forceinline__ void operator()(const f32x4 (&acc)[2][2][4][2], const Unit& u, int wr, int wc, int fr, int fq) const {
        if (u.pm >= 128) { const Unit v{u.pm - 128, u.pn - 8}; c(acc, v, wr, wc, fr, fq); }
        else g(acc, u, wr, wc, fr, fq);
    }
};
struct EpiOut {
    static constexpr bool PERM = true, AFTER_DRAIN = false;
    const float* bias; const float* X; bf16_t* PREB; float alpha;
    __device__ __forceinline__ void operator()(const f32x4 (&acc)[2][2][4][2], const Unit& u, int wr, int wc, int fr, int fq) const {
        const int row0 = u.pm * BM + wr * 64 + fr, c0 = u.pn * BM + wc * 32 + 8 * fq;
        f32x4 bv[2][2];
#pragma unroll
        for (int bj = 0; bj < 2; ++bj)
#pragma unroll
            for (int n = 0; n < 2; ++n) bv[bj][n] = *(const f32x4*)(bias + c0 + bj * HALF + 4 * n);
#pragma unroll
        for (int ai = 0; ai < 2; ++ai) {
            f32x4 xv[4][2][2];
#pragma unroll
            for (int m = 0; m < 4; ++m)
#pragma unroll
                for (int bj = 0; bj < 2; ++bj) {
                    const float* xp = X + (size_t)(row0 + ai * HALF + m * 16) * 1024 + c0 + bj * HALF;
                    xv[m][bj][0] = *(const f32x4*)xp; xv[m][bj][1] = *(const f32x4*)(xp + 4);
                }
            asm volatile("" ::: "memory");
#pragma unroll
            for (int m = 0; m < 4; ++m) {
                const size_t off = (size_t)(row0 + ai * HALF + m * 16) * 1024 + c0;
#pragma unroll
                for (int bj = 0; bj < 2; ++bj) {
                    const f32x4 v0 = acc[ai][bj][m][0] + bv[bj][0] + xv[m][bj][0] * alpha, v1 = acc[ai][bj][m][1] + bv[bj][1] + xv[m][bj][1] * alpha;
                    u32x4 w; w.x = pk2_(v0.x, v0.y); w.y = pk2_(v0.z, v0.w); w.z = pk2_(v1.x, v1.y); w.w = pk2_(v1.z, v1.w);
                    *(u32x4*)(PREB + off + bj * HALF) = w;
                }
            }
            asm volatile("" ::: "memory");
        }
    }
};

struct MoeOrder {
    const PG8_LAS int* tab; int G, c, sh;
    __device__ __forceinline__ bool next(int i, Unit& u) const {
        const int L = i * G + c;
        if (L >= __builtin_amdgcn_readfirstlane(tab[32])) return false;
        int e = 0;
#pragma unroll 1
        while (L >= __builtin_amdgcn_readfirstlane(tab[e + 1])) ++e;
        const int ll = L - __builtin_amdgcn_readfirstlane(tab[e]);
        u.pm = __builtin_amdgcn_readfirstlane(tab[64 + e]) + (ll >> sh); u.pn = (e << sh) + (ll & ((1 << sh) - 1)); return true;
    }
    __device__ __forceinline__ void a_ready(const Unit&) const {}
    __device__ __forceinline__ void done(const Unit&) const {}
};
struct EpiDownP {
    static constexpr bool PERM = true, AFTER_DRAIN = false;
    const PG8_LAS int* tab; const int* TOK; const float* GATE; bf16_t* YM; bf16_t* dump; int Ttok;
    __device__ __forceinline__ void operator()(const f32x4 (&acc)[2][2][4][2], const Unit& u, int wr, int wc, int fr, int fq) const {
        const int e = u.pn >> 2, j = u.pn & 3;
        const int cnt = __builtin_amdgcn_readfirstlane(tab[128 + e]), idx0 = (u.pm - __builtin_amdgcn_readfirstlane(tab[64 + e])) * BM + wr * 64 + fr;
        const int* tl = TOK + (size_t)e * Ttok;
        const int c0 = j * BM + wc * 32 + 8 * fq;
        int entv[2][4]; float gtv[2][4];
#pragma unroll
        for (int ai = 0; ai < 2; ++ai)
#pragma unroll
            for (int m = 0; m < 4; ++m) { const int idx = idx0 + ai * HALF + m * 16; entv[ai][m] = tl[idx < cnt ? idx : 0]; }
#pragma unroll
        for (int ai = 0; ai < 2; ++ai)
#pragma unroll
            for (int m = 0; m < 4; ++m) gtv[ai][m] = GATE[entv[ai][m]];
        asm volatile("" ::: "memory");
#pragma unroll
        for (int ai = 0; ai < 2; ++ai)
#pragma unroll
            for (int m = 0; m < 4; ++m) {
                const int idx = idx0 + ai * HALF + m * 16;
                const bool ok = idx < cnt;
                const int ent = entv[ai][m];
                const float g = gtv[ai][m];
                bf16_t* const dst = (ok ? YM + (size_t)ent * 1024 : dump) + c0;
#pragma unroll
                for (int bj = 0; bj < 2; ++bj) {
                    const f32x4 v0 = acc[ai][bj][m][0] * g, v1 = acc[ai][bj][m][1] * g;
                    u32x4 w; w.x = pk2_(v0.x, v0.y); w.y = pk2_(v0.z, v0.w); w.z = pk2_(v1.x, v1.y); w.w = pk2_(v1.z, v1.w);
                    *(u32x4*)(dst + bj * HALF) = w;
                }
                asm volatile("" ::: "memory");
            }
    }
};

struct MoeRows {
    const PG8_LAS int* tab; const int* TOK; int Ttok; unsigned rowbytes;
    __device__ __forceinline__ unsigned rowoff(const Unit& u, int h, int R) const {
        const int e = u.pn >> 1;
        const int idx = (u.pm - __builtin_amdgcn_readfirstlane(tab[64 + e])) * BM + h * HALF + R;
        const int tok = idx < __builtin_amdgcn_readfirstlane(tab[128 + e]) ? (TOK[(size_t)e * Ttok + idx] >> 1) : 0;
        return (unsigned)tok * rowbytes;
    }
};
struct EpiGUP {
    static constexpr bool PERM = true, AFTER_DRAIN = false;
    bf16_t* HID;
    __device__ __forceinline__ void operator()(const f32x4 (&acc)[2][2][4][2], const Unit& u, int wr, int wc, int fr, int fq) const {
        const int row0 = u.pm * BM + wr * 64 + fr, hc = (u.pn & 1) * HALF + wc * 32 + 8 * fq;
#pragma unroll
        for (int ai = 0; ai < 2; ++ai)
#pragma unroll
            for (int m = 0; m < 4; ++m) {
                const size_t row = (size_t)(row0 + ai * HALF + m * 16);
                const f32x4 g0 = acc[ai][0][m][0], g1 = acc[ai][0][m][1], u0 = acc[ai][1][m][0], u1 = acc[ai][1][m][1];
                u32x4 w; w.x = pk2_(g0.x * sg_(g0.x) * u0.x, g0.y * sg_(g0.y) * u0.y); w.y = pk2_(g0.z * sg_(g0.z) * u0.z, g0.w * sg_(g0.w) * u0.w);
                w.z = pk2_(g1.x * sg_(g1.x) * u1.x, g1.y * sg_(g1.y) * u1.y); w.w = pk2_(g1.z * sg_(g1.z) * u1.z, g1.w * sg_(g1.w) * u1.w);
                *(u32x4*)(HID + row * 256 + hc) = w;
            }
    }
};

template <class Epi, class Sched, bool ALIGN_EPI = false, bool SP2 = false>
__device__ __forceinline__ void gemm_phase(PG8_LAS unsigned char* lds, const Gemm g, const Sched& S, const Epi& E) {
    int tid_ = threadIdx.x; asm volatile("" : "+v"(tid_));
    const int tid = tid_, wid = __builtin_amdgcn_readfirstlane(tid >> 6), lane = tid & 63, wr = wid >> 2, wc = wid & 3, fr = lane & 15, fq = lane >> 4;
    const int K = g.K, nt = K / BK;
    unsigned voffA[2], voffB[2];
#pragma unroll
    for (int i = 0; i < 2; ++i) { int R, C; stage_rc(tid * 16 + i * 8192, R, C); const int Rb = Epi::PERM ? ((R & ~31) + perm32(R & 31)) : R;
        voffA[i] = (unsigned)(R * K + C) * 2u; voffB[i] = (unsigned)(Rb * K + C) * 2u; }
    const size_t kstep = (size_t)(BK * 2);
    const size_t hstep = (size_t)HALF * K * 2;
    const size_t tstep = 2 * hstep;
    const unsigned ldsw = (unsigned)wid * 1024u;
    const int aoff = lds_byte(wr * 64 + fr, fq * 8), boff = lds_byte(wc * 32 + fr, fq * 8);
#define PG8_SA(b, h) (((b) * 2 + (h)) * HTB)
#define PG8_SB(b, h) ((4 + (b) * 2 + (h)) * HTB)
#define PG8_STAGE(bufoff, gbase, voff) do { _Pragma("unroll") for (int _i = 0; _i < 2; ++_i) \
        __builtin_amdgcn_global_load_lds((const unsigned*)((const char*)(gbase) + (voff)[_i]), (PG8_LAS unsigned*)(lds + (bufoff) + ldsw + _i * 8192), 16, 0, 0); } while (0)
#define PG8_LDA(dst, b, h) do { _Pragma("unroll") for (int m = 0; m < 4; ++m) _Pragma("unroll") for (int k = 0; k < 2; ++k) dst[m][k] = *(const PG8_LAS bf16x8*)(lds + PG8_SA(b, h) + aoff + m * 2048 + k * 1024); } while (0)
#define PG8_LDB(dst, b, h) do { _Pragma("unroll") for (int n = 0; n < 2; ++n) _Pragma("unroll") for (int k = 0; k < 2; ++k) dst[n][k] = *(const PG8_LAS bf16x8*)(lds + PG8_SB(b, h) + boff + n * 2048 + k * 1024); } while (0)
#define PG8_MMA(ai, bj, At, Bt) do { __builtin_amdgcn_s_setprio(1); _Pragma("unroll") for (int m = 0; m < 4; ++m) _Pragma("unroll") for (int n = 0; n < 2; ++n) _Pragma("unroll") for (int k = 0; k < 2; ++k) \
        acc[ai][bj][m][n] = mfma16_h(Bt[n][k], At[m][k], acc[ai][bj][m][n], 0, 0, 0); __builtin_amdgcn_s_setprio(0); } while (0)
#define PG8_WAIT_V(n) asm volatile("s_waitcnt vmcnt(" #n ")" ::: "memory")
#define PG8_WAIT_L(n) asm volatile("s_waitcnt lgkmcnt(" #n ")" ::: "memory")
#define PG8_BAR __builtin_amdgcn_s_barrier()
#define PG8_SCHED __builtin_amdgcn_sched_barrier(0)
    Unit cur, nxt; int ui = 0;
    if (!S.next(0, cur)) return;
    f32x4 acc[2][2][4][2];
#pragma unroll
    for (int a = 0; a < 2; ++a)
#pragma unroll
        for (int b = 0; b < 2; ++b)
#pragma unroll
            for (int m = 0; m < 4; ++m)
#pragma unroll
                for (int n = 0; n < 2; ++n) acc[a][b][m][n] = (f32x4){0.f, 0.f, 0.f, 0.f};
    bf16x8 At[4][2], B0[2][2], B1[2][2];
    const char* cA = (const char*)g.A + (size_t)cur.pm * tstep; const char* cB = (const char*)g.Bt + (size_t)cur.pn * tstep;
    S.a_ready(cur);
    if constexpr (SP2) {
        PG8_STAGE(PG8_SB(0, 0), cB, voffB); PG8_STAGE(PG8_SB(0, 1), cB + hstep, voffB); PG8_STAGE(PG8_SA(0, 0), cA, voffA); PG8_STAGE(PG8_SA(0, 1), cA + hstep, voffA);
        if (wr == 1) PG8_BAR;
        PG8_WAIT_V(2); PG8_BAR;
        PG8_STAGE(PG8_SB(1, 0), cB + kstep, voffB); PG8_STAGE(PG8_SA(1, 0), cA + kstep, voffA); PG8_STAGE(PG8_SB(1, 1), cB + hstep + kstep, voffB);
        PG8_WAIT_V(6); PG8_BAR;
    } else {
        PG8_STAGE(PG8_SB(0, 0), cB, voffB); PG8_STAGE(PG8_SA(0, 0), cA, voffA); PG8_STAGE(PG8_SB(0, 1), cB + hstep, voffB); PG8_STAGE(PG8_SA(0, 1), cA + hstep, voffA);
        if (wr == 1) PG8_BAR;
        PG8_WAIT_V(4); PG8_BAR;
        PG8_STAGE(PG8_SB(1, 0), cB + kstep, voffB); PG8_STAGE(PG8_SA(1, 0), cA + kstep, voffA); PG8_STAGE(PG8_SB(1, 1), cB + hstep + kstep, voffB);
        PG8_WAIT_V(6); PG8_BAR;
    }
    for (;;) {
        const bool has_next = S.next(ui + 1, nxt);
        const char* nA = has_next ? (const char*)g.A + (size_t)nxt.pm * tstep : cA; const char* nB = has_next ? (const char*)g.Bt + (size_t)nxt.pn * tstep : cB;
        for (int t = 0; t < nt; t += 2) {
            const bool last = (t == nt - 2);
            const char* a1 = cA + (size_t)(t + 1) * kstep;
            const char* a2 = last ? nA : cA + (size_t)(t + 2) * kstep; const char* b2 = last ? nB : cB + (size_t)(t + 2) * kstep;
            const char* a3 = a2 + kstep; const char* b3 = b2 + kstep;
            if (last && has_next) S.a_ready(nxt);
            if constexpr (SP2) {
            PG8_LDB(B0, 0, 0); PG8_LDB(B1, 0, 1); PG8_SCHED; PG8_LDA(At, 0, 0); PG8_STAGE(PG8_SA(1, 1), a1 + hstep, voffA);
            PG8_WAIT_V(8); PG8_WAIT_L(0); PG8_BAR; PG8_MMA(0, 0, At, B0); PG8_MMA(0, 1, At, B1); PG8_BAR; PG8_SCHED;
            PG8_LDA(At, 0, 1); PG8_STAGE(PG8_SB(0, 0), b2, voffB); PG8_STAGE(PG8_SB(0, 1), b2 + hstep, voffB); PG8_STAGE(PG8_SA(0, 0), a2, voffA);
            PG8_WAIT_V(8); PG8_WAIT_L(0); PG8_BAR; PG8_MMA(1, 0, At, B0); PG8_MMA(1, 1, At, B1); PG8_BAR; PG8_SCHED;
            PG8_LDB(B0, 1, 0); PG8_LDB(B1, 1, 1); PG8_SCHED; PG8_LDA(At, 1, 0); PG8_STAGE(PG8_SA(0, 1), a2 + hstep, voffA);
            PG8_WAIT_V(8); PG8_WAIT_L(0); PG8_BAR; PG8_MMA(0, 0, At, B0); PG8_MMA(0, 1, At, B1); PG8_BAR; PG8_SCHED;
            PG8_LDA(At, 1, 1); PG8_STAGE(PG8_SB(1, 0), b3, voffB); PG8_STAGE(PG8_SB(1, 1), b3 + hstep, voffB); PG8_STAGE(PG8_SA(1, 0), a3, voffA);
            PG8_WAIT_V(8); PG8_WAIT_L(0); PG8_BAR; PG8_MMA(1, 0, At, B0); PG8_MMA(1, 1, At, B1); PG8_BAR; PG8_SCHED;
            } else {
            PG8_LDB(B0, 0, 0); PG8_SCHED; PG8_LDA(At, 0, 0); PG8_STAGE(PG8_SA(1, 1), a1 + hstep, voffA);
            PG8_WAIT_L(8); PG8_BAR; PG8_WAIT_L(0); PG8_MMA(0, 0, At, B0); PG8_BAR; PG8_SCHED;
            PG8_LDB(B1, 0, 1); PG8_STAGE(PG8_SB(0, 0), b2, voffB);
            PG8_BAR; PG8_WAIT_L(0); PG8_MMA(0, 1, At, B1); PG8_BAR;
            PG8_LDA(At, 0, 1); PG8_STAGE(PG8_SA(0, 0), a2, voffA);
            PG8_BAR; PG8_WAIT_L(0); PG8_MMA(1, 0, At, B0); PG8_BAR; PG8_SCHED;
            PG8_STAGE(PG8_SB(0, 1), b2 + hstep, voffB);
            PG8_WAIT_V(6); PG8_BAR; PG8_MMA(1, 1, At, B1); PG8_BAR;
            PG8_LDB(B0, 1, 0); PG8_SCHED; PG8_LDA(At, 1, 0); PG8_STAGE(PG8_SA(0, 1), a2 + hstep, voffA);
            PG8_WAIT_L(8); PG8_BAR; PG8_WAIT_L(0); PG8_MMA(0, 0, At, B0); PG8_BAR; PG8_SCHED;
            PG8_LDB(B1, 1, 1); PG8_STAGE(PG8_SB(1, 0), b3, voffB);
            PG8_BAR; PG8_WAIT_L(0); PG8_MMA(0, 1, At, B1); PG8_BAR;
            PG8_LDA(At, 1, 1); PG8_STAGE(PG8_SA(1, 0), a3, voffA);
            PG8_BAR; PG8_WAIT_L(0); PG8_MMA(1, 0, At, B0); PG8_BAR; PG8_SCHED;
            PG8_STAGE(PG8_SB(1, 1), b3 + hstep, voffB);
            PG8_WAIT_V(6); PG8_BAR; PG8_MMA(1, 1, At, B1); PG8_BAR;
            }
        }
        if constexpr (ALIGN_EPI) { if (wr == 0) PG8_BAR; }
        if constexpr (!Epi::AFTER_DRAIN) { E(acc, cur, wr, wc, fr, fq); S.done(cur); }
        if (!has_next) break;
#pragma unroll
        for (int a = 0; a < 2; ++a)
#pragma unroll
            for (int b = 0; b < 2; ++b)
#pragma unroll
                for (int m = 0; m < 4; ++m)
#pragma unroll
                    for (int n = 0; n < 2; ++n) acc[a][b][m][n] = (f32x4){0.f, 0.f, 0.f, 0.f};
        cur = nxt; cA = nA; cB = nB; ++ui;
        if constexpr (ALIGN_EPI) { if (wr == 1) PG8_BAR; }
    }
    PG8_WAIT_V(0);
    if constexpr (!ALIGN_EPI) { if (wr == 0) PG8_BAR; }
    PG8_BAR;
    if constexpr (Epi::AFTER_DRAIN) { E.fused(acc, cur, wr, wc, fr, fq, lds, wid, lane); S.done(cur); }
#undef PG8_SA
#undef PG8_SB
#undef PG8_STAGE
#undef PG8_LDA
#undef PG8_LDB
#undef PG8_MMA
#undef PG8_WAIT_V
#undef PG8_WAIT_L
#undef PG8_BAR
#undef PG8_SCHED
}
template <class Epi, class Sched, class Rows>
__device__ __forceinline__ void gemm_phase_gather(PG8_LAS unsigned char* lds, const Gemm g, const Sched& S, const Epi& E, const Rows& rows) {
    constexpr bool ALIGN_EPI = true, SP2 = true;
    int tid_ = threadIdx.x; asm volatile("" : "+v"(tid_));
    const int tid = tid_, wid = __builtin_amdgcn_readfirstlane(tid >> 6), lane = tid & 63, wr = wid >> 2, wc = wid & 3, fr = lane & 15, fq = lane >> 4;
    const int K = g.K, nt = K / BK;
    unsigned voffB[2], cofs[2]; int RA[2];
#pragma unroll
    for (int i = 0; i < 2; ++i) { int R, C; stage_rc(tid * 16 + i * 8192, R, C); const int Rb = Epi::PERM ? ((R & ~31) + perm32(R & 31)) : R;
        RA[i] = R; cofs[i] = (unsigned)C * 2u; voffB[i] = (unsigned)(Rb * K + C) * 2u; }
    unsigned vC[2][2], vN[2][2];
#define PG8_LOADOFFS(v, un) do { _Pragma("unroll") for (int _h = 0; _h < 2; ++_h) _Pragma("unroll") for (int _i = 0; _i < 2; ++_i) (v)[_h][_i] = rows.rowoff((un), _h, RA[_i]) + cofs[_i]; } while (0)
    const size_t kstep = (size_t)(BK * 2);
    const size_t hstep = (size_t)HALF * K * 2;
    const size_t tstep = 2 * hstep;
    const unsigned ldsw = (unsigned)wid * 1024u;
    const int aoff = lds_byte(wr * 64 + fr, fq * 8), boff = lds_byte(wc * 32 + fr, fq * 8);
#define PG8_SA(b, h) (((b) * 2 + (h)) * HTB)
#define PG8_SB(b, h) ((4 + (b) * 2 + (h)) * HTB)
#define PG8_STAGE(bufoff, gbase, voff) do { _Pragma("unroll") for (int _i = 0; _i < 2; ++_i) \
        __builtin_amdgcn_global_load_lds((const unsigned*)((const char*)(gbase) + (voff)[_i]), (PG8_LAS unsigned*)(lds + (bufoff) + ldsw + _i * 8192), 16, 0, 0); } while (0)
#define PG8_LDA(dst, b, h) do { _Pragma("unroll") for (int m = 0; m < 4; ++m) _Pragma("unroll") for (int k = 0; k < 2; ++k) dst[m][k] = *(const PG8_LAS bf16x8*)(lds + PG8_SA(b, h) + aoff + m * 2048 + k * 1024); } while (0)
#define PG8_LDB(dst, b, h) do { _Pragma("unroll") for (int n = 0; n < 2; ++n) _Pragma("unroll") for (int k = 0; k < 2; ++k) dst[n][k] = *(const PG8_LAS bf16x8*)(lds + PG8_SB(b, h) + boff + n * 2048 + k * 1024); } while (0)
#define PG8_MMA(ai, bj, At, Bt) do { __builtin_amdgcn_s_setprio(1); _Pragma("unroll") for (int m = 0; m < 4; ++m) _Pragma("unroll") for (int n = 0; n < 2; ++n) _Pragma("unroll") for (int k = 0; k < 2; ++k) \
        acc[ai][bj][m][n] = mfma16_h(Bt[n][k], At[m][k], acc[ai][bj][m][n], 0, 0, 0); __builtin_amdgcn_s_setprio(0); } while (0)
#define PG8_WAIT_V(n) asm volatile("s_waitcnt vmcnt(" #n ")" ::: "memory")
#define PG8_WAIT_L(n) asm volatile("s_waitcnt lgkmcnt(" #n ")" ::: "memory")
#define PG8_BAR __builtin_amdgcn_s_barrier()
#define PG8_SCHED __builtin_amdgcn_sched_barrier(0)
    Unit cur, nxt; int ui = 0;
    if (!S.next(0, cur)) return;
    f32x4 acc[2][2][4][2];
#pragma unroll
    for (int a = 0; a < 2; ++a)
#pragma unroll
        for (int b = 0; b < 2; ++b)
#pragma unroll
            for (int m = 0; m < 4; ++m)
#pragma unroll
                for (int n = 0; n < 2; ++n) acc[a][b][m][n] = (f32x4){0.f, 0.f, 0.f, 0.f};
    bf16x8 At[4][2], B0[2][2], B1[2][2];
    const char* const Ab = (const char*)g.A; const char* cB = (const char*)g.Bt + (size_t)cur.pn * tstep;
    PG8_LOADOFFS(vC, cur);
    S.a_ready(cur);
    if constexpr (SP2) {
        PG8_STAGE(PG8_SB(0, 0), cB, voffB); PG8_STAGE(PG8_SB(0, 1), cB + hstep, voffB); PG8_STAGE(PG8_SA(0, 0), Ab, vC[0]); PG8_STAGE(PG8_SA(0, 1), Ab, vC[1]);
        if (wr == 1) PG8_BAR;
        PG8_WAIT_V(2); PG8_BAR;
        PG8_STAGE(PG8_SB(1, 0), cB + kstep, voffB); PG8_STAGE(PG8_SA(1, 0), Ab + kstep, vC[0]); PG8_STAGE(PG8_SB(1, 1), cB + hstep + kstep, voffB);
        PG8_WAIT_V(6); PG8_BAR;
    }
    for (;;) {
        const bool has_next = S.next(ui + 1, nxt);
        const char* nB = has_next ? (const char*)g.Bt + (size_t)nxt.pn * tstep : cB;
        if (has_next) { PG8_LOADOFFS(vN, nxt); } else { vN[0][0] = vC[0][0]; vN[0][1] = vC[0][1]; vN[1][0] = vC[1][0]; vN[1][1] = vC[1][1]; }
        for (int t = 0; t < nt; t += 2) {
            const bool last = (t == nt - 2);
            const char* a1 = Ab + (size_t)(t + 1) * kstep;
            const char* a2 = last ? Ab : Ab + (size_t)(t + 2) * kstep; const char* b2 = last ? nB : cB + (size_t)(t + 2) * kstep;
            const char* a3 = a2 + kstep; const char* b3 = b2 + kstep;
            unsigned s2h0[2], s2h1[2]; s2h0[0] = last ? vN[0][0] : vC[0][0]; s2h0[1] = last ? vN[0][1] : vC[0][1]; s2h1[0] = last ? vN[1][0] : vC[1][0]; s2h1[1] = last ? vN[1][1] : vC[1][1];
            if (last && has_next) S.a_ready(nxt);
            if constexpr (SP2) {
            PG8_LDB(B0, 0, 0); PG8_LDB(B1, 0, 1); PG8_SCHED; PG8_LDA(At, 0, 0); PG8_STAGE(PG8_SA(1, 1), a1, vC[1]);
            PG8_WAIT_V(8); PG8_WAIT_L(0); PG8_BAR; PG8_MMA(0, 0, At, B0); PG8_MMA(0, 1, At, B1); PG8_BAR; PG8_SCHED;
            PG8_LDA(At, 0, 1); PG8_STAGE(PG8_SB(0, 0), b2, voffB); PG8_STAGE(PG8_SB(0, 1), b2 + hstep, voffB); PG8_STAGE(PG8_SA(0, 0), a2, s2h0);
            PG8_WAIT_V(8); PG8_WAIT_L(0); PG8_BAR; PG8_MMA(1, 0, At, B0); PG8_MMA(1, 1, At, B1); PG8_BAR; PG8_SCHED;
            PG8_LDB(B0, 1, 0); PG8_LDB(B1, 1, 1); PG8_SCHED; PG8_LDA(At, 1, 0); PG8_STAGE(PG8_SA(0, 1), a2, s2h1);
            PG8_WAIT_V(8); PG8_WAIT_L(0); PG8_BAR; PG8_MMA(0, 0, At, B0); PG8_MMA(0, 1, At, B1); PG8_BAR; PG8_SCHED;
            PG8_LDA(At, 1, 1); PG8_STAGE(PG8_SB(1, 0), b3, voffB); PG8_STAGE(PG8_SB(1, 1), b3 + hstep, voffB); PG8_STAGE(PG8_SA(1, 0), a3, s2h0);
            PG8_WAIT_V(8); PG8_WAIT_L(0); PG8_BAR; PG8_MMA(1, 0, At, B0); PG8_MMA(1, 1, At, B1); PG8_BAR; PG8_SCHED;
            }
        }
        if constexpr (ALIGN_EPI) { if (wr == 0) PG8_BAR; }
        if constexpr (!Epi::AFTER_DRAIN) { E(acc, cur, wr, wc, fr, fq); S.done(cur); }
        if (!has_next) break;
#pragma unroll
        for (int a = 0; a < 2; ++a)
#pragma unroll
            for (int b = 0; b < 2; ++b)
#pragma unroll
                for (int m = 0; m < 4; ++m)
#pragma unroll
                    for (int n = 0; n < 2; ++n) acc[a][b][m][n] = (f32x4){0.f, 0.f, 0.f, 0.f};
        cur = nxt; cB = nB; ++ui; vC[0][0] = vN[0][0]; vC[0][1] = vN[0][1]; vC[1][0] = vN[1][0]; vC[1][1] = vN[1][1];
        if constexpr (ALIGN_EPI) { if (wr == 1) PG8_BAR; }
    }
    PG8_WAIT_V(0);
    if constexpr (!ALIGN_EPI) { if (wr == 0) PG8_BAR; }
    PG8_BAR;
    if constexpr (Epi::AFTER_DRAIN) { E.fused(acc, cur, wr, wc, fr, fq, lds, wid, lane); S.done(cur); }
#undef PG8_LOADOFFS
#undef PG8_SA
#undef PG8_SB
#undef PG8_STAGE
#undef PG8_LDA
#undef PG8_LDB
#undef PG8_MMA
#undef PG8_WAIT_V
#undef PG8_WAIT_L
#undef PG8_BAR
#undef PG8_SCHED
}
}

template <int NI, class RowPtr, class Epi>
__device__ __forceinline__ void gemm_tile(unsigned char* lds, const RowPtr& rowptr, const bf16* Bt, const int K, const Epi& epi) {
    const int tid = threadIdx.x, lane = tid & 63, wave = tid >> 6, wm = wave >> 2, wn = wave & 3, fr = lane & 15, fq = lane >> 4;
    const int sr = tid >> 3, cp = tid & 7;
    const int sw = (cp ^ (sr & 7)) << 3;
    const bf16* ap0 = rowptr(sr) + sw;
    const bf16* ap1 = rowptr(sr + 64) + sw;
    const bf16* bp = Bt + (size_t)sr * K + sw;
    const size_t bstep = (size_t)64 * K;
    f32x4 acc[4][NI];
#pragma unroll
    for (int i = 0; i < 4; ++i)
#pragma unroll
        for (int j = 0; j < NI; ++j) acc[i][j] = (f32x4){0.f, 0.f, 0.f, 0.f};
    const int nt = K >> 6;
    {
        unsigned char* Ab = lds; unsigned char* Bb = lds + 16384;
        glds16(ap0, Ab + tid * 16); glds16(ap1, Ab + 8192 + tid * 16);
#pragma unroll
        for (int i = 0; i < NI; ++i) glds16(bp + i * bstep, Bb + i * 8192 + tid * 16);
    }
    const int aoff = (wm * 64 + fr) * 128, boff = (wn * 16 * NI + fr) * 128;
    for (int kt = 0; kt < nt; ++kt) {
        asm volatile("s_waitcnt vmcnt(0)" ::: "memory");
        __syncthreads();
        if (kt + 1 < nt) {
            unsigned char* Ab = lds + ((kt + 1) & 1) * 49152; unsigned char* Bb = Ab + 16384;
            const int ko = (kt + 1) * 64;
            glds16(ap0 + ko, Ab + tid * 16); glds16(ap1 + ko, Ab + 8192 + tid * 16);
#pragma unroll
            for (int i = 0; i < NI; ++i) glds16(bp + i * bstep + ko, Bb + i * 8192 + tid * 16);
        }
        const unsigned char* Ab = lds + (kt & 1) * 49152; const unsigned char* Bb = Ab + 16384;
#pragma unroll
        for (int ks = 0; ks < 2; ++ks) {
            const int so = ((ks * 4 + fq) ^ (fr & 7)) << 4;
            bf16x8 af[4], bfr[NI];
#pragma unroll
            for (int i = 0; i < 4; ++i) af[i] = *(const bf16x8*)(Ab + aoff + i * 2048 + so);
#pragma unroll
            for (int i = 0; i < NI; ++i) bfr[i] = *(const bf16x8*)(Bb + boff + i * 2048 + so);
#pragma unroll
            for (int mi = 0; mi < 4; ++mi)
#pragma unroll
                for (int ni = 0; ni < NI; ++ni) acc[mi][ni] = mfma16_h(bfr[ni], af[mi], acc[mi][ni], 0, 0, 0);
        }
    }
    __syncthreads();
    epi(acc, wm * 64 + fr, wn * 16 * NI + 4 * fq);
}

template <class F>
__device__ __forceinline__ void transpose_item(const float* W, int K, int N, bf16* WT, float* scr, int item, int lane, const F& rowmap) {
    const int nblk = N / 32, kb = item / nblk, nb = item % nblk, k0 = 64 * kb, n0 = 32 * nb;
#pragma unroll 8
    for (int i = 0; i < 32; ++i) { const int kk = 2 * i + (lane >> 5); scr[kk * 33 + (lane & 31)] = W[(size_t)(k0 + kk) * N + n0 + (lane & 31)]; }
    asm volatile("s_waitcnt lgkmcnt(0)" ::: "memory");
    const int c = lane & 7;
#pragma unroll
    for (int j = 0; j < 4; ++j) {
        const int n = (lane >> 3) + 8 * j; const float* s = scr + (8 * c) * 33 + n;
        u32x4 o; o.x = pk2(s[0 * 33], s[1 * 33]); o.y = pk2(s[2 * 33], s[3 * 33]); o.z = pk2(s[4 * 33], s[5 * 33]); o.w = pk2(s[6 * 33], s[7 * 33]);
        *(u32x4*)(WT + (size_t)rowmap(n0 + n) * K + k0 + 8 * c) = o;
    }
    asm volatile("s_waitcnt lgkmcnt(0)" ::: "memory");
}

__device__ __forceinline__ void sincos_d(double x, double& s, double& c) {
    const double k = rint(x * 0.63661977236758134308);
    const double r = (x - k * 1.57079632679489655800) - k * 6.123233995736766036e-17;
    const double r2 = r * r;
    double sp = 1.0 / 121645100408832000.0;
    sp = sp * r2 * (-1.0) + 1.0 / 355687428096000.0;
    sp = sp * r2 * (-1.0) + 1.0 / 1307674368000.0;
    sp = sp * r2 * (-1.0) + 1.0 / 6227020800.0;
    sp = sp * r2 * (-1.0) + 1.0 / 39916800.0;
    sp = sp * r2 * (-1.0) + 1.0 / 362880.0;
    sp = sp * r2 * (-1.0) + 1.0 / 5040.0;
    sp = sp * r2 * (-1.0) + 1.0 / 120.0;
    sp = sp * r2 * (-1.0) + 1.0 / 6.0;
    sp = sp * r2 * (-1.0) + 1.0;
    const double sr = sp * r;
    double cpn = 1.0 / 6402373705728000.0;
    cpn = cpn * r2 * (-1.0) + 1.0 / 20922789888000.0;
    cpn = cpn * r2 * (-1.0) + 1.0 / 87178291200.0;
    cpn = cpn * r2 * (-1.0) + 1.0 / 479001600.0;
    cpn = cpn * r2 * (-1.0) + 1.0 / 3628800.0;
    cpn = cpn * r2 * (-1.0) + 1.0 / 40320.0;
    cpn = cpn * r2 * (-1.0) + 1.0 / 720.0;
    cpn = cpn * r2 * (-1.0) + 1.0 / 24.0;
    cpn = cpn * r2 * (-1.0) + 0.5;
    const double cr = 1.0 - cpn * r2;
    const int q = ((int)k) & 3;
    s = (q == 0) ? sr : (q == 1) ? cr : (q == 2) ? -sr : -cr;
    c = (q == 0) ? cr : (q == 1) ? -sr : (q == 2) ? -cr : sr;
}
__device__ __forceinline__ double exp_small_d(double x) {
    const double y = x * 0.125;
    double p = 1.0 / 479001600.0;
    p = p * y + 1.0 / 39916800.0; p = p * y + 1.0 / 3628800.0; p = p * y + 1.0 / 362880.0; p = p * y + 1.0 / 40320.0;
    p = p * y + 1.0 / 5040.0; p = p * y + 1.0 / 720.0; p = p * y + 1.0 / 120.0; p = p * y + 1.0 / 24.0;
    p = p * y + 1.0 / 6.0; p = p * y + 0.5; p = p * y + 1.0; p = p * y + 1.0;
    p = p * p; p = p * p; p = p * p;
    return p;
}

__device__ __forceinline__ void phase_prep(const Params& P, unsigned char* lds) {
    int tid_ = threadIdx.x; asm volatile("" : "+v"(tid_));
    const int tid = tid_, lane = tid & 63, wave = tid >> 6;
    const int G = gridDim.x;
    const int gw = blockIdx.x * 8 + wave, NGW = G * 8;
    const size_t gtid = (size_t)blockIdx.x * NTHREADS + tid, NGT = (size_t)G * NTHREADS;
    unsigned char* ws = P.ws;
    if (blockIdx.x == 0 && tid < 64) ((int*)(ws + WS_CTL))[tid] = 0;
    {
        const f32x4* x4 = (const f32x4*)P.in[0]; u32x4* o = (u32x4*)(ws + WS_XB);
        const size_t n8 = (size_t)T * D / 8;
        for (size_t i = gtid; i < n8; i += NGT) { const f32x4 v = x4[2 * i], u = x4[2 * i + 1]; u32x4 w; w.x = pk2(v.x, v.y); w.y = pk2(v.z, v.w); w.z = pk2(u.x, u.y); w.w = pk2(u.z, u.w); o[i] = w; }
    }
    {
        float* scr = (float*)(lds + wave * 8704);
        constexpr int I_IN = 16 * 112, I_GLU = 8 * 64, I_COUT = 8 * 32, I_OUT = 16 * 32, I_RG = 16 * 1  , I_G = 16 * 8, I_D = 4 * 32;
        (void)I_RG;
        constexpr int TOTAL = I_IN + I_GLU + I_COUT + I_OUT + NEXP * (2 * I_G + I_D) + 16  ;
        for (int it = gw; it < TOTAL; it += NGW) {
            int r = it;
            if (r < I_IN) {
                transpose_item(P.in[1], D, DIN, (bf16*)(ws + WS_WIN), scr, r, lane,
                               [](int c) { return c < 512 ? c : (c < 1024 ? 512 + (((c - 512) >> 7) << 8) + ((c - 512) & 127) : (c < 1536 ? 512 + (((c - 1024) >> 7) << 8) + 128 + ((c - 1024) & 127) : c)); });
                continue;
            }
            r -= I_IN;
            if (r < I_GLU) { transpose_item(P.in[11], DSSM, 2 * D, (bf16*)(ws + WS_WGLU), scr, r, lane, [](int c) { return c < 1024 ? ((c >> 7) << 8) + (c & 127) : (((c - 1024) >> 7) << 8) + 128 + ((c - 1024) & 127); }); continue; }
            r -= I_GLU;
            if (r < I_COUT) { transpose_item(P.in[17], DCONV, D, (bf16*)(ws + WS_WCOUT), scr, r, lane, [](int c) { return c; }); continue; }
            r -= I_COUT;
            if (r < I_OUT) { transpose_item(P.in[19], D, D, (bf16*)(ws + WS_WOUT), scr, r, lane, [](int c) { return c; }); continue; }
            r -= I_OUT;
            if (r < NEXP * I_G) { const int e = r / I_G; transpose_item(P.in[27] + (size_t)e * D * DFF, D, DFF, (bf16*)(ws + WS_WGU) + (size_t)e * 512 * D, scr, r % I_G, lane, [](int c) { return ((c >> 7) << 8) + (c & 127); }); continue; }
            r -= NEXP * I_G;
            if (r < NEXP * I_G) { const int e = r / I_G; transpose_item(P.in[28] + (size_t)e * D * DFF, D, DFF, (bf16*)(ws + WS_WGU) + (size_t)e * 512 * D, scr, r % I_G, lane, [](int c) { return ((c >> 7) << 8) + 128 + (c & 127); }); continue; }
            r -= NEXP * I_G;
            if (r < NEXP * I_D) { const int e = r / I_D; transpose_item(P.in[29] + (size_t)e * DFF * D, DFF, D, (bf16*)(ws + WS_WD) + (size_t)e * D * DFF, scr, r % I_D, lane, [](int c) { return c; }); continue; }
            r -= NEXP * I_D;
            transpose_item(P.in[25], D, NEXP, (bf16*)(ws + WS_WR), scr, r, lane, [](int c) { return 4 + c; });
        }
    }
    {
        bf16* wr = (bf16*)(ws + WS_WR);
        for (size_t i = gtid; i < (size_t)4 * D; i += NGT) { const int n = (int)(i / D), k = (int)(i % D); wr[(size_t)n * D + k] = (bf16)f2bf(P.in[23][(size_t)k * 4 + n]); }
        for (size_t i = gtid; i < (size_t)(256 - 36) * D / 2; i += NGT) ((unsigned*)(wr + (size_t)36 * D))[i] = 0u;
    }
    {
        float* binp = (float*)(ws + WS_TAB + TAB_BINP); float* bglup = (float*)(ws + WS_TAB + TAB_BGLUP);
        for (size_t i = gtid; i < (size_t)DIN; i += NGT) { const int c = (int)i; const int r = c < 512 ? c : (c < 1024 ? 512 + (((c - 512) >> 7) << 8) + ((c - 512) & 127) : (c < 1536 ? 512 + (((c - 1024) >> 7) << 8) + 128 + ((c - 1024) & 127) : c)); binp[r] = P.in[2][c]; }
        for (size_t i = gtid; i < (size_t)2 * D; i += NGT) { const int c = (int)i; const int r = c < 1024 ? ((c >> 7) << 8) + (c & 127) : (((c - 1024) >> 7) << 8) + 128 + ((c - 1024) & 127); bglup[r] = P.in[12][c]; }
    }
    if (gtid < (size_t)NGRP * NST) {
        const int g = (int)gtid >> 6, p = (int)gtid & 63;
        const double lr = (double)P.in[3][g * 64 + p], li = (double)P.in[4][g * 64 + p];
        const double dt = (double)expf(P.in[5][g]);
        const double mag = exp_small_d(lr * dt);
        double sn, cs; sincos_d(li * dt, sn, cs);
        const double ar = mag * cs, ai = mag * sn;
        const double den = lr * lr + li * li;
        const double fr_ = ((ar - 1.0) * lr + ai * li) / den, fi_ = (ai * lr - (ar - 1.0) * li) / den;
        float* atab = (float*)(ws + WS_TAB + TAB_A);
        atab[(g * 64 + p) * 2 + 0] = (float)ar; atab[(g * 64 + p) * 2 + 1] = (float)ai;
        bf16* bb = (bf16*)(ws + WS_TAB + TAB_BB); bf16* cm = (bf16*)(ws + WS_TAB + TAB_CM);
        const int sh = p >> 5, p32 = p & 31;
        for (int h = 0; h < NH; ++h) {
            const double bre = (double)P.in[6][(g * 64 + p) * 16 + h], bim = (double)P.in[7][(g * 64 + p) * 16 + h];
            const double vre = fr_ * bre - fi_ * bim, vim = fr_ * bim + fi_ * bre;
            const int ln = p32 + 32 * (h >> 3), j = h & 7;
            bb[(((size_t)g * 4 + sh * 2 + 0) * 64 + ln) * 8 + j] = (bf16)f2bf((float)vre);
            bb[(((size_t)g * 4 + sh * 2 + 1) * 64 + ln) * 8 + j] = (bf16)f2bf((float)vim);
        }
        for (int ho = 0; ho < NH; ++ho) {
            const float cre = P.in[8][g * 1024 + ho * 64 + p], cim = P.in[9][g * 1024 + ho * 64 + p];
#pragma unroll
            for (int ri = 0; ri < 2; ++ri) {
                const int k = 2 * p + ri, ks = k >> 5, kk = k & 31, ln = ho + 16 * (kk >> 3), j = kk & 7;
                cm[(((size_t)g * 4 + ks) * 64 + ln) * 8 + j] = (bf16)f2bf(ri == 0 ? cre : -cim);
            }
        }
    }
}

struct EpiProj {
    const float* binp; bf16* U; bf16* V; bf16* SGS; bf16* SGC; int row0, col0;
    __device__ __forceinline__ void operator()(const f32x4 (&acc)[4][4], int r_in, int c_in) const {
#pragma unroll
        for (int mi = 0; mi < 4; ++mi) {
            const size_t row = (size_t)(row0 + r_in + mi * 16);
#pragma unroll
            for (int ni = 0; ni < 4; ++ni) {
                const int col = col0 + c_in + ni * 16;
                const f32x4 b = *(const f32x4*)(binp + col);
                const f32x4 v = acc[mi][ni] + b;
                if (col0 < 512) {
                    u32x2 w; w.x = pk2(v.x, v.y); w.y = pk2(v.z, v.w); *(u32x2*)(U + row * 512 + col) = w;
                } else if (col0 < 1536) {
                    const float v0 = v.x * sigmoidf_(v.y), v1 = v.z * sigmoidf_(v.w);
                    *(unsigned*)(V + row * 512 + ((col - 512) >> 1)) = pk2(v0, v1);
                } else if (col0 < 2560) {
                    u32x2 w; w.x = pk2(sigmoidf_(v.x), sigmoidf_(v.y)); w.y = pk2(sigmoidf_(v.z), sigmoidf_(v.w)); *(u32x2*)(SGS + row * 1024 + (col - 1536)) = w;
                } else {
                    u32x2 w; w.x = pk2(sigmoidf_(v.x), sigmoidf_(v.y)); w.y = pk2(sigmoidf_(v.z), sigmoidf_(v.w)); *(u32x2*)(SGC + row * 1024 + (col - 2560)) = w;
                }
            }
        }
    }
};
struct EpiCout {
    const float* bias; const bf16* SGC; bf16* MERGED; int row0, col0;
    __device__ __forceinline__ void operator()(const f32x4 (&acc)[4][4], int r_in, int c_in) const {
#pragma unroll
        for (int mi = 0; mi < 4; ++mi) {
            const size_t row = (size_t)(row0 + r_in + mi * 16);
#pragma unroll
            for (int ni = 0; ni < 4; ++ni) {
                const int col = col0 + c_in + ni * 16;
                const f32x4 v = acc[mi][ni] + *(const f32x4*)(bias + col);
                const u32x2 g = *(const u32x2*)(SGC + row * 1024 + col);
                u32x2 w; w.x = pk2(v.x * bflo(g.x), v.y * bfhi(g.x)); w.y = pk2(v.z * bflo(g.y), v.w * bfhi(g.y));
                *(u32x2*)(MERGED + row * 1024 + col) = w;
            }
        }
    }
};
struct EpiGlu {
    const float* bglup; const bf16* SGS; bf16* MERGED; int row0, col0;
    __device__ __forceinline__ void operator()(const f32x4 (&acc)[4][4], int r_in, int c_in) const {
#pragma unroll
        for (int mi = 0; mi < 4; ++mi) {
            const size_t row = (size_t)(row0 + r_in + mi * 16);
#pragma unroll
            for (int ni = 0; ni < 4; ++ni) {
                const int col = col0 + c_in + ni * 16;
                const f32x4 v = acc[mi][ni] + *(const f32x4*)(bglup + col);
                const int mc = col >> 1;
                const float s0 = v.x * sigmoidf_(v.y), s1 = v.z * sigmoidf_(v.w);
                const unsigned g = *(const unsigned*)(SGS + row * 1024 + mc);
                const unsigned m = *(const unsigned*)(MERGED + row * 1024 + mc);
                *(unsigned*)(MERGED + row * 1024 + mc) = pk2(bflo(m) + bflo(g) * s0, bfhi(m) + bfhi(g) * s1);
            }
        }
    }
};
struct EpiOut {
    const float* bias; const float* X; float* PRE; int row0, col0;
    __device__ __forceinline__ void operator()(const f32x4 (&acc)[4][4], int r_in, int c_in) const {
#pragma unroll
        for (int mi = 0; mi < 4; ++mi) {
            const size_t row = (size_t)(row0 + r_in + mi * 16);
#pragma unroll
            for (int ni = 0; ni < 4; ++ni) {
                const int col = col0 + c_in + ni * 16;
                const f32x4 xv = *(const f32x4*)(X + row * 1024 + col);
                *(f32x4*)(PRE + row * 1024 + col) = acc[mi][ni] + *(const f32x4*)(bias + col) + xv * ALPHA;
            }
        }
    }
};
struct EpiZ {
    float* Z; int row0;
    __device__ __forceinline__ void operator()(const f32x4 (&acc)[4][1], int r_in, int c_in) const {
#pragma unroll
        for (int mi = 0; mi < 4; ++mi) *(f32x4*)(Z + (size_t)(row0 + r_in + mi * 16) * 64 + c_in) = acc[mi][0];
    }
};
struct EpiGU {
    bf16* HID; int prow0, col0;
    __device__ __forceinline__ void operator()(const f32x4 (&acc)[4][4], int r_in, int c_in) const {
#pragma unroll
        for (int mi = 0; mi < 4; ++mi) {
            const size_t row = (size_t)(prow0 + r_in + mi * 16);
#pragma unroll
            for (int ni = 0; ni < 4; ++ni) {
                const int col = col0 + c_in + ni * 16;
                const f32x4 v = acc[mi][ni];
                *(unsigned*)(HID + row * 256 + (col >> 1)) = pk2(siluf_(v.x) * v.y, siluf_(v.z) * v.w);
            }
        }
    }
};
struct EpiDown {
    bf16* YM; const int* toklist; const float* GATE; int idx0, cnt, col0;
    __device__ __forceinline__ void operator()(const f32x4 (&acc)[4][4], int r_in, int c_in) const {
#pragma unroll
        for (int mi = 0; mi < 4; ++mi) {
            const int idx = idx0 + r_in + mi * 16;
            if (idx < cnt) {
                const int ent = toklist[idx];
                const float g = GATE[ent];
#pragma unroll
                for (int ni = 0; ni < 4; ++ni) {
                    const int col = col0 + c_in + ni * 16;
                    const f32x4 v = acc[mi][ni] * g;
                    u32x2 w; w.x = pk2(v.x, v.y); w.y = pk2(v.z, v.w);
                    *(u32x2*)(YM + (size_t)ent * 1024 + col) = w;
                }
            }
        }
    }
};

struct RowsDense { const bf16* base; size_t ld; __device__ __forceinline__ const bf16* operator()(int r) const { return base + (size_t)r * ld; } };
struct RowsGather {
    const bf16* HB; const int* toklist; int idx0, cnt;
    __device__ __forceinline__ const bf16* operator()(int r) const { const int idx = idx0 + r; const int tok = idx < cnt ? (toklist[idx] >> 1) : 0; return HB + (size_t)tok * 1024; }
};

constexpr int S5_WREG = 10752, S5_LBUF = 8 * S5_WREG;
__device__ __forceinline__ void s5_block_item(const Params& P, unsigned char* lds, int item) {
    unsigned char* ws = P.ws;
    int tid_ = threadIdx.x; asm volatile("" : "+v"(tid_));
    const int tid = tid_, lane = tid & 63, wave = __builtin_amdgcn_readfirstlane(tid >> 6);
    unsigned char* sbuf = lds + wave * S5_WREG; unsigned char* ubuf = sbuf + 8704; unsigned char* ybuf = sbuf + 9728;
    f32x4* Lbuf = (f32x4*)(lds + S5_LBUF);
    const int g = item & 31, bp = item >> 5;
    const int p32 = lane & 31, hf = lane >> 5;
    const float* atab = (const float*)(ws + WS_TAB + TAB_A);
    const float ar0 = atab[(g * 64 + p32) * 2], ai0 = atab[(g * 64 + p32) * 2 + 1];
    const float ar1 = atab[(g * 64 + p32 + 32) * 2], ai1 = atab[(g * 64 + p32 + 32) * 2 + 1];
    bf16x8 bb[4], cm[4];
#pragma unroll
    for (int q = 0; q < 4; ++q) {
        bb[q] = *(const bf16x8*)(ws + WS_TAB + TAB_BB + (((size_t)g * 4 + q) * 64 + lane) * 16);
        cm[q] = *(const bf16x8*)(ws + WS_TAB + TAB_CM + (((size_t)g * 4 + q) * 64 + lane) * 16);
    }
    const bf16* U = (const bf16*)(ws + WS_U);
    bf16* YG = (bf16*)(ws + WS_YG);
    const int a_seq = (p32 >> 2) & 1, a_ti = (p32 & 3) + 4 * (p32 >> 3);
    const int tbase = wave * 256;
    const bf16* ua = U + ((size_t)(2 * bp + a_seq) * SEQ + tbase + a_ti) * 512 + g * 16 + 8 * hf;
    const int ho = lane & 15, i4 = 4 * (lane >> 4);
    const float dsk = P.in[10][g * 16 + ho];
    const f32x16 z16 = {0.f, 0.f, 0.f, 0.f, 0.f, 0.f, 0.f, 0.f, 0.f, 0.f, 0.f, 0.f, 0.f, 0.f, 0.f, 0.f};
    float s0r = 0.f, s0i = 0.f, s1r = 0.f, s1i = 0.f;
    {
        bf16x8 afr[16];
#pragma unroll
        for (int blk = 0; blk < 16; ++blk) afr[blk] = *(const bf16x8*)(ua + (size_t)(blk * 16) * 512);
#pragma unroll
        for (int blk = 0; blk < 16; ++blk) {
            const bf16x8 af = afr[blk];
            const f32x16 b0r = mfma32_h(af, bb[0], z16, 0, 0, 0);
            const f32x16 b0i = mfma32_h(af, bb[1], z16, 0, 0, 0);
            const f32x16 b1r = mfma32_h(af, bb[2], z16, 0, 0, 0);
            const f32x16 b1i = mfma32_h(af, bb[3], z16, 0, 0, 0);
#pragma unroll
            for (int i = 0; i < 16; ++i) {
                float n0r = __builtin_fmaf(ar0, s0r, __builtin_fmaf(-ai0, s0i, b0r[i])); asm volatile("" : "+v"(n0r));
                float n0i = __builtin_fmaf(ar0, s0i, __builtin_fmaf(ai0, s0r, b0i[i]));  asm volatile("" : "+v"(n0i));
                float n1r = __builtin_fmaf(ar1, s1r, __builtin_fmaf(-ai1, s1i, b1r[i])); asm volatile("" : "+v"(n1r));
                float n1i = __builtin_fmaf(ar1, s1i, __builtin_fmaf(ai1, s1r, b1i[i]));  asm volatile("" : "+v"(n1i));
                s0r = n0r; s0i = n0i; s1r = n1r; s1i = n1i;
            }
        }
    }
    Lbuf[wave * 64 + lane] = (f32x4){s0r, s0i, s1r, s1i};
    __syncthreads();
    {
        float pr0 = ar0, pi0 = ai0, pr1 = ar1, pi1 = ai1;
#pragma unroll
        for (int i = 0; i < 8; ++i) {
            const float t0r = pr0 * pr0 - pi0 * pi0, t0i = 2.0f * pr0 * pi0, t1r = pr1 * pr1 - pi1 * pi1, t1i = 2.0f * pr1 * pi1;
            pr0 = t0r; pi0 = t0i; pr1 = t1r; pi1 = t1i;
        }
        s0r = 0.f; s0i = 0.f; s1r = 0.f; s1i = 0.f;
        for (int j = 0; j < wave; ++j) {
            const f32x4 L = Lbuf[j * 64 + lane];
            const float n0r = pr0 * s0r - pi0 * s0i + L.x, n0i = pr0 * s0i + pi0 * s0r + L.y;
            const float n1r = pr1 * s1r - pi1 * s1i + L.z, n1i = pr1 * s1i + pi1 * s1r + L.w;
            s0r = n0r; s0i = n0i; s1r = n1r; s1i = n1i;
        }
    }
    {
        bf16x8 af = *(const bf16x8*)ua;
        unsigned char* wrow = sbuf + (hf * 16) * 272 + 4 * p32;
        unsigned char* uw = ubuf + (a_seq * 16 + a_ti) * 32 + hf * 16;
        const int orow = lane >> 1, ohalf = lane & 1;
        bf16* yg_out = YG + ((size_t)(2 * bp + (orow >> 4)) * SEQ + tbase + (orow & 15)) * 512 + g * 16 + ohalf * 8;
        for (int blk = 0; blk < 16; ++blk) {
            const bf16x8 afn = *(const bf16x8*)(ua + (size_t)((blk < 15 ? blk + 1 : blk) * 16) * 512);
            *(bf16x8*)uw = af;
            const f32x16 b0r = mfma32_h(af, bb[0], z16, 0, 0, 0);
            const f32x16 b0i = mfma32_h(af, bb[1], z16, 0, 0, 0);
            const f32x16 b1r = mfma32_h(af, bb[2], z16, 0, 0, 0);
            const f32x16 b1i = mfma32_h(af, bb[3], z16, 0, 0, 0);
#pragma unroll
            for (int i = 0; i < 16; ++i) {
                float n0r = __builtin_fmaf(ar0, s0r, __builtin_fmaf(-ai0, s0i, b0r[i])); asm volatile("" : "+v"(n0r));
                float n0i = __builtin_fmaf(ar0, s0i, __builtin_fmaf(ai0, s0r, b0i[i]));  asm volatile("" : "+v"(n0i));
                float n1r = __builtin_fmaf(ar1, s1r, __builtin_fmaf(-ai1, s1i, b1r[i])); asm volatile("" : "+v"(n1r));
                float n1i = __builtin_fmaf(ar1, s1i, __builtin_fmaf(ai1, s1r, b1i[i]));  asm volatile("" : "+v"(n1i));
                s0r = n0r; s0i = n0i; s1r = n1r; s1i = n1i;
                *(unsigned*)(wrow + i * 272) = pk2(s0r, s0i);
                *(unsigned*)(wrow + i * 272 + 128) = pk2(s1r, s1i);
            }
            asm volatile("s_waitcnt lgkmcnt(0)" ::: "memory");
#pragma unroll
            for (int mb = 0; mb < 2; ++mb) {
                f32x4 y = {0.f, 0.f, 0.f, 0.f};
#pragma unroll
                for (int ks = 0; ks < 4; ++ks) {
                    const bf16x8 sf = *(const bf16x8*)(sbuf + (mb * 16 + (lane & 15)) * 272 + ks * 64 + (lane >> 4) * 16);
                    y = mfma16_h(sf, cm[ks], y, 0, 0, 0);
                }
#pragma unroll
                for (int r = 0; r < 4; ++r) {
                    const int ro = ((mb * 16 + i4 + r) * 32 + ho * 2);
                    const float yv = y[r] + dsk * bf2f(*(const bf16*)(ubuf + ro));
                    *(bf16*)(ybuf + ro) = (bf16)(pk2(geluf_(yv), 0.f) & 0xffffu);
                }
            }
            asm volatile("s_waitcnt lgkmcnt(0)" ::: "memory");
            const u32x4 yo = *(const u32x4*)(ybuf + orow * 32 + ohalf * 16);
            *(u32x4*)(yg_out + (size_t)(blk * 16) * 512) = yo;
            asm volatile("s_waitcnt lgkmcnt(0)" ::: "memory");
            af = afn;
        }
    }
    __syncthreads();
}

__device__ __forceinline__ void conv_phase(const Params& P, unsigned char* lds) {
    unsigned char* ws = P.ws;
    int tid_ = threadIdx.x; asm volatile("" : "+v"(tid_));
    const int tid = tid_, lane = tid & 63, wave = tid >> 6;
    const bf16* V = (const bf16*)(ws + WS_V);
    bf16* CV = (bf16*)(ws + WS_CV);
    unsigned char* vt = lds;
    float* ct = (float*)(lds + 63488);
    const int G = gridDim.x, nitems = T / 32;
    const int ch = tid;
    float w0[CW];
#pragma unroll
    for (int k = 0; k < CW; ++k) w0[k] = P.in[13][k * 512 + ch];
    const float cb0 = P.in[14][ch];
    const f32x4 g0 = *(const f32x4*)(P.in[15] + lane * 4), g1 = *(const f32x4*)(P.in[15] + 256 + lane * 4);
    const f32x4 b0 = *(const f32x4*)(P.in[16] + lane * 4), b1 = *(const f32x4*)(P.in[16] + 256 + lane * 4);
    u32x4 pf[8];
#define CONV_FETCH(item_) do { const int tokb_ = (item_) * 32, tloc_ = tokb_ & (SEQ - 1); \
        _Pragma("unroll") for (int n = 0; n < 8; ++n) { const int q = tid + n * NTHREADS; const int r = q >> 6, c16 = q & 63; \
            pf[n] = (u32x4){0u, 0u, 0u, 0u}; \
            if (q < 62 * 64 && tloc_ - 30 + r >= 0) pf[n] = *(const u32x4*)(V + (size_t)(tokb_ - 30 + r) * 512 + c16 * 8); } } while (0)
    int item = blockIdx.x;
    if (item < nitems) CONV_FETCH(item);
    for (; item < nitems; item += G) {
        const int tokb = item * 32;
#pragma unroll
        for (int n = 0; n < 8; ++n) { const int q = tid + n * NTHREADS; if (q < 62 * 64) *(u32x4*)(vt + (q >> 6) * 1024 + (q & 63) * 16) = pf[n]; }
        __syncthreads();
        if (item + G < nitems) CONV_FETCH(item + G);
#pragma unroll 1
        for (int jc = 0; jc < 4; ++jc) {
            const int base = jc * 8;
            float a0[8];
#pragma unroll
            for (int j = 0; j < 8; ++j) a0[j] = cb0;
#pragma unroll
            for (int r = 0; r < 38; ++r) {
                const float x0 = bf2f(*(const bf16*)(vt + (base + r) * 1024 + ch * 2));
#pragma unroll
                for (int j = 0; j < 8; ++j) {
                    const int k = r - j;
                    if (k >= 0 && k < CW) a0[j] += w0[k] * x0;
                }
            }
#pragma unroll
            for (int j = 0; j < 8; ++j) ct[(base + j) * 512 + ch] = a0[j];
        }
        __syncthreads();
#pragma unroll
        for (int rr = 0; rr < 4; ++rr) {
            const int row = wave * 4 + rr;
            const f32x4 c0 = *(const f32x4*)(ct + row * 512 + lane * 4), c1 = *(const f32x4*)(ct + row * 512 + 256 + lane * 4);
            const float mean = wave_sum((c0.x + c0.y) + (c0.z + c0.w) + (c1.x + c1.y) + (c1.z + c1.w)) * (1.0f / 512.0f);
            const f32x4 d0 = c0 - mean, d1 = c1 - mean;
            const float var = wave_sum((d0.x * d0.x + d0.y * d0.y) + (d0.z * d0.z + d0.w * d0.w) + (d1.x * d1.x + d1.y * d1.y) + (d1.z * d1.z + d1.w * d1.w)) * (1.0f / 512.0f);
            const float rstd = 1.0f / sqrtf(var + LN_EPS);
            const f32x4 y0 = d0 * rstd * g0 + b0, y1 = d1 * rstd * g1 + b1;
            u32x2 o0, o1;
            o0.x = pk2(siluf_(y0.x), siluf_(y0.y)); o0.y = pk2(siluf_(y0.z), siluf_(y0.w));
            o1.x = pk2(siluf_(y1.x), siluf_(y1.y)); o1.y = pk2(siluf_(y1.z), siluf_(y1.w));
            bf16* orow = CV + (size_t)(tokb + row) * 512;
            *(u32x2*)(orow + lane * 4) = o0; *(u32x2*)(orow + 256 + lane * 4) = o1;
        }
        __syncthreads();
    }
#undef CONV_FETCH
}

__device__ __forceinline__ void ln1_rows(const Params& P) {
    const int tid = threadIdx.x, lane = tid & 63, wave = tid >> 6;
    const int gw = blockIdx.x * 8 + wave, NGW = gridDim.x * 8;
    const float* PRE = P.out; bf16* HB = (bf16*)(P.ws + WS_HB);
    const float* lg = P.in[21]; const float* lb = P.in[22];
    f32x4 g[4], b[4];
#pragma unroll
    for (int j = 0; j < 4; ++j) { g[j] = *(const f32x4*)(lg + j * 256 + lane * 4); b[j] = *(const f32x4*)(lb + j * 256 + lane * 4); }
    for (int row = gw; row < T; row += NGW) {
        const float* xr = PRE + (size_t)row * 1024;
        f32x4 v[4]; float s = 0.f;
#pragma unroll
        for (int j = 0; j < 4; ++j) { v[j] = *(const f32x4*)(xr + j * 256 + lane * 4); s += (v[j].x + v[j].y) + (v[j].z + v[j].w); }
        const float mean = wave_sum(s) * (1.0f / 1024.0f); float s2 = 0.f;
#pragma unroll
        for (int j = 0; j < 4; ++j) { v[j] = v[j] - mean; s2 += (v[j].x * v[j].x + v[j].y * v[j].y) + (v[j].z * v[j].z + v[j].w * v[j].w); }
        const float rstd = 1.0f / sqrtf(wave_sum(s2) * (1.0f / 1024.0f) + LN_EPS);
        bf16* orow = HB + (size_t)row * 1024;
#pragma unroll
        for (int j = 0; j < 4; ++j) {
            const f32x4 y = v[j] * rstd * g[j] + b[j];
            u32x2 w; w.x = pk2(y.x, y.y); w.y = pk2(y.z, y.w);
            *(u32x2*)(orow + j * 256 + lane * 4) = w;
        }
    }
}
__device__ __forceinline__ void final_rows(const Params& P) {
    int tid_ = threadIdx.x; asm volatile("" : "+v"(tid_));
    const int tid = tid_, lane = tid & 63, wave = tid >> 6;
    const int gw = blockIdx.x * 8 + wave, NGW = gridDim.x * 8;
    const bf16* HB = (const bf16*)(P.ws + WS_HB); const bf16* YM = (const bf16*)(P.ws + WS_YM);
    const float* lg = P.in[30]; const float* lb = P.in[31];
    f32x4 g[4], b[4];
#pragma unroll
    for (int j = 0; j < 4; ++j) { g[j] = *(const f32x4*)(lg + j * 256 + lane * 4); b[j] = *(const f32x4*)(lb + j * 256 + lane * 4); }
#pragma unroll 2
    for (int row = gw; row < T; row += NGW) {
        f32x4 v[4]; float s = 0.f;
#pragma unroll
        for (int j = 0; j < 4; ++j) {
            const u32x2 h = *(const u32x2*)(HB + (size_t)row * 1024 + j * 256 + lane * 4);
            const u32x2 y0 = *(const u32x2*)(YM + (size_t)(2 * row) * 1024 + j * 256 + lane * 4);
            const u32x2 y1 = *(const u32x2*)(YM + (size_t)(2 * row + 1) * 1024 + j * 256 + lane * 4);
            v[j].x = ALPHA * bflo(h.x) + bflo(y0.x) + bflo(y1.x); v[j].y = ALPHA * bfhi(h.x) + bfhi(y0.x) + bfhi(y1.x);
            v[j].z = ALPHA * bflo(h.y) + bflo(y0.y) + bflo(y1.y); v[j].w = ALPHA * bfhi(h.y) + bfhi(y0.y) + bfhi(y1.y);
            s += (v[j].x + v[j].y) + (v[j].z + v[j].w);
        }
        const float mean = wave_sum(s) * (1.0f / 1024.0f); float s2 = 0.f;
#pragma unroll
        for (int j = 0; j < 4; ++j) { v[j] = v[j] - mean; s2 += (v[j].x * v[j].x + v[j].y * v[j].y) + (v[j].z * v[j].z + v[j].w * v[j].w); }
        const float rstd = 1.0f / sqrtf(wave_sum(s2) * (1.0f / 1024.0f) + LN_EPS);
        float* orow = P.out + (size_t)row * 1024;
#pragma unroll
        for (int j = 0; j < 4; ++j) *(f32x4*)(orow + j * 256 + lane * 4) = v[j] * rstd * g[j] + b[j];
    }
}
struct EpiZlds {
    float* Zs;
    __device__ __forceinline__ void operator()(const f32x4 (&acc)[4][4], int r_in, int c_in) const {
        if (c_in >= 64) return;
#pragma unroll
        for (int mi = 0; mi < 4; ++mi)
#pragma unroll
            for (int ni = 0; ni < 3; ++ni) {
                const int c = c_in + ni * 16;
                if (c < 40) *(f32x4*)(Zs + (r_in + mi * 16) * 40 + c) = acc[mi][ni];
            }
    }
};
__device__ __forceinline__ void ln_route_phase(const Params& P, unsigned char* lds) {
    unsigned char* ws = P.ws;
    int tid_ = threadIdx.x; asm volatile("" : "+v"(tid_));
    const int tid = tid_, lane = tid & 63, wave = tid >> 6, r = lane & 15, q = lane >> 4;
    const bf16* PREB = (const bf16*)(ws + WS_PREB); bf16* HB = (bf16*)(ws + WS_HB);
    int* CNT = (int*)(ws + WS_CTL); int* TOK = (int*)(ws + WS_TOK); float* GATE = (float*)(ws + WS_GATE);
    const float* lg = P.in[21]; const float* lb = P.in[22];
    const float* brg = P.in[24]; const float* bre = P.in[26];
    unsigned char* wl = lds;
    float* gl = (float*)(lds + 74304);
    float* zt = (float*)(lds + 82496 + wave * 3328);
    int* hist = (int*)(lds + 109120); int* base = hist + 32;
    for (int t = blockIdx.x; t < T / 128; t += gridDim.x) {
        asm volatile("" ::: "memory");
        int q8 = q * 8, ro = r * 1024 + q * 8;
        asm volatile("" : "+v"(q8), "+v"(ro));
#pragma unroll
        for (int i = 0; i < 9; ++i) {
            const int h = i * 8 + wave, wrow = h >> 1, half = h & 1;
            glds16((const bf16*)(ws + WS_WR) + wrow * 1024 + half * 512 + lane * 8, wl + wrow * 2064 + half * 1024 + lane * 16);
        }
        glds16(tid < 256 ? lg + tid * 4 : lb + (tid - 256) * 4, (unsigned char*)gl + tid * 16);
        const unsigned char* wrp0 = wl + (ro >> 10) * 2064 + q8 * 2;
        const unsigned char* wrp2 = wl + (32 + ((ro >> 10) & 3)) * 2064 + q8 * 2;
        const float* lgq = gl + q8; const float* lbq = gl + 1024 + q8;
        if (tid < 32) hist[tid] = 0;
        const size_t row = (size_t)t * 128 + wave * 16 + r;
        const bf16* prow = PREB + row * 1024 + q8;
        u32x4 pv[32];
#pragma unroll
        for (int s = 0; s < 32; ++s) pv[s] = *(const u32x4*)(prow + s * 32);
        float sm = 0.f;
#pragma unroll
        for (int s = 0; s < 32; ++s)
            sm += ((bflo(pv[s].x) + bfhi(pv[s].x)) + (bflo(pv[s].y) + bfhi(pv[s].y))) + ((bflo(pv[s].z) + bfhi(pv[s].z)) + (bflo(pv[s].w) + bfhi(pv[s].w)));
        sm += __shfl_xor(sm, 16); sm += __shfl_xor(sm, 32);
        const float mean = sm * (1.0f / 1024.0f);
#pragma unroll
        for (int s = 0; s < 32; ++s) asm volatile("" : "+v"(pv[s]));
        float s2 = 0.f;
#pragma unroll
        for (int s = 0; s < 32; ++s) {
            const float d0 = bflo(pv[s].x) - mean, d1 = bfhi(pv[s].x) - mean, d2 = bflo(pv[s].y) - mean, d3 = bfhi(pv[s].y) - mean;
            const float d4 = bflo(pv[s].z) - mean, d5 = bfhi(pv[s].z) - mean, d6 = bflo(pv[s].w) - mean, d7 = bfhi(pv[s].w) - mean;
            s2 += ((d0 * d0 + d1 * d1) + (d2 * d2 + d3 * d3)) + ((d4 * d4 + d5 * d5) + (d6 * d6 + d7 * d7));
        }
        s2 += __shfl_xor(s2, 16); s2 += __shfl_xor(s2, 32);
        const float rstd = 1.0f / sqrtf(s2 * (1.0f / 1024.0f) + LN_EPS);
#pragma unroll
        for (int s = 0; s < 32; ++s) asm volatile("" : "+v"(pv[s]));
        asm volatile("s_waitcnt vmcnt(0)" ::: "memory");
        __syncthreads();
        f32x4 acc[3];
#pragma unroll
        for (int i = 0; i < 3; ++i) acc[i] = (f32x4){0.f, 0.f, 0.f, 0.f};
        bf16* hrow = HB + row * 1024 + q8;
#pragma unroll
        for (int s = 0; s < 32; ++s) {
            const f32x4 g0 = *(const f32x4*)(lgq + s * 32), g1 = *(const f32x4*)(lgq + s * 32 + 4);
            const f32x4 b0 = *(const f32x4*)(lbq + s * 32), b1 = *(const f32x4*)(lbq + s * 32 + 4);
            const f32x4 v0 = {bflo(pv[s].x), bfhi(pv[s].x), bflo(pv[s].y), bfhi(pv[s].y)}, v1 = {bflo(pv[s].z), bfhi(pv[s].z), bflo(pv[s].w), bfhi(pv[s].w)};
            const f32x4 y0 = (v0 - mean) * rstd * g0 + b0, y1 = (v1 - mean) * rstd * g1 + b1;
            u32x4 w; w.x = pk2(y0.x, y0.y); w.y = pk2(y0.z, y0.w); w.z = pk2(y1.x, y1.y); w.w = pk2(y1.z, y1.w);
            *(u32x4*)(hrow + s * 32) = w;
            const bf16x8 a = __builtin_bit_cast(bf16x8, w);
            acc[0] = mfma16_h(*(const bf16x8*)(wrp0 + s * 64), a, acc[0], 0, 0, 0);
            acc[1] = mfma16_h(*(const bf16x8*)(wrp0 + 16 * 2064 + s * 64), a, acc[1], 0, 0, 0);
            acc[2] = mfma16_h(*(const bf16x8*)(wrp2 + s * 64), a, acc[2], 0, 0, 0);
        }
#pragma unroll
        for (int nt = 0; nt < 3; ++nt) *(f32x4*)(zt + r * 52 + nt * 16 + 4 * q) = acc[nt];
        __syncthreads();
        const size_t tok = (size_t)t * 128 + wave * 16 + lane;
        int e0 = 0, e1 = 0, r0 = 0, r1 = 0;
        if (lane < 16) {
            const float* z = zt + lane * 52;
            float zg[4];
#pragma unroll
            for (int i = 0; i < 4; ++i) zg[i] = z[i] + brg[i];
            int gs = 0; float mx = zg[0];
#pragma unroll
            for (int i = 1; i < 4; ++i) if (zg[i] > mx) { mx = zg[i]; gs = i; }
            float den = 0.f;
#pragma unroll
            for (int i = 0; i < 4; ++i) den += __expf(zg[i] - mx);
            const float pgrp = 1.0f / den;
            float ze[8];
#pragma unroll
            for (int i = 0; i < 8; ++i) ze[i] = z[4 + gs * 8 + i] + bre[gs * 8 + i];
            int i0 = 0; float v0 = ze[0];
#pragma unroll
            for (int i = 1; i < 8; ++i) if (ze[i] > v0) { v0 = ze[i]; i0 = i; }
            int i1 = -1; float v1 = -3.0e38f;
#pragma unroll
            for (int i = 0; i < 8; ++i) if (i != i0 && ze[i] > v1) { v1 = ze[i]; i1 = i; }
            const float sx = __expf(v1 - v0);
            const float g0 = pgrp / (1.0f + sx), g1 = pgrp * sx / (1.0f + sx);
            e0 = gs * 8 + i0; e1 = gs * 8 + i1;
            GATE[tok * 2] = g0; GATE[tok * 2 + 1] = g1;
            r0 = atomicAdd(&hist[e0], 1); r1 = atomicAdd(&hist[e1], 1);
        }
        __syncthreads();
        if (tid < 32) base[tid] = atomicAdd(&CNT[tid], hist[tid]);
        __syncthreads();
        if (lane < 16) {
            TOK[(size_t)e0 * T + base[e0] + r0] = (int)(tok * 2);
            TOK[(size_t)e1 * T + base[e1] + r1] = (int)(tok * 2 + 1);
        }
        __syncthreads();
    }
}

#define LAS __attribute__((address_space(3)))
#define XB_TMO      128
#define XB_XCNT(j)  (256  + 64 * (j))
#define XB_XSUB(j)  (1280 + 64 * (j))
#define XB_XGEN(j)  (2304 + 64 * (j))
#define XB_TOP      3328
#define XB_TOPGEN   3392
#define XCD_BAR_WORDS 3456
#define XB_SPIN_CAP (1u << 20)
__device__ __forceinline__ unsigned xb_ld(unsigned* p)              { return __hip_atomic_load(p, __ATOMIC_RELAXED, __HIP_MEMORY_SCOPE_AGENT); }
__device__ __forceinline__ unsigned xb_add(unsigned* p, unsigned v) { return __hip_atomic_fetch_add(p, v, __ATOMIC_RELAXED, __HIP_MEMORY_SCOPE_AGENT); }
__device__ __forceinline__ unsigned xb_xcc_id() { return (unsigned)__builtin_amdgcn_s_getreg((3 << 11) | 20) & 0xFu; }
#define XB_SPIN(cond, bar) do { unsigned _sp = 0; while (cond) { __builtin_amdgcn_s_sleep(1); \
    if ((++_sp & 255u) == 0u) { if (xb_ld(&(bar)[XB_TMO])) break; if (_sp > XB_SPIN_CAP) { atomicAdd(&(bar)[XB_TMO], 1u); break; } } } } while (0)
struct XcdBarrier { unsigned* bar; unsigned x; volatile LAS unsigned* st; };
__device__ __forceinline__ XcdBarrier xcd_barrier_post(unsigned* bar, volatile LAS unsigned* st) {
    XcdBarrier b; b.bar = bar; b.x = xb_xcc_id(); b.st = st;
    if (threadIdx.x == 0) (void)xb_add(&bar[XB_XCNT(b.x)], 1u);
    return b;
}
__device__ __forceinline__ void xcd_barrier_complete(unsigned* bar, unsigned x, unsigned& nloc, unsigned& nx) {
    const unsigned G = gridDim.x * gridDim.y * gridDim.z;
    unsigned sum, cnt, mine, sp = 0u;
    for (;;) {
        sum = 0u; cnt = 0u; mine = 0u;
#pragma unroll
        for (unsigned j = 0; j < 16; ++j) { const unsigned c = xb_ld(&bar[XB_XCNT(j)]); sum += c; cnt += (c > 0u) ? 1u : 0u; mine = (j == x) ? c : mine; }
        if (sum == G) break;
        __builtin_amdgcn_s_sleep(1);
        if ((++sp & 255u) == 0u) { if (xb_ld(&bar[XB_TMO])) break; if (sp > XB_SPIN_CAP) { atomicAdd(&bar[XB_TMO], 1u); break; } }
    }
    nloc = mine > 0u ? mine : 1u; nx = cnt > 0u ? cnt : 1u;
}
__device__ __forceinline__ void xcd_barrier(const XcdBarrier& b) {
    asm volatile("s_waitcnt vmcnt(0)" ::: "memory");
    __syncthreads();
    if (threadIdx.x == 0) {
        unsigned* bar = b.bar;
        __builtin_amdgcn_s_waitcnt(0);
        unsigned nloc = b.st[0], nx = b.st[1];
        if (nloc == 0u) { xcd_barrier_complete(bar, b.x, nloc, nx); b.st[0] = nloc; b.st[1] = nx; }
        const unsigned old = xb_add(&bar[XB_XSUB(b.x)], 1u);
        const unsigned gen = old / nloc;
        if (old + 1u == (gen + 1u) * nloc) {
            __builtin_amdgcn_fence(__ATOMIC_RELEASE, "agent");
            asm volatile("s_waitcnt vmcnt(0)" ::: "memory");
            const unsigned og = xb_add(&bar[XB_TOP], 1u);
            const unsigned tg = og / nx;
            if (og + 1u == (tg + 1u) * nx) xb_add(&bar[XB_TOPGEN], 1u);
            else XB_SPIN(xb_ld(&bar[XB_TOPGEN]) == tg, bar);
            __builtin_amdgcn_fence(__ATOMIC_ACQUIRE, "agent");
            xb_add(&bar[XB_XGEN(b.x)], 1u);
            asm volatile("s_waitcnt vmcnt(0)" ::: "memory");
        } else {
            XB_SPIN(xb_ld(&bar[XB_XGEN(b.x)]) == gen, bar);
            __builtin_amdgcn_fence(__ATOMIC_ACQUIRE, "agent");
            asm volatile("s_waitcnt vmcnt(0)" ::: "memory");
        }
    }
    __syncthreads();
}

__device__ __forceinline__ void run_phase(const Params& P, unsigned char* lds, int ph) {
    unsigned char* ws = P.ws;
    const int G = gridDim.x, bid = blockIdx.x;
    switch (ph) {
    case 0: phase_prep(P, lds); break;
    case 1: {
        pg8::Gemm g{(const pg8::bf16_t*)(ws + WS_XB), (const pg8::bf16_t*)(ws + WS_WIN), T, DIN, D};
        pg8::StaticOrder S; S.init(T, DIN, G, bid);
        pg8::EpiProj E{(const float*)(ws + WS_TAB + TAB_BINP), (bf16*)(ws + WS_U), (bf16*)(ws + WS_V), (bf16*)(ws + WS_SGS), (bf16*)(ws + WS_SGC)};
        pg8::gemm_phase<pg8::EpiProj, pg8::StaticOrder, true, true>((PG8_LAS unsigned char*)lds, g, S, E);
    } break;
    case 2: {
        for (int it = bid; it < 256; it += G) s5_block_item(P, lds, it);
        conv_phase(P, lds);
    } break;
    case 3: {
        static_assert(WS_CV == WS_YG + (size_t)T * DSSM * 2 && WS_WCOUT == WS_WGLU + (size_t)2 * D * DSSM * 2 && DSSM == DCONV && T / 256 == 128, "virtual operands must be contiguous");
        pg8::Gemm g{(const pg8::bf16_t*)(ws + WS_YG), (const pg8::bf16_t*)(ws + WS_WGLU), 2 * T, 3 * D, DSSM};
        pg8::TripleOrder S; S.so.init(T, D, G, bid);
        pg8::EpiCG E{{P.in[18], (const bf16*)(ws + WS_SGC), (bf16*)(ws + WS_M1)},
                     {(const float*)(ws + WS_TAB + TAB_BGLUP), (const bf16*)(ws + WS_SGS), (const bf16*)(ws + WS_M1), (bf16*)(ws + WS_MERGED)}};
        pg8::gemm_phase<pg8::EpiCG, pg8::TripleOrder, true, true>((PG8_LAS unsigned char*)lds, g, S, E);
    } break;
    case 5: {
        pg8::Gemm g{(const pg8::bf16_t*)(ws + WS_MERGED), (const pg8::bf16_t*)(ws + WS_WOUT), T, D, D};
        pg8::StaticOrder S; S.init(T, D, G, bid);
        pg8::EpiOut E{P.in[20], P.in[0], (bf16*)(ws + WS_PREB), ALPHA};
        pg8::gemm_phase<pg8::EpiOut, pg8::StaticOrder, true, true>((PG8_LAS unsigned char*)lds, g, S, E);
    } break;
    case 6: ln_route_phase(P, lds); break;
    case 9: {
        const int* CNT = (const int*)(ws + WS_CTL);
        PG8_LAS int* tab = (PG8_LAS int*)((PG8_LAS unsigned char*)lds + LDS_MISC + 64);
        if (threadIdx.x == 0) {
            int up = 0, bp = 0;
            for (int e = 0; e < NEXP; ++e) { const int cnt = CNT[e], nb = (cnt + 255) >> 8; tab[e] = up; tab[64 + e] = bp; tab[128 + e] = cnt; up += nb * 2; bp += nb; }
            tab[32] = up; tab[96] = bp;
        }
        __syncthreads();
        pg8::Gemm g{(const pg8::bf16_t*)(ws + WS_HB), (const pg8::bf16_t*)(ws + WS_WGU), 0, NEXP * 512, D};
        pg8::MoeOrder S{tab, G, bid, 1};
        pg8::MoeRows R{tab, (const int*)(ws + WS_TOK), T, (unsigned)(D * 2)};
        pg8::EpiGUP E{(bf16*)(ws + WS_HID)};
        pg8::gemm_phase_gather<pg8::EpiGUP, pg8::MoeOrder, pg8::MoeRows>((PG8_LAS unsigned char*)lds, g, S, E, R);
        __syncthreads();
    } break;
    case 10: {
        const int* CNT = (const int*)(ws + WS_CTL);
        PG8_LAS int* tab = (PG8_LAS int*)((PG8_LAS unsigned char*)lds + LDS_MISC + 64);
        if (threadIdx.x == 0) {
            int up = 0, bp = 0;
            for (int e = 0; e < NEXP; ++e) { const int cnt = CNT[e], nb = (cnt + 255) >> 8; tab[e] = up; tab[64 + e] = bp; tab[128 + e] = cnt; up += nb * 4; bp += nb; }
            tab[32] = up; tab[96] = bp;
        }
        __syncthreads();
        pg8::Gemm g{(const pg8::bf16_t*)(ws + WS_HID), (const pg8::bf16_t*)(ws + WS_WD), 0, NEXP * D, DFF};
        pg8::MoeOrder S{tab, G, bid, 2};
        pg8::EpiDownP E{tab, (const int*)(ws + WS_TOK), (const float*)(ws + WS_GATE), (bf16*)(ws + WS_YM), (bf16*)(ws + WS_Z), T};
        pg8::gemm_phase<pg8::EpiDownP, pg8::MoeOrder, true, true>((PG8_LAS unsigned char*)lds, g, S, E);
    } break;
    case 11: final_rows(P); break;
    default: break;
    }
}

#if ONE_LAUNCH
__global__ void __launch_bounds__(NTHREADS) fwd_kernel(Params P) {
    extern __shared__ __attribute__((aligned(16))) unsigned char lds[];
    if (P.ph_hi < 0) cg::this_grid().sync();
    volatile LAS unsigned* misc = (volatile LAS unsigned*)(LAS unsigned char*)(lds + LDS_MISC);
    if (threadIdx.x < 4) misc[threadIdx.x] = 0u;
    __syncthreads();
    XcdBarrier bar = xcd_barrier_post((unsigned*)(P.ws + WS_CTL) + CTL_BAR, misc);
#define GSYNC() xcd_barrier(bar)
    run_phase(P, lds, 0); GSYNC();
    run_phase(P, lds, 1); GSYNC();
    run_phase(P, lds, 2); GSYNC();
    run_phase(P, lds, 3); GSYNC();
    run_phase(P, lds, 5); GSYNC();
    run_phase(P, lds, 6); GSYNC();
    run_phase(P, lds, 9); GSYNC();
    run_phase(P, lds, 10); GSYNC();
    run_phase(P, lds, 11);
}
#else
template <int PH>
__global__ void __launch_bounds__(NTHREADS) phase_kernel(Params P) {
    extern __shared__ __attribute__((aligned(16))) unsigned char lds[];
    run_phase(P, lds, PH);
}
template <int PH> static void launch_phase(int grid, const Params& p, hipStream_t stream) {
    static bool init = false;
    if (!init) { (void)hipFuncSetAttribute((const void*)phase_kernel<PH>, hipFuncAttributeMaxDynamicSharedMemorySize, LDS_BYTES); init = true; }
    hipLaunchKernelGGL(phase_kernel<PH>, dim3(grid), dim3(NTHREADS), LDS_BYTES, stream, p);
}
#endif

extern "C" void kernel_launch(void* const* d_in, const int* in_sizes, int n_in, void* d_out, int out_size, void* d_ws, size_t ws_size, hipStream_t stream) {
    static int grid = 0;
    if (grid == 0) {
        if (n_in != 32 || in_sizes[0] != T * D || out_size != T * D || ws_size < WS_END) {
            fprintf(stderr, "kernel_launch: unexpected shapes (n_in %d, in0 %d, out %d, ws %zu)\n", n_in, n_in > 0 ? in_sizes[0] : -1, out_size, ws_size);
            grid = -1; return;
        }
        int dev = 0, cus = 0, per_cu = 1;
        (void)hipGetDevice(&dev);
        (void)hipDeviceGetAttribute(&cus, hipDeviceAttributeMultiprocessorCount, dev);
#if ONE_LAUNCH
        (void)hipFuncSetAttribute((const void*)fwd_kernel, hipFuncAttributeMaxDynamicSharedMemorySize, LDS_BYTES);
        (void)hipOccupancyMaxActiveBlocksPerMultiprocessor(&per_cu, (const void*)fwd_kernel, NTHREADS, LDS_BYTES);
        if (per_cu < 1) per_cu = 1;
#endif
        grid = cus * per_cu;
        (void)hipGetLastError();
    }
    if (grid < 0) return;
    if (hipMemsetAsync((char*)d_ws + WS_CTL, 0, CTL_ZERO_BYTES, stream) != hipSuccess) { fprintf(stderr, "kernel_launch: memset failed\n"); return; }
    Params p{};
    for (int i = 0; i < 32; ++i) p.in[i] = (const float*)d_in[i];
    p.out = (float*)d_out; p.ws = (unsigned char*)d_ws;
#if ONE_LAUNCH
    p.ph_lo = 0; p.ph_hi = NPHASE;
    void* args[] = {&p};
    hipError_t e = hipLaunchCooperativeKernel((const void*)fwd_kernel, dim3(grid), dim3(NTHREADS), args, LDS_BYTES, stream);
    if (e != hipSuccess) fprintf(stderr, "cooperative launch failed: %s (grid %d)\n", hipGetErrorString(e), grid);
#else
    p.ph_lo = 0; p.ph_hi = NPHASE;
    launch_phase<0>(grid, p, stream); launch_phase<1>(grid, p, stream); launch_phase<2>(grid, p, stream); launch_phase<3>(grid, p, stream);
    launch_phase<4>(grid, p, stream); launch_phase<5>(grid, p, stream); launch_phase<6>(grid, p, stream); launch_phase<7>(grid, p, stream);
    launch_phase<8>(grid, p, stream); launch_phase<9>(grid, p, stream); launch_phase<10>(grid, p, stream); launch_phase<11>(grid, p, stream);
#endif
}
```

```cpp
#include <hip/hip_runtime.h>
#include <hip/hip_cooperative_groups.h>
#include <cstdio>
#include <cstdint>
namespace cg = cooperative_groups;

#ifndef ONE_LAUNCH
#define ONE_LAUNCH 1
#endif

typedef unsigned short bf16;
typedef short bf16x8 __attribute__((ext_vector_type(8)));
typedef float f32x4 __attribute__((ext_vector_type(4)));
typedef float f32x16 __attribute__((ext_vector_type(16)));
typedef unsigned u32x2 __attribute__((ext_vector_type(2)));
typedef unsigned u32x4 __attribute__((ext_vector_type(4)));

constexpr int T = 32768, D = 1024, SEQ = 2048, NB = 16;
constexpr int DIN = 3584, DSSM = 512, NGRP = 32, NST = 64, NH = 16, DCONV = 512, CW = 31;
constexpr int NEXP = 32, DFF = 256;
constexpr float LN_EPS = 1e-5f;
constexpr float ALPHA = 1.189207115002721f;
constexpr int NPHASE = 12;
constexpr int NTHREADS = 512;
constexpr int LDS_BYTES = 131072 + 2048, LDS_MISC = 131072;
constexpr int CTL_BAR = 4096;
constexpr size_t CTL_ZERO_BYTES = 65536;

constexpr size_t MiB = 1u << 20;
constexpr size_t WS_CTL = 0;
constexpr size_t WS_TAB = 1 * MiB;
constexpr size_t TAB_BINP = 0, TAB_BGLUP = 16384, TAB_A = 32768, TAB_BB = 65536, TAB_CM = 65536 + 131072;
constexpr size_t WS_WIN = 2 * MiB, WS_WGLU = 9 * MiB, WS_WCOUT = 11 * MiB, WS_WOUT = 12 * MiB, WS_WR = 14 * MiB;
constexpr size_t WS_WGU = 16 * MiB, WS_WD = 48 * MiB;
constexpr size_t WS_M1 = 128 * MiB, WS_PREB = 256 * MiB;
constexpr size_t WS_XB = 64 * MiB, WS_U = 128 * MiB, WS_V = 160 * MiB, WS_YM = 64 * MiB;
constexpr size_t WS_SGS = 192 * MiB, WS_HB = 192 * MiB, WS_SGC = 256 * MiB;
constexpr size_t WS_YG = 320 * MiB, WS_CV = 352 * MiB, WS_MERGED = 384 * MiB;
constexpr size_t WS_HID = 448 * MiB, WS_Z = 488 * MiB, WS_TOK = 496 * MiB, WS_GATE = 500 * MiB, WS_END = 501 * MiB;

struct Params {
    const float* in[32];
    float* out;
    unsigned char* ws;
    int ph_lo, ph_hi;
};

typedef float f32x2_t __attribute__((ext_vector_type(2)));
typedef _Float16 h2_t __attribute__((ext_vector_type(2)));
typedef _Float16 h8_t __attribute__((ext_vector_type(8)));
__device__ __forceinline__ unsigned pk2(float lo, float hi) { const f32x2_t v = {lo, hi}; const h2_t h = __builtin_convertvector(v, h2_t); return __builtin_bit_cast(unsigned, h); }
__device__ __forceinline__ unsigned f2bf(float f) { return pk2(f, 0.f) & 0xffffu; }
__device__ __forceinline__ float bflo(unsigned w) { return (float)__builtin_bit_cast(h2_t, w).x; }
__device__ __forceinline__ float bfhi(unsigned w) { return (float)__builtin_bit_cast(h2_t, w).y; }
__device__ __forceinline__ float bf2f(bf16 b) { return (float)__builtin_bit_cast(_Float16, b); }
__device__ __forceinline__ f32x4 mfma16_h(bf16x8 a, bf16x8 b, f32x4 c, int, int, int) { return __builtin_amdgcn_mfma_f32_16x16x32_f16(__builtin_bit_cast(h8_t, a), __builtin_bit_cast(h8_t, b), c, 0, 0, 0); }
__device__ __forceinline__ f32x16 mfma32_h(bf16x8 a, bf16x8 b, f32x16 c, int, int, int) { return __builtin_amdgcn_mfma_f32_32x32x16_f16(__builtin_bit_cast(h8_t, a), __builtin_bit_cast(h8_t, b), c, 0, 0, 0); }
__device__ __forceinline__ float sigmoidf_(float z) { return __builtin_amdgcn_rcpf(1.0f + __expf(-z)); }
__device__ __forceinline__ float siluf_(float z) { return z * sigmoidf_(z); }
__device__ __forceinline__ float geluf_(float x) { const float z = 1.5957691216057308f * (x + 0.044715f * x * x * x); return x * sigmoidf_(z); }
__device__ __forceinline__ float wave_sum(float v) {
    v += __builtin_bit_cast(float, __builtin_amdgcn_update_dpp(0, __builtin_bit_cast(int, v), 0xB1, 0xF, 0xF, true));
    v += __builtin_bit_cast(float, __builtin_amdgcn_update_dpp(0, __builtin_bit_cast(int, v), 0x4E, 0xF, 0xF, true));
    v += __builtin_bit_cast(float, __builtin_amdgcn_update_dpp(0, __builtin_bit_cast(int, v), 0x141, 0xF, 0xF, true));
    v += __builtin_bit_cast(float, __builtin_amdgcn_update_dpp(0, __builtin_bit_cast(int, v), 0x140, 0xF, 0xF, true));
    const int iv = __builtin_bit_cast(int, v);
    const float r0 = __builtin_bit_cast(float, __builtin_amdgcn_readlane(iv, 0)), r1 = __builtin_bit_cast(float, __builtin_amdgcn_readlane(iv, 16));
    const float r2 = __builtin_bit_cast(float, __builtin_amdgcn_readlane(iv, 32)), r3 = __builtin_bit_cast(float, __builtin_amdgcn_readlane(iv, 48));
    return (r0 + r1) + (r2 + r3);
}
__device__ __forceinline__ void glds16(const void* g, void* l) {
    __builtin_amdgcn_global_load_lds((const __attribute__((address_space(1))) unsigned*)g, (__attribute__((address_space(3))) unsigned*)l, 16, 0, 0);
}

namespace pg8 {
#define PG8_LAS __attribute__((address_space(3)))
typedef unsigned short bf16_t;
typedef short bf16x8 __attribute__((ext_vector_type(8)));
typedef float f32x4 __attribute__((ext_vector_type(4)));
typedef unsigned u32x4 __attribute__((ext_vector_type(4)));
constexpr int BM = 256, BK = 64, HALF = 128, HTB = HALF * BK * 2  , STAGE_BYTES = 8 * HTB, NXCD = 8, WGM = 8;

__host__ __device__ __forceinline__ int lds_byte(int r, int c) { const int st = (r >> 4) * 2 + (c >> 5), rr = r & 15, cc = c & 31, ob = rr * 64 + cc * 2; return st * 1024 + (ob ^ (((ob >> 9) & 1) << 5)); }
__host__ __device__ __forceinline__ void stage_rc(int b, int& R, int& C) { const int st = b / 1024, sb = b % 1024, swz = sb ^ (((sb >> 9) & 1) << 5); R = (st >> 1) * 16 + swz / 64; C = (st & 1) * 32 + (swz % 64) / 2; }
__host__ __device__ __forceinline__ int perm32(int rho) { const int n = rho >> 4, i = rho & 15; return 8 * (i >> 2) + 4 * n + (i & 3); }

struct Unit { int pm, pn; };
struct Gemm { const bf16_t* A; const bf16_t* Bt; int M, N, K; };

struct StaticOrder {
    int nM, nN, nwg, G, c;
    __host__ __device__ void init(int M, int N, int G_, int c_) { nM = M / BM; nN = N / BM; nwg = nM * nN; G = G_; c = c_; }
    __host__ __device__ bool next(int i, Unit& u) const {
        const long L = (long)i * G + c; if (L >= nwg) return false;
        int wgid = (int)L; { const int q = nwg / NXCD, r = nwg % NXCD, xcd = wgid % NXCD, off = wgid / NXCD; wgid = (xcd < r ? xcd * (q + 1) : r * (q + 1) + (xcd - r) * q) + off; }
        const int nig = WGM * nN, gid = wgid / nig, fm = gid * WGM, gsz = (nM - fm) < WGM ? (nM - fm) : WGM;
        u.pm = fm + ((wgid % nig) % gsz); u.pn = (wgid % nig) / gsz; return true;
    }
    __device__ __forceinline__ void a_ready(const Unit&) const {}
    __device__ __forceinline__ void done(const Unit&) const {}
};

__device__ __forceinline__ unsigned pk2_(float lo, float hi) { return ::pk2(lo, hi); }
__device__ __forceinline__ float sg_(float z) { return __builtin_amdgcn_rcpf(1.0f + __expf(-z)); }
__device__ __forceinline__ float lo_(unsigned w) { return ::bflo(w); }
__device__ __forceinline__ float hi_(unsigned w) { return ::bfhi(w); }
typedef unsigned u32x2 __attribute__((ext_vector_type(2)));
struct EpiProj {
    static constexpr bool PERM = true, AFTER_DRAIN = false;
    const float* binp; bf16_t* U; bf16_t* V; bf16_t* SGS; bf16_t* SGC;
    __device__ __forceinline__ void operator()(const f32x4 (&acc)[2][2][4][2], const Unit& u, int wr, int wc, int fr, int fq) const {
        const int row0 = u.pm * BM + wr * 64 + fr, colt = u.pn * BM, c0 = colt + wc * 32 + 8 * fq;
        f32x4 bv[2][2];
#pragma unroll
        for (int bj = 0; bj < 2; ++bj)
#pragma unroll
            for (int n = 0; n < 2; ++n) bv[bj][n] = *(const f32x4*)(binp + c0 + bj * HALF + 4 * n);
#pragma unroll
        for (int ai = 0; ai < 2; ++ai)
#pragma unroll
            for (int m = 0; m < 4; ++m) {
                const size_t row = (size_t)(row0 + ai * HALF + m * 16);
#pragma unroll
                for (int bj = 0; bj < 2; ++bj) {
                    const int c8 = c0 + bj * HALF;
                    const f32x4 v0 = acc[ai][bj][m][0] + bv[bj][0], v1 = acc[ai][bj][m][1] + bv[bj][1];
                    if (colt < 512) {
                        u32x4 w; w.x = pk2_(v0.x, v0.y); w.y = pk2_(v0.z, v0.w); w.z = pk2_(v1.x, v1.y); w.w = pk2_(v1.z, v1.w);
                        *(u32x4*)(U + row * 512 + c8) = w;
                    } else if (colt < 1536) {
                        if (bj == 0) {
                            const f32x4 g0 = acc[ai][1][m][0] + bv[1][0], g1 = acc[ai][1][m][1] + bv[1][1];
                            u32x4 w; w.x = pk2_(v0.x * sg_(g0.x), v0.y * sg_(g0.y)); w.y = pk2_(v0.z * sg_(g0.z), v0.w * sg_(g0.w));
                            w.z = pk2_(v1.x * sg_(g1.x), v1.y * sg_(g1.y)); w.w = pk2_(v1.z * sg_(g1.z), v1.w * sg_(g1.w));
                            *(u32x4*)(V + row * 512 + ((colt - 512) >> 1) + wc * 32 + 8 * fq) = w;
                        }
                    } else {
                        u32x4 w; w.x = pk2_(sg_(v0.x), sg_(v0.y)); w.y = pk2_(sg_(v0.z), sg_(v0.w)); w.z = pk2_(sg_(v1.x), sg_(v1.y)); w.w = pk2_(sg_(v1.z), sg_(v1.w));
                        if (colt < 2560) *(u32x4*)(SGS + row * 1024 + (c8 - 1536)) = w; else *(u32x4*)(SGC + row * 1024 + (c8 - 2560)) = w;
                    }
                }
            }
    }
};
struct EpiCout {
    static constexpr bool PERM = true, AFTER_DRAIN = false;
    const float* bias; const bf16_t* SGC; bf16_t* M1;
    __device__ __forceinline__ void operator()(const f32x4 (&acc)[2][2][4][2], const Unit& u, int wr, int wc, int fr, int fq) const {
        const int row0 = u.pm * BM + wr * 64 + fr, c0 = u.pn * BM + wc * 32 + 8 * fq;
        f32x4 bv[2][2];
#pragma unroll
        for (int bj = 0; bj < 2; ++bj)
#pragma unroll
            for (int n = 0; n < 2; ++n) bv[bj][n] = *(const f32x4*)(bias + c0 + bj * HALF + 4 * n);
#pragma unroll
        for (int ai = 0; ai < 2; ++ai) {
            u32x4 gv[4][2];
#pragma unroll
            for (int m = 0; m < 4; ++m)
#pragma unroll
                for (int bj = 0; bj < 2; ++bj) gv[m][bj] = *(const u32x4*)(SGC + (size_t)(row0 + ai * HALF + m * 16) * 1024 + c0 + bj * HALF);
            asm volatile("" ::: "memory");
#pragma unroll
            for (int m = 0; m < 4; ++m) {
                const size_t row = (size_t)(row0 + ai * HALF + m * 16);
#pragma unroll
                for (int bj = 0; bj < 2; ++bj) {
                    const int c8 = c0 + bj * HALF;
                    const f32x4 v0 = acc[ai][bj][m][0] + bv[bj][0], v1 = acc[ai][bj][m][1] + bv[bj][1];
                    const u32x4 g = gv[m][bj];
                    u32x4 w; w.x = pk2_(v0.x * lo_(g.x), v0.y * hi_(g.x)); w.y = pk2_(v0.z * lo_(g.y), v0.w * hi_(g.y));
                    w.z = pk2_(v1.x * lo_(g.z), v1.y * hi_(g.z)); w.w = pk2_(v1.z * lo_(g.w), v1.w * hi_(g.w));
                    *(u32x4*)(M1 + row * 1024 + c8) = w;
                }
            }
            asm volatile("" ::: "memory");
        }
    }
};
struct EpiGlu {
    static constexpr bool PERM = true, AFTER_DRAIN = false;
    const float* bglup; const bf16_t* SGS; const bf16_t* M1; bf16_t* MERGED;
    __device__ __forceinline__ void operator()(const f32x4 (&acc)[2][2][4][2], const Unit& u, int wr, int wc, int fr, int fq) const {
        const int row0 = u.pm * BM + wr * 64 + fr, c0 = u.pn * BM + wc * 32 + 8 * fq, mc = u.pn * HALF + wc * 32 + 8 * fq;
        f32x4 bv[2][2];
#pragma unroll
        for (int bj = 0; bj < 2; ++bj)
#pragma unroll
            for (int n = 0; n < 2; ++n) bv[bj][n] = *(const f32x4*)(bglup + c0 + bj * HALF + 4 * n);
#pragma unroll
        for (int ai = 0; ai < 2; ++ai) {
            u32x4 gv[4], qv[4];
#pragma unroll
            for (int m = 0; m < 4; ++m) {
                const size_t off = (size_t)(row0 + ai * HALF + m * 16) * 1024 + mc;
                gv[m] = *(const u32x4*)(SGS + off); qv[m] = *(const u32x4*)(M1 + off);
            }
            asm volatile("" ::: "memory");
#pragma unroll
            for (int m = 0; m < 4; ++m) {
                const size_t off = (size_t)(row0 + ai * HALF + m * 16) * 1024 + mc;
                const f32x4 a0 = acc[ai][0][m][0] + bv[0][0], a1 = acc[ai][0][m][1] + bv[0][1];
                const f32x4 b0 = acc[ai][1][m][0] + bv[1][0], b1 = acc[ai][1][m][1] + bv[1][1];
                const u32x4 g = gv[m], q = qv[m];
                u32x4 w;
                w.x = pk2_(lo_(q.x) + lo_(g.x) * (a0.x * sg_(b0.x)), hi_(q.x) + hi_(g.x) * (a0.y * sg_(b0.y)));
                w.y = pk2_(lo_(q.y) + lo_(g.y) * (a0.z * sg_(b0.z)), hi_(q.y) + hi_(g.y) * (a0.w * sg_(b0.w)));
                w.z = pk2_(lo_(q.z) + lo_(g.z) * (a1.x * sg_(b1.x)), hi_(q.z) + hi_(g.z) * (a1.y * sg_(b1.y)));
                w.w = pk2_(lo_(q.w) + lo_(g.w) * (a1.z * sg_(b1.z)), hi_(q.w) + hi_(g.w) * (a1.w * sg_(b1.w)));
                *(u32x4*)(MERGED + off) = w;
            }
            asm volatile("" ::: "memory");
        }
    }
};
struct TripleOrder {
    StaticOrder so;
    __device__ __forceinline__ bool next(int i, Unit& u) const {
        const int tr = i / 3, sub = i - tr * 3; Unit v;
        if (!so.next(tr, v)) return false;
        if (sub == 0) { u.pm = 128 + v.pm; u.pn = 8 + v.pn; } else { u.pm = v.pm; u.pn = 2 * v.pn + sub - 1; }
        return true;
    }
    __device__ __forceinline__ void a_ready(const Unit&) const {}
    __device__ __forceinline__ void done(const Unit&) const {}
};
struct EpiCG {
    static constexpr bool PERM = true, AFTER_DRAIN = false;
    EpiCout c; EpiGlu g;
    __device__ __forceinline__ void operator()(const f32x4 (&acc)[2][2][4][2], const Unit& u, int wr, int wc, int fr, int fq) const {
        if (u.pm >= 128) { const Unit v{u.pm - 128, u.pn - 8}; c(acc, v, wr, wc, fr, fq); }
        else g(acc, u, wr, wc, fr, fq);
    }
};
struct EpiOut {
    static constexpr bool PERM = true, AFTER_DRAIN = false;
    const float* bias; const bf16_t* XB; bf16_t* PREB; float alpha;
    __device__ __forceinline__ void operator()(const f32x4 (&acc)[2][2][4][2], const Unit& u, int wr, int wc, int fr, int fq) const {
        const int row0 = u.pm * BM + wr * 64 + fr, c0 = u.pn * BM + wc * 32 + 8 * fq;
        u32x4 xv[2][4][2];
#pragma unroll
        for (int ai = 0; ai < 2; ++ai)
#pragma unroll
            for (int m = 0; m < 4; ++m)
#pragma unroll
                for (int bj = 0; bj < 2; ++bj) xv[ai][m][bj] = *(const u32x4*)(XB + (size_t)(row0 + ai * HALF + m * 16) * 1024 + c0 + bj * HALF);
        asm volatile("" ::: "memory");
#pragma unroll
        for (int bj = 0; bj < 2; ++bj) {
            const int c8 = c0 + bj * HALF;
            const f32x4 bv0 = *(const f32x4*)(bias + c8), bv1 = *(const f32x4*)(bias + c8 + 4);
#pragma unroll
            for (int ai = 0; ai < 2; ++ai)
#pragma unroll
                for (int m = 0; m < 4; ++m) {
                    int ro_ = row0 + ai * HALF + m * 16; asm volatile("" : "+v"(ro_));
                    const u32x4 x = xv[ai][m][bj];
                    const f32x4 x0 = {lo_(x.x), hi_(x.x), lo_(x.y), hi_(x.y)}, x1 = {lo_(x.z), hi_(x.z), lo_(x.w), hi_(x.w)};
                    const f32x4 v0 = acc[ai][bj][m][0] + bv0 + x0 * alpha, v1 = acc[ai][bj][m][1] + bv1 + x1 * alpha;
                    u32x4 w; w.x = pk2_(v0.x, v0.y); w.y = pk2_(v0.z, v0.w); w.z = pk2_(v1.x, v1.y); w.w = pk2_(v1.z, v1.w);
                    *(u32x4*)(PREB + (size_t)ro_ * 1024 + c8) = w;
                }
            asm volatile("" ::: "memory");
        }
    }
};

struct MoeOrder {
    const PG8_LAS int* tab; int G, c, sh;
    __device__ __forceinline__ bool next(int i, Unit& u) const {
        const int L = i * G + c;
        if (L >= __builtin_amdgcn_readfirstlane(tab[32])) return false;
        int e = 0;
#pragma unroll 1
        while (L >= __builtin_amdgcn_readfirstlane(tab[e + 1])) ++e;
        const int ll = L - __builtin_amdgcn_readfirstlane(tab[e]);
        u.pm = __builtin_amdgcn_readfirstlane(tab[64 + e]) + (ll >> sh); u.pn = (e << sh) + (ll & ((1 << sh) - 1)); return true;
    }
    __device__ __forceinline__ void a_ready(const Unit&) const {}
    __device__ __forceinline__ void done(const Unit&) const {}
};
struct EpiDownP {
    static constexpr bool PERM = true, AFTER_DRAIN = false;
    const PG8_LAS int* tab; const int* TOK; const float* GATE; bf16_t* YM; bf16_t* dump; int Ttok;
    __device__ __forceinline__ void operator()(const f32x4 (&acc)[2][2][4][2], const Unit& u, int wr, int wc, int fr, int fq) const {
        const int e = u.pn >> 2, j = u.pn & 3;
        const int cnt = __builtin_amdgcn_readfirstlane(tab[128 + e]), idx0 = (u.pm - __builtin_amdgcn_readfirstlane(tab[64 + e])) * BM + wr * 64 + fr;
        const int* tl = TOK + (size_t)e * Ttok;
        const int c0 = j * BM + wc * 32 + 8 * fq;
        int entv[2][4]; float gtv[2][4];
#pragma unroll
        for (int ai = 0; ai < 2; ++ai)
#pragma unroll
            for (int m = 0; m < 4; ++m) { const int idx = idx0 + ai * HALF + m * 16; entv[ai][m] = tl[idx < cnt ? idx : 0]; }
#pragma unroll
        for (int ai = 0; ai < 2; ++ai)
#pragma unroll
            for (int m = 0; m < 4; ++m) gtv[ai][m] = GATE[entv[ai][m]];
        asm volatile("" ::: "memory");
#pragma unroll
        for (int ai = 0; ai < 2; ++ai)
#pragma unroll
            for (int m = 0; m < 4; ++m) {
                const int idx = idx0 + ai * HALF + m * 16;
                const bool ok = idx < cnt;
                const int ent = entv[ai][m];
                const float g = gtv[ai][m];
                bf16_t* const dst = (ok ? YM + (size_t)ent * 1024 : dump) + c0;
#pragma unroll
                for (int bj = 0; bj < 2; ++bj) {
                    const f32x4 v0 = acc[ai][bj][m][0] * g, v1 = acc[ai][bj][m][1] * g;
                    u32x4 w; w.x = pk2_(v0.x, v0.y); w.y = pk2_(v0.z, v0.w); w.z = pk2_(v1.x, v1.y); w.w = pk2_(v1.z, v1.w);
                    *(u32x4*)(dst + bj * HALF) = w;
                }
                asm volatile("" ::: "memory");
            }
    }
};

struct MoeRows {
    const PG8_LAS int* tab; const int* TOK; int Ttok; unsigned rowbytes;
    __device__ __forceinline__ unsigned rowoff(const Unit& u, int h, int R) const {
        const int e = u.pn >> 1;
        const int idx = (u.pm - __builtin_amdgcn_readfirstlane(tab[64 + e])) * BM + h * HALF + R;
        const int tok = idx < __builtin_amdgcn_readfirstlane(tab[128 + e]) ? (TOK[(size_t)e * Ttok + idx] >> 1) : 0;
        return (unsigned)tok * rowbytes;
    }
};
struct EpiGUP {
    static constexpr bool PERM = true, AFTER_DRAIN = false;
    bf16_t* HID;
    __device__ __forceinline__ void operator()(const f32x4 (&acc)[2][2][4][2], const Unit& u, int wr, int wc, int fr, int fq) const {
        const int row0 = u.pm * BM + wr * 64 + fr, hc = (u.pn & 1) * HALF + wc * 32 + 8 * fq;
#pragma unroll
        for (int ai = 0; ai < 2; ++ai)
#pragma unroll
            for (int m = 0; m < 4; ++m) {
                const size_t row = (size_t)(row0 + ai * HALF + m * 16);
                const f32x4 g0 = acc[ai][0][m][0], g1 = acc[ai][0][m][1], u0 = acc[ai][1][m][0], u1 = acc[ai][1][m][1];
                u32x4 w; w.x = pk2_(g0.x * sg_(g0.x) * u0.x, g0.y * sg_(g0.y) * u0.y); w.y = pk2_(g0.z * sg_(g0.z) * u0.z, g0.w * sg_(g0.w) * u0.w);
                w.z = pk2_(g1.x * sg_(g1.x) * u1.x, g1.y * sg_(g1.y) * u1.y); w.w = pk2_(g1.z * sg_(g1.z) * u1.z, g1.w * sg_(g1.w) * u1.w);
                *(u32x4*)(HID + row * 256 + hc) = w;
            }
    }
};

template <class Epi, class Sched, bool ALIGN_EPI = false, bool SP2 = false>
__device__ __forceinline__ void gemm_phase(PG8_LAS unsigned char* lds, const Gemm g, const Sched& S, const Epi& E) {
    int tid_ = threadIdx.x; asm volatile("" : "+v"(tid_));
    const int tid = tid_, wid = __builtin_amdgcn_readfirstlane(tid >> 6), lane = tid & 63, wr = wid >> 2, wc = wid & 3, fr = lane & 15, fq = lane >> 4;
    const int K = g.K, nt = K / BK;
    unsigned voffA[2], voffB[2];
#pragma unroll
    for (int i = 0; i < 2; ++i) { int R, C; stage_rc(tid * 16 + i * 8192, R, C); const int Rb = Epi::PERM ? ((R & ~31) + perm32(R & 31)) : R;
        voffA[i] = (unsigned)(R * K + C) * 2u; voffB[i] = (unsigned)(Rb * K + C) * 2u; }
    const size_t kstep = (size_t)(BK * 2);
    const size_t hstep = (size_t)HALF * K * 2;
    const size_t tstep = 2 * hstep;
    const unsigned ldsw = (unsigned)wid * 1024u;
    const int aoff = lds_byte(wr * 64 + fr, fq * 8), boff = lds_byte(wc * 32 + fr, fq * 8);
#define PG8_SA(b, h) (((b) * 2 + (h)) * HTB)
#define PG8_SB(b, h) ((4 + (b) * 2 + (h)) * HTB)
#define PG8_STAGE(bufoff, gbase, voff) do { _Pragma("unroll") for (int _i = 0; _i < 2; ++_i) \
        __builtin_amdgcn_global_load_lds((const unsigned*)((const char*)(gbase) + (voff)[_i]), (PG8_LAS unsigned*)(lds + (bufoff) + ldsw + _i * 8192), 16, 0, 0); } while (0)
#define PG8_LDA(dst, b, h) do { _Pragma("unroll") for (int m = 0; m < 4; ++m) _Pragma("unroll") for (int k = 0; k < 2; ++k) dst[m][k] = *(const PG8_LAS bf16x8*)(lds + PG8_SA(b, h) + aoff + m * 2048 + k * 1024); } while (0)
#define PG8_LDB(dst, b, h) do { _Pragma("unroll") for (int n = 0; n < 2; ++n) _Pragma("unroll") for (int k = 0; k < 2; ++k) dst[n][k] = *(const PG8_LAS bf16x8*)(lds + PG8_SB(b, h) + boff + n * 2048 + k * 1024); } while (0)
#define PG8_MMA(ai, bj, At, Bt) do { __builtin_amdgcn_s_setprio(1); _Pragma("unroll") for (int m = 0; m < 4; ++m) _Pragma("unroll") for (int n = 0; n < 2; ++n) _Pragma("unroll") for (int k = 0; k < 2; ++k) \
        acc[ai][bj][m][n] = mfma16_h(Bt[n][k], At[m][k], acc[ai][bj][m][n], 0, 0, 0); __builtin_amdgcn_s_setprio(0); } while (0)
#define PG8_WAIT_V(n) asm volatile("s_waitcnt vmcnt(" #n ")" ::: "memory")
#define PG8_WAIT_L(n) asm volatile("s_waitcnt lgkmcnt(" #n ")" ::: "memory")
#define PG8_BAR __builtin_amdgcn_s_barrier()
#define PG8_SCHED __builtin_amdgcn_sched_barrier(0)
    Unit cur, nxt; int ui = 0;
    if (!S.next(0, cur)) return;
    f32x4 acc[2][2][4][2];
#pragma unroll
    for (int a = 0; a < 2; ++a)
#pragma unroll
        for (int b = 0; b < 2; ++b)
#pragma unroll
            for (int m = 0; m < 4; ++m)
#pragma unroll
                for (int n = 0; n < 2; ++n) acc[a][b][m][n] = (f32x4){0.f, 0.f, 0.f, 0.f};
    bf16x8 At[4][2], B0[2][2], B1[2][2];
    const char* cA = (const char*)g.A + (size_t)cur.pm * tstep; const char* cB = (const char*)g.Bt + (size_t)cur.pn * tstep;
    S.a_ready(cur);
    if constexpr (SP2) {
        PG8_STAGE(PG8_SB(0, 0), cB, voffB); PG8_STAGE(PG8_SB(0, 1), cB + hstep, voffB); PG8_STAGE(PG8_SA(0, 0), cA, voffA); PG8_STAGE(PG8_SA(0, 1), cA + hstep, voffA);
        if (wr == 1) PG8_BAR;
        PG8_WAIT_V(2); PG8_BAR;
        PG8_STAGE(PG8_SB(1, 0), cB + kstep, voffB); PG8_STAGE(PG8_SA(1, 0), cA + kstep, voffA); PG8_STAGE(PG8_SB(1, 1), cB + hstep + kstep, voffB);
        PG8_WAIT_V(6); PG8_BAR;
    } else {
        PG8_STAGE(PG8_SB(0, 0), cB, voffB); PG8_STAGE(PG8_SA(0, 0), cA, voffA); PG8_STAGE(PG8_SB(0, 1), cB + hstep, voffB); PG8_STAGE(PG8_SA(0, 1), cA + hstep, voffA);
        if (wr == 1) PG8_BAR;
        PG8_WAIT_V(4); PG8_BAR;
        PG8_STAGE(PG8_SB(1, 0), cB + kstep, voffB); PG8_STAGE(PG8_SA(1, 0), cA + kstep, voffA); PG8_STAGE(PG8_SB(1, 1), cB + hstep + kstep, voffB);
        PG8_WAIT_V(6); PG8_BAR;
    }
    for (;;) {
        const bool has_next = S.next(ui + 1, nxt);
        const char* nA = has_next ? (const char*)g.A + (size_t)nxt.pm * tstep : cA; const char* nB = has_next ? (const char*)g.Bt + (size_t)nxt.pn * tstep : cB;
        for (int t = 0; t < nt; t += 2) {
            const bool last = (t == nt - 2);
            const char* a1 = cA + (size_t)(t + 1) * kstep;
            const char* a2 = last ? nA : cA + (size_t)(t + 2) * kstep; const char* b2 = last ? nB : cB + (size_t)(t + 2) * kstep;
            const char* a3 = a2 + kstep; const char* b3 = b2 + kstep;
            if (last && has_next) S.a_ready(nxt);
            if constexpr (SP2) {
            PG8_LDB(B0, 0, 0); PG8_LDB(B1, 0, 1); PG8_SCHED; PG8_LDA(At, 0, 0); PG8_STAGE(PG8_SA(1, 1), a1 + hstep, voffA);
            PG8_WAIT_V(8); PG8_WAIT_L(0); PG8_BAR; PG8_MMA(0, 0, At, B0); PG8_MMA(0, 1, At, B1); PG8_BAR; PG8_SCHED;
            PG8_LDA(At, 0, 1); PG8_STAGE(PG8_SB(0, 0), b2, voffB); PG8_STAGE(PG8_SB(0, 1), b2 + hstep, voffB); PG8_STAGE(PG8_SA(0, 0), a2, voffA);
            PG8_WAIT_V(8); PG8_WAIT_L(0); PG8_BAR; PG8_MMA(1, 0, At, B0); PG8_MMA(1, 1, At, B1); PG8_BAR; PG8_SCHED;
            PG8_LDB(B0, 1, 0); PG8_LDB(B1, 1, 1); PG8_SCHED; PG8_LDA(At, 1, 0); PG8_STAGE(PG8_SA(0, 1), a2 + hstep, voffA);
            PG8_WAIT_V(8); PG8_WAIT_L(0); PG8_BAR; PG8_MMA(0, 0, At, B0); PG8_MMA(0, 1, At, B1); PG8_BAR; PG8_SCHED;
            PG8_LDA(At, 1, 1); PG8_STAGE(PG8_SB(1, 0), b3, voffB); PG8_STAGE(PG8_SB(1, 1), b3 + hstep, voffB); PG8_STAGE(PG8_SA(1, 0), a3, voffA);
            PG8_WAIT_V(8); PG8_WAIT_L(0); PG8_BAR; PG8_MMA(1, 0, At, B0); PG8_MMA(1, 1, At, B1); PG8_BAR; PG8_SCHED;
            } else {
            PG8_LDB(B0, 0, 0); PG8_SCHED; PG8_LDA(At, 0, 0); PG8_STAGE(PG8_SA(1, 1), a1 + hstep, voffA);
            PG8_WAIT_L(8); PG8_BAR; PG8_WAIT_L(0); PG8_MMA(0, 0, At, B0); PG8_BAR; PG8_SCHED;
            PG8_LDB(B1, 0, 1); PG8_STAGE(PG8_SB(0, 0), b2, voffB);
            PG8_BAR; PG8_WAIT_L(0); PG8_MMA(0, 1, At, B1); PG8_BAR;
            PG8_LDA(At, 0, 1); PG8_STAGE(PG8_SA(0, 0), a2, voffA);
            PG8_BAR; PG8_WAIT_L(0); PG8_MMA(1, 0, At, B0); PG8_BAR; PG8_SCHED;
            PG8_STAGE(PG8_SB(0, 1), b2 + hstep, voffB);
            PG8_WAIT_V(6); PG8_BAR; PG8_MMA(1, 1, At, B1); PG8_BAR;
            PG8_LDB(B0, 1, 0); PG8_SCHED; PG8_LDA(At, 1, 0); PG8_STAGE(PG8_SA(0, 1), a2 + hstep, voffA);
            PG8_WAIT_L(8); PG8_BAR; PG8_WAIT_L(0); PG8_MMA(0, 0, At, B0); PG8_BAR; PG8_SCHED;
            PG8_LDB(B1, 1, 1); PG8_STAGE(PG8_SB(1, 0), b3, voffB);
            PG8_BAR; PG8_WAIT_L(0); PG8_MMA(0, 1, At, B1); PG8_BAR;
            PG8_LDA(At, 1, 1); PG8_STAGE(PG8_SA(1, 0), a3, voffA);
            PG8_BAR; PG8_WAIT_L(0); PG8_MMA(1, 0, At, B0); PG8_BAR; PG8_SCHED;
            PG8_STAGE(PG8_SB(1, 1), b3 + hstep, voffB);
            PG8_WAIT_V(6); PG8_BAR; PG8_MMA(1, 1, At, B1); PG8_BAR;
            }
        }
        if constexpr (ALIGN_EPI) { if (wr == 0) PG8_BAR; }
        if constexpr (!Epi::AFTER_DRAIN) { E(acc, cur, wr, wc, fr, fq); S.done(cur); }
        if (!has_next) break;
#pragma unroll
        for (int a = 0; a < 2; ++a)
#pragma unroll
            for (int b = 0; b < 2; ++b)
#pragma unroll
                for (int m = 0; m < 4; ++m)
#pragma unroll
                    for (int n = 0; n < 2; ++n) acc[a][b][m][n] = (f32x4){0.f, 0.f, 0.f, 0.f};
        cur = nxt; cA = nA; cB = nB; ++ui;
        if constexpr (ALIGN_EPI) { if (wr == 1) PG8_BAR; }
    }
    PG8_WAIT_V(0);
    if constexpr (!ALIGN_EPI) { if (wr == 0) PG8_BAR; }
    PG8_BAR;
    if constexpr (Epi::AFTER_DRAIN) { E.fused(acc, cur, wr, wc, fr, fq, lds, wid, lane); S.done(cur); }
#undef PG8_SA
#undef PG8_SB
#undef PG8_STAGE
#undef PG8_LDA
#undef PG8_LDB
#undef PG8_MMA
#undef PG8_WAIT_V
#undef PG8_WAIT_L
#undef PG8_BAR
#undef PG8_SCHED
}
template <class Epi, class Sched, class Rows>
__device__ __forceinline__ void gemm_phase_gather(PG8_LAS unsigned char* lds, const Gemm g, const Sched& S, const Epi& E, const Rows& rows) {
    constexpr bool ALIGN_EPI = true, SP2 = true;
    int tid_ = threadIdx.x; asm volatile("" : "+v"(tid_));
    const int tid = tid_, wid = __builtin_amdgcn_readfirstlane(tid >> 6), lane = tid & 63, wr = wid >> 2, wc = wid & 3, fr = lane & 15, fq = lane >> 4;
    const int K = g.K, nt = K / BK;
    unsigned voffB[2], cofs[2]; int RA[2];
#pragma unroll
    for (int i = 0; i < 2; ++i) { int R, C; stage_rc(tid * 16 + i * 8192, R, C); const int Rb = Epi::PERM ? ((R & ~31) + perm32(R & 31)) : R;
        RA[i] = R; cofs[i] = (unsigned)C * 2u; voffB[i] = (unsigned)(Rb * K + C) * 2u; }
    unsigned vC[2][2], vN[2][2];
#define PG8_LOADOFFS(v, un) do { _Pragma("unroll") for (int _h = 0; _h < 2; ++_h) _Pragma("unroll") for (int _i = 0; _i < 2; ++_i) (v)[_h][_i] = rows.rowoff((un), _h, RA[_i]) + cofs[_i]; } while (0)
    const size_t kstep = (size_t)(BK * 2);
    const size_t hstep = (size_t)HALF * K * 2;
    const size_t tstep = 2 * hstep;
    const unsigned ldsw = (unsigned)wid * 1024u;
    const int aoff = lds_byte(wr * 64 + fr, fq * 8), boff = lds_byte(wc * 32 + fr, fq * 8);
#define PG8_SA(b, h) (((b) * 2 + (h)) * HTB)
#define PG8_SB(b, h) ((4 + (b) * 2 + (h)) * HTB)
#define PG8_STAGE(bufoff, gbase, voff) do { _Pragma("unroll") for (int _i = 0; _i < 2; ++_i) \
        __builtin_amdgcn_global_load_lds((const unsigned*)((const char*)(gbase) + (voff)[_i]), (PG8_LAS unsigned*)(lds + (bufoff) + ldsw + _i * 8192), 16, 0, 0); } while (0)
#define PG8_LDA(dst, b, h) do { _Pragma("unroll") for (int m = 0; m < 4; ++m) _Pragma("unroll") for (int k = 0; k < 2; ++k) dst[m][k] = *(const PG8_LAS bf16x8*)(lds + PG8_SA(b, h) + aoff + m * 2048 + k * 1024); } while (0)
#define PG8_LDB(dst, b, h) do { _Pragma("unroll") for (int n = 0; n < 2; ++n) _Pragma("unroll") for (int k = 0; k < 2; ++k) dst[n][k] = *(const PG8_LAS bf16x8*)(lds + PG8_SB(b, h) + boff + n * 2048 + k * 1024); } while (0)
#define PG8_MMA(ai, bj, At, Bt) do { __builtin_amdgcn_s_setprio(1); _Pragma("unroll") for (int m = 0; m < 4; ++m) _Pragma("unroll") for (int n = 0; n < 2; ++n) _Pragma("unroll") for (int k = 0; k < 2; ++k) \
        acc[ai][bj][m][n] = mfma16_h(Bt[n][k], At[m][k], acc[ai][bj][m][n], 0, 0, 0); __builtin_amdgcn_s_setprio(0); } while (0)
#define PG8_WAIT_V(n) asm volatile("s_waitcnt vmcnt(" #n ")" ::: "memory")
#define PG8_WAIT_L(n) asm volatile("s_waitcnt lgkmcnt(" #n ")" ::: "memory")
#define PG8_BAR __builtin_amdgcn_s_barrier()
#define PG8_SCHED __builtin_amdgcn_sched_barrier(0)
    Unit cur, nxt; int ui = 0;
    if (!S.next(0, cur)) return;
    f32x4 acc[2][2][4][2];
#pragma unroll
    for (int a = 0; a < 2; ++a)
#pragma unroll
        for (int b = 0; b < 2; ++b)
#pragma unroll
            for (int m = 0; m < 4; ++m)
#pragma unroll
                for (int n = 0; n < 2; ++n) acc[a][b][m][n] = (f32x4){0.f, 0.f, 0.f, 0.f};
    bf16x8 At[4][2], B0[2][2], B1[2][2];
    const char* const Ab = (const char*)g.A; const char* cB = (const char*)g.Bt + (size_t)cur.pn * tstep;
    PG8_LOADOFFS(vC, cur);
    S.a_ready(cur);
    if constexpr (SP2) {
        PG8_STAGE(PG8_SB(0, 0), cB, voffB); PG8_STAGE(PG8_SB(0, 1), cB + hstep, voffB); PG8_STAGE(PG8_SA(0, 0), Ab, vC[0]); PG8_STAGE(PG8_SA(0, 1), Ab, vC[1]);
        if (wr == 1) PG8_BAR;
        PG8_WAIT_V(2); PG8_BAR;
        PG8_STAGE(PG8_SB(1, 0), cB + kstep, voffB); PG8_STAGE(PG8_SA(1, 0), Ab + kstep, vC[0]); PG8_STAGE(PG8_SB(1, 1), cB + hstep + kstep, voffB);
        PG8_WAIT_V(6); PG8_BAR;
    }
    for (;;) {
        const bool has_next = S.next(ui + 1, nxt);
        const char* nB = has_next ? (const char*)g.Bt + (size_t)nxt.pn * tstep : cB;
        if (has_next) { PG8_LOADOFFS(vN, nxt); } else { vN[0][0] = vC[0][0]; vN[0][1] = vC[0][1]; vN[1][0] = vC[1][0]; vN[1][1] = vC[1][1]; }
        for (int t = 0; t < nt; t += 2) {
            const bool last = (t == nt - 2);
            const char* a1 = Ab + (size_t)(t + 1) * kstep;
            const char* a2 = last ? Ab : Ab + (size_t)(t + 2) * kstep; const char* b2 = last ? nB : cB + (size_t)(t + 2) * kstep;
            const char* a3 = a2 + kstep; const char* b3 = b2 + kstep;
            unsigned s2h0[2], s2h1[2]; s2h0[0] = last ? vN[0][0] : vC[0][0]; s2h0[1] = last ? vN[0][1] : vC[0][1]; s2h1[0] = last ? vN[1][0] : vC[1][0]; s2h1[1] = last ? vN[1][1] : vC[1][1];
            if (last && has_next) S.a_ready(nxt);
            if constexpr (SP2) {
            PG8_LDB(B0, 0, 0); PG8_LDB(B1, 0, 1); PG8_SCHED; PG8_LDA(At, 0, 0); PG8_STAGE(PG8_SA(1, 1), a1, vC[1]);
            PG8_WAIT_V(8); PG8_WAIT_L(0); PG8_BAR; PG8_MMA(0, 0, At, B0); PG8_MMA(0, 1, At, B1); PG8_BAR; PG8_SCHED;
            PG8_LDA(At, 0, 1); PG8_STAGE(PG8_SB(0, 0), b2, voffB); PG8_STAGE(PG8_SB(0, 1), b2 + hstep, voffB); PG8_STAGE(PG8_SA(0, 0), a2, s2h0);
            PG8_WAIT_V(8); PG8_WAIT_L(0); PG8_BAR; PG8_MMA(1, 0, At, B0); PG8_MMA(1, 1, At, B1); PG8_BAR; PG8_SCHED;
            PG8_LDB(B0, 1, 0); PG8_LDB(B1, 1, 1); PG8_SCHED; PG8_LDA(At, 1, 0); PG8_STAGE(PG8_SA(0, 1), a2, s2h1);
            PG8_WAIT_V(8); PG8_WAIT_L(0); PG8_BAR; PG8_MMA(0, 0, At, B0); PG8_MMA(0, 1, At, B1); PG8_BAR; PG8_SCHED;
            PG8_LDA(At, 1, 1); PG8_STAGE(PG8_SB(1, 0), b3, voffB); PG8_STAGE(PG8_SB(1, 1), b3 + hstep, voffB); PG8_STAGE(PG8_SA(1, 0), a3, s2h0);
            PG8_WAIT_V(8); PG8_WAIT_L(0); PG8_BAR; PG8_MMA(1, 0, At, B0); PG8_MMA(1, 1, At, B1); PG8_BAR; PG8_SCHED;
            }
        }
        if constexpr (ALIGN_EPI) { if (wr == 0) PG8_BAR; }
        if constexpr (!Epi::AFTER_DRAIN) { E(acc, cur, wr, wc, fr, fq); S.done(cur); }
        if (!has_next) break;
#pragma unroll
        for (int a = 0; a < 2; ++a)
#pragma unroll
            for (int b = 0; b < 2; ++b)
#pragma unroll
                for (int m = 0; m < 4; ++m)
#pragma unroll
                    for (int n = 0; n < 2; ++n) acc[a][b][m][n] = (f32x4){0.f, 0.f, 0.f, 0.f};
        cur = nxt; cB = nB; ++ui; vC[0][0] = vN[0][0]; vC[0][1] = vN[0][1]; vC[1][0] = vN[1][0]; vC[1][1] = vN[1][1];
        if constexpr (ALIGN_EPI) { if (wr == 1) PG8_BAR; }
    }
    PG8_WAIT_V(0);
    if constexpr (!ALIGN_EPI) { if (wr == 0) PG8_BAR; }
    PG8_BAR;
    if constexpr (Epi::AFTER_DRAIN) { E.fused(acc, cur, wr, wc, fr, fq, lds, wid, lane); S.done(cur); }
#undef PG8_LOADOFFS
#undef PG8_SA
#undef PG8_SB
#undef PG8_STAGE
#undef PG8_LDA
#undef PG8_LDB
#undef PG8_MMA
#undef PG8_WAIT_V
#undef PG8_WAIT_L
#undef PG8_BAR
#undef PG8_SCHED
}
}

template <int NI, class RowPtr, class Epi>
__device__ __forceinline__ void gemm_tile(unsigned char* lds, const RowPtr& rowptr, const bf16* Bt, const int K, const Epi& epi) {
    const int tid = threadIdx.x, lane = tid & 63, wave = tid >> 6, wm = wave >> 2, wn = wave & 3, fr = lane & 15, fq = lane >> 4;
    const int sr = tid >> 3, cp = tid & 7;
    const int sw = (cp ^ (sr & 7)) << 3;
    const bf16* ap0 = rowptr(sr) + sw;
    const bf16* ap1 = rowptr(sr + 64) + sw;
    const bf16* bp = Bt + (size_t)sr * K + sw;
    const size_t bstep = (size_t)64 * K;
    f32x4 acc[4][NI];
#pragma unroll
    for (int i = 0; i < 4; ++i)
#pragma unroll
        for (int j = 0; j < NI; ++j) acc[i][j] = (f32x4){0.f, 0.f, 0.f, 0.f};
    const int nt = K >> 6;
    {
        unsigned char* Ab = lds; unsigned char* Bb = lds + 16384;
        glds16(ap0, Ab + tid * 16); glds16(ap1, Ab + 8192 + tid * 16);
#pragma unroll
        for (int i = 0; i < NI; ++i) glds16(bp + i * bstep, Bb + i * 8192 + tid * 16);
    }
    const int aoff = (wm * 64 + fr) * 128, boff = (wn * 16 * NI + fr) * 128;
    for (int kt = 0; kt < nt; ++kt) {
        asm volatile("s_waitcnt vmcnt(0)" ::: "memory");
        __syncthreads();
        if (kt + 1 < nt) {
            unsigned char* Ab = lds + ((kt + 1) & 1) * 49152; unsigned char* Bb = Ab + 16384;
            const int ko = (kt + 1) * 64;
            glds16(ap0 + ko, Ab + tid * 16); glds16(ap1 + ko, Ab + 8192 + tid * 16);
#pragma unroll
            for (int i = 0; i < NI; ++i) glds16(bp + i * bstep + ko, Bb + i * 8192 + tid * 16);
        }
        const unsigned char* Ab = lds + (kt & 1) * 49152; const unsigned char* Bb = Ab + 16384;
#pragma unroll
        for (int ks = 0; ks < 2; ++ks) {
            const int so = ((ks * 4 + fq) ^ (fr & 7)) << 4;
            bf16x8 af[4], bfr[NI];
#pragma unroll
            for (int i = 0; i < 4; ++i) af[i] = *(const bf16x8*)(Ab + aoff + i * 2048 + so);
#pragma unroll
            for (int i = 0; i < NI; ++i) bfr[i] = *(const bf16x8*)(Bb + boff + i * 2048 + so);
#pragma unroll
            for (int mi = 0; mi < 4; ++mi)
#pragma unroll
                for (int ni = 0; ni < NI; ++ni) acc[mi][ni] = mfma16_h(bfr[ni], af[mi], acc[mi][ni], 0, 0, 0);
        }
    }
    __syncthreads();
    epi(acc, wm * 64 + fr, wn * 16 * NI + 4 * fq);
}

template <class F>
__device__ __forceinline__ void transpose_item(const float* W, int K, int N, bf16* WT, float* scr, int item, int lane, const F& rowmap) {
    const int nblk = N / 32, kb = item / nblk, nb = item % nblk, k0 = 64 * kb, n0 = 32 * nb;
#pragma unroll 8
    for (int i = 0; i < 32; ++i) { const int kk = 2 * i + (lane >> 5); scr[kk * 33 + (lane & 31)] = W[(size_t)(k0 + kk) * N + n0 + (lane & 31)]; }
    asm volatile("s_waitcnt lgkmcnt(0)" ::: "memory");
    const int c = lane & 7;
#pragma unroll
    for (int j = 0; j < 4; ++j) {
        const int n = (lane >> 3) + 8 * j; const float* s = scr + (8 * c) * 33 + n;
        u32x4 o; o.x = pk2(s[0 * 33], s[1 * 33]); o.y = pk2(s[2 * 33], s[3 * 33]); o.z = pk2(s[4 * 33], s[5 * 33]); o.w = pk2(s[6 * 33], s[7 * 33]);
        *(u32x4*)(WT + (size_t)rowmap(n0 + n) * K + k0 + 8 * c) = o;
    }
    asm volatile("s_waitcnt lgkmcnt(0)" ::: "memory");
}

__device__ __forceinline__ void sincos_d(double x, double& s, double& c) {
    const double k = rint(x * 0.63661977236758134308);
    const double r = (x - k * 1.57079632679489655800) - k * 6.123233995736766036e-17;
    const double r2 = r * r;
    double sp = 1.0 / 121645100408832000.0;
    sp = sp * r2 * (-1.0) + 1.0 / 355687428096000.0;
    sp = sp * r2 * (-1.0) + 1.0 / 1307674368000.0;
    sp = sp * r2 * (-1.0) + 1.0 / 6227020800.0;
    sp = sp * r2 * (-1.0) + 1.0 / 39916800.0;
    sp = sp * r2 * (-1.0) + 1.0 / 362880.0;
    sp = sp * r2 * (-1.0) + 1.0 / 5040.0;
    sp = sp * r2 * (-1.0) + 1.0 / 120.0;
    sp = sp * r2 * (-1.0) + 1.0 / 6.0;
    sp = sp * r2 * (-1.0) + 1.0;
    const double sr = sp * r;
    double cpn = 1.0 / 6402373705728000.0;
    cpn = cpn * r2 * (-1.0) + 1.0 / 20922789888000.0;
    cpn = cpn * r2 * (-1.0) + 1.0 / 87178291200.0;
    cpn = cpn * r2 * (-1.0) + 1.0 / 479001600.0;
    cpn = cpn * r2 * (-1.0) + 1.0 / 3628800.0;
    cpn = cpn * r2 * (-1.0) + 1.0 / 40320.0;
    cpn = cpn * r2 * (-1.0) + 1.0 / 720.0;
    cpn = cpn * r2 * (-1.0) + 1.0 / 24.0;
    cpn = cpn * r2 * (-1.0) + 0.5;
    const double cr = 1.0 - cpn * r2;
    const int q = ((int)k) & 3;
    s = (q == 0) ? sr : (q == 1) ? cr : (q == 2) ? -sr : -cr;
    c = (q == 0) ? cr : (q == 1) ? -sr : (q == 2) ? -cr : sr;
}
__device__ __forceinline__ double exp_small_d(double x) {
    const double y = x * 0.125;
    double p = 1.0 / 479001600.0;
    p = p * y + 1.0 / 39916800.0; p = p * y + 1.0 / 3628800.0; p = p * y + 1.0 / 362880.0; p = p * y + 1.0 / 40320.0;
    p = p * y + 1.0 / 5040.0; p = p * y + 1.0 / 720.0; p = p * y + 1.0 / 120.0; p = p * y + 1.0 / 24.0;
    p = p * y + 1.0 / 6.0; p = p * y + 0.5; p = p * y + 1.0; p = p * y + 1.0;
    p = p * p; p = p * p; p = p * p;
    return p;
}

__device__ __forceinline__ void phase_prep(const Params& P, unsigned char* lds) {
    int tid_ = threadIdx.x; asm volatile("" : "+v"(tid_));
    const int tid = tid_, lane = tid & 63, wave = tid >> 6;
    const int G = gridDim.x;
    const int gw = blockIdx.x * 8 + wave, NGW = G * 8;
    const size_t gtid = (size_t)blockIdx.x * NTHREADS + tid, NGT = (size_t)G * NTHREADS;
    unsigned char* ws = P.ws;
    if (blockIdx.x == 0 && tid < 64) ((int*)(ws + WS_CTL))[tid] = 0;
    {
        const f32x4* x4 = (const f32x4*)P.in[0]; u32x4* o = (u32x4*)(ws + WS_XB);
        const size_t n8 = (size_t)T * D / 8;
        for (size_t i = gtid; i < n8; i += NGT) { const f32x4 v = x4[2 * i], u = x4[2 * i + 1]; u32x4 w; w.x = pk2(v.x, v.y); w.y = pk2(v.z, v.w); w.z = pk2(u.x, u.y); w.w = pk2(u.z, u.w); o[i] = w; }
    }
    {
        float* scr = (float*)(lds + wave * 8704);
        constexpr int I_IN = 16 * 112, I_GLU = 8 * 64, I_COUT = 8 * 32, I_OUT = 16 * 32, I_RG = 16 * 1  , I_G = 16 * 8, I_D = 4 * 32;
        (void)I_RG;
        constexpr int TOTAL = I_IN + I_GLU + I_COUT + I_OUT + NEXP * (2 * I_G + I_D) + 16  ;
        for (int it = gw; it < TOTAL; it += NGW) {
            int r = it;
            if (r < I_IN) {
                transpose_item(P.in[1], D, DIN, (bf16*)(ws + WS_WIN), scr, r, lane,
                               [](int c) { return c < 512 ? c : (c < 1024 ? 512 + (((c - 512) >> 7) << 8) + ((c - 512) & 127) : (c < 1536 ? 512 + (((c - 1024) >> 7) << 8) + 128 + ((c - 1024) & 127) : c)); });
                continue;
            }
            r -= I_IN;
            if (r < I_GLU) { transpose_item(P.in[11], DSSM, 2 * D, (bf16*)(ws + WS_WGLU), scr, r, lane, [](int c) { return c < 1024 ? ((c >> 7) << 8) + (c & 127) : (((c - 1024) >> 7) << 8) + 128 + ((c - 1024) & 127); }); continue; }
            r -= I_GLU;
            if (r < I_COUT) { transpose_item(P.in[17], DCONV, D, (bf16*)(ws + WS_WCOUT), scr, r, lane, [](int c) { return c; }); continue; }
            r -= I_COUT;
            if (r < I_OUT) { transpose_item(P.in[19], D, D, (bf16*)(ws + WS_WOUT), scr, r, lane, [](int c) { return c; }); continue; }
            r -= I_OUT;
            if (r < NEXP * I_G) { const int e = r / I_G; transpose_item(P.in[27] + (size_t)e * D * DFF, D, DFF, (bf16*)(ws + WS_WGU) + (size_t)e * 512 * D, scr, r % I_G, lane, [](int c) { return ((c >> 7) << 8) + (c & 127); }); continue; }
            r -= NEXP * I_G;
            if (r < NEXP * I_G) { const int e = r / I_G; transpose_item(P.in[28] + (size_t)e * D * DFF, D, DFF, (bf16*)(ws + WS_WGU) + (size_t)e * 512 * D, scr, r % I_G, lane, [](int c) { return ((c >> 7) << 8) + 128 + (c & 127); }); continue; }
            r -= NEXP * I_G;
            if (r < NEXP * I_D) { const int e = r / I_D; transpose_item(P.in[29] + (size_t)e * DFF * D, DFF, D, (bf16*)(ws + WS_WD) + (size_t)e * D * DFF, scr, r % I_D, lane, [](int c) { return c; }); continue; }
            r -= NEXP * I_D;
            transpose_item(P.in[25], D, NEXP, (bf16*)(ws + WS_WR), scr, r, lane, [](int c) { return 4 + c; });
        }
    }
    {
        bf16* wr = (bf16*)(ws + WS_WR);
        for (size_t i = gtid; i < (size_t)4 * D; i += NGT) { const int n = (int)(i / D), k = (int)(i % D); wr[(size_t)n * D + k] = (bf16)f2bf(P.in[23][(size_t)k * 4 + n]); }
        for (size_t i = gtid; i < (size_t)(256 - 36) * D / 2; i += NGT) ((unsigned*)(wr + (size_t)36 * D))[i] = 0u;
    }
    {
        float* binp = (float*)(ws + WS_TAB + TAB_BINP); float* bglup = (float*)(ws + WS_TAB + TAB_BGLUP);
        for (size_t i = gtid; i < (size_t)DIN; i += NGT) { const int c = (int)i; const int r = c < 512 ? c : (c < 1024 ? 512 + (((c - 512) >> 7) << 8) + ((c - 512) & 127) : (c < 1536 ? 512 + (((c - 1024) >> 7) << 8) + 128 + ((c - 1024) & 127) : c)); binp[r] = P.in[2][c]; }
        for (size_t i = gtid; i < (size_t)2 * D; i += NGT) { const int c = (int)i; const int r = c < 1024 ? ((c >> 7) << 8) + (c & 127) : (((c - 1024) >> 7) << 8) + 128 + ((c - 1024) & 127); bglup[r] = P.in[12][c]; }
    }
    if (gtid < (size_t)NGRP * NST) {
        const int g = (int)gtid >> 6, p = (int)gtid & 63;
        const double lr = (double)P.in[3][g * 64 + p], li = (double)P.in[4][g * 64 + p];
        const double dt = (double)expf(P.in[5][g]);
        const double mag = exp_small_d(lr * dt);
        double sn, cs; sincos_d(li * dt, sn, cs);
        const double ar = mag * cs, ai = mag * sn;
        const double den = lr * lr + li * li;
        const double fr_ = ((ar - 1.0) * lr + ai * li) / den, fi_ = (ai * lr - (ar - 1.0) * li) / den;
        float* atab = (float*)(ws + WS_TAB + TAB_A);
        atab[(g * 64 + p) * 2 + 0] = (float)ar; atab[(g * 64 + p) * 2 + 1] = (float)ai;
        bf16* bb = (bf16*)(ws + WS_TAB + TAB_BB); bf16* cm = (bf16*)(ws + WS_TAB + TAB_CM);
        const int sh = p >> 5, p32 = p & 31;
        for (int h = 0; h < NH; ++h) {
            const double bre = (double)P.in[6][(g * 64 + p) * 16 + h], bim = (double)P.in[7][(g * 64 + p) * 16 + h];
            const double vre = fr_ * bre - fi_ * bim, vim = fr_ * bim + fi_ * bre;
            const int ln = p32 + 32 * (h >> 3), j = h & 7;
            bb[(((size_t)g * 4 + sh * 2 + 0) * 64 + ln) * 8 + j] = (bf16)f2bf((float)vre);
            bb[(((size_t)g * 4 + sh * 2 + 1) * 64 + ln) * 8 + j] = (bf16)f2bf((float)vim);
        }
        for (int ho = 0; ho < NH; ++ho) {
            const float cre = P.in[8][g * 1024 + ho * 64 + p], cim = P.in[9][g * 1024 + ho * 64 + p];
#pragma unroll
            for (int ri = 0; ri < 2; ++ri) {
                const int k = 2 * p + ri, ks = k >> 5, kk = k & 31, ln = ho + 16 * (kk >> 3), j = kk & 7;
                cm[(((size_t)g * 4 + ks) * 64 + ln) * 8 + j] = (bf16)f2bf(ri == 0 ? cre : -cim);
            }
        }
    }
}

struct EpiProj {
    const float* binp; bf16* U; bf16* V; bf16* SGS; bf16* SGC; int row0, col0;
    __device__ __forceinline__ void operator()(const f32x4 (&acc)[4][4], int r_in, int c_in) const {
#pragma unroll
        for (int mi = 0; mi < 4; ++mi) {
            const size_t row = (size_t)(row0 + r_in + mi * 16);
#pragma unroll
            for (int ni = 0; ni < 4; ++ni) {
                const int col = col0 + c_in + ni * 16;
                const f32x4 b = *(const f32x4*)(binp + col);
                const f32x4 v = acc[mi][ni] + b;
                if (col0 < 512) {
                    u32x2 w; w.x = pk2(v.x, v.y); w.y = pk2(v.z, v.w); *(u32x2*)(U + row * 512 + col) = w;
                } else if (col0 < 1536) {
                    const float v0 = v.x * sigmoidf_(v.y), v1 = v.z * sigmoidf_(v.w);
                    *(unsigned*)(V + row * 512 + ((col - 512) >> 1)) = pk2(v0, v1);
                } else if (col0 < 2560) {
                    u32x2 w; w.x = pk2(sigmoidf_(v.x), sigmoidf_(v.y)); w.y = pk2(sigmoidf_(v.z), sigmoidf_(v.w)); *(u32x2*)(SGS + row * 1024 + (col - 1536)) = w;
                } else {
                    u32x2 w; w.x = pk2(sigmoidf_(v.x), sigmoidf_(v.y)); w.y = pk2(sigmoidf_(v.z), sigmoidf_(v.w)); *(u32x2*)(SGC + row * 1024 + (col - 2560)) = w;
                }
            }
        }
    }
};
struct EpiCout {
    const float* bias; const bf16* SGC; bf16* MERGED; int row0, col0;
    __device__ __forceinline__ void operator()(const f32x4 (&acc)[4][4], int r_in, int c_in) const {
#pragma unroll
        for (int mi = 0; mi < 4; ++mi) {
            const size_t row = (size_t)(row0 + r_in + mi * 16);
#pragma unroll
            for (int ni = 0; ni < 4; ++ni) {
                const int col = col0 + c_in + ni * 16;
                const f32x4 v = acc[mi][ni] + *(const f32x4*)(bias + col);
                const u32x2 g = *(const u32x2*)(SGC + row * 1024 + col);
                u32x2 w; w.x = pk2(v.x * bflo(g.x), v.y * bfhi(g.x)); w.y = pk2(v.z * bflo(g.y), v.w * bfhi(g.y));
                *(u32x2*)(MERGED + row * 1024 + col) = w;
            }
        }
    }
};
struct EpiGlu {
    const float* bglup; const bf16* SGS; bf16* MERGED; int row0, col0;
    __device__ __forceinline__ void operator()(const f32x4 (&acc)[4][4], int r_in, int c_in) const {
#pragma unroll
        for (int mi = 0; mi < 4; ++mi) {
            const size_t row = (size_t)(row0 + r_in + mi * 16);
#pragma unroll
            for (int ni = 0; ni < 4; ++ni) {
                const int col = col0 + c_in + ni * 16;
                const f32x4 v = acc[mi][ni] + *(const f32x4*)(bglup + col);
                const int mc = col >> 1;
                const float s0 = v.x * sigmoidf_(v.y), s1 = v.z * sigmoidf_(v.w);
                const unsigned g = *(const unsigned*)(SGS + row * 1024 + mc);
                const unsigned m = *(const unsigned*)(MERGED + row * 1024 + mc);
                *(unsigned*)(MERGED + row * 1024 + mc) = pk2(bflo(m) + bflo(g) * s0, bfhi(m) + bfhi(g) * s1);
            }
        }
    }
};
struct EpiOut {
    const float* bias; const float* X; float* PRE; int row0, col0;
    __device__ __forceinline__ void operator()(const f32x4 (&acc)[4][4], int r_in, int c_in) const {
#pragma unroll
        for (int mi = 0; mi < 4; ++mi) {
            const size_t row = (size_t)(row0 + r_in + mi * 16);
#pragma unroll
            for (int ni = 0; ni < 4; ++ni) {
                const int col = col0 + c_in + ni * 16;
                const f32x4 xv = *(const f32x4*)(X + row * 1024 + col);
                *(f32x4*)(PRE + row * 1024 + col) = acc[mi][ni] + *(const f32x4*)(bias + col) + xv * ALPHA;
            }
        }
    }
};
struct EpiZ {
    float* Z; int row0;
    __device__ __forceinline__ void operator()(const f32x4 (&acc)[4][1], int r_in, int c_in) const {
#pragma unroll
        for (int mi = 0; mi < 4; ++mi) *(f32x4*)(Z + (size_t)(row0 + r_in + mi * 16) * 64 + c_in) = acc[mi][0];
    }
};
struct EpiGU {
    bf16* HID; int prow0, col0;
    __device__ __forceinline__ void operator()(const f32x4 (&acc)[4][4], int r_in, int c_in) const {
#pragma unroll
        for (int mi = 0; mi < 4; ++mi) {
            const size_t row = (size_t)(prow0 + r_in + mi * 16);
#pragma unroll
            for (int ni = 0; ni < 4; ++ni) {
                const int col = col0 + c_in + ni * 16;
                const f32x4 v = acc[mi][ni];
                *(unsigned*)(HID + row * 256 + (col >> 1)) = pk2(siluf_(v.x) * v.y, siluf_(v.z) * v.w);
            }
        }
    }
};
struct EpiDown {
    bf16* YM; const int* toklist; const float* GATE; int idx0, cnt, col0;
    __device__ __forceinline__ void operator()(const f32x4 (&acc)[4][4], int r_in, int c_in) const {
#pragma unroll
        for (int mi = 0; mi < 4; ++mi) {
            const int idx = idx0 + r_in + mi * 16;
            if (idx < cnt) {
                const int ent = toklist[idx];
                const float g = GATE[ent];
#pragma unroll
                for (int ni = 0; ni < 4; ++ni) {
                    const int col = col0 + c_in + ni * 16;
                    const f32x4 v = acc[mi][ni] * g;
                    u32x2 w; w.x = pk2(v.x, v.y); w.y = pk2(v.z, v.w);
                    *(u32x2*)(YM + (size_t)ent * 1024 + col) = w;
                }
            }
        }
    }
};

struct RowsDense { const bf16* base; size_t ld; __device__ __forceinline__ const bf16* operator()(int r) const { return base + (size_t)r * ld; } };
struct RowsGather {
    const bf16* HB; const int* toklist; int idx0, cnt;
    __device__ __forceinline__ const bf16* operator()(int r) const { const int idx = idx0 + r; const int tok = idx < cnt ? (toklist[idx] >> 1) : 0; return HB + (size_t)tok * 1024; }
};

constexpr int S5_WREG = 10752, S5_LBUF = 8 * S5_WREG;
__device__ __forceinline__ void s5_block_item(const Params& P, unsigned char* lds, int item) {
    unsigned char* ws = P.ws;
    int tid_ = threadIdx.x; asm volatile("" : "+v"(tid_));
    const int tid = tid_, lane = tid & 63, wave = __builtin_amdgcn_readfirstlane(tid >> 6);
    unsigned char* sbuf = lds + wave * S5_WREG; unsigned char* ubuf = sbuf + 8704; unsigned char* ybuf = sbuf + 9728;
    f32x4* Lbuf = (f32x4*)(lds + S5_LBUF);
    const int g = item & 31, bp = item >> 5;
    const int p32 = lane & 31, hf = lane >> 5;
    const float* atab = (const float*)(ws + WS_TAB + TAB_A);
    const float ar0 = atab[(g * 64 + p32) * 2], ai0 = atab[(g * 64 + p32) * 2 + 1];
    const float ar1 = atab[(g * 64 + p32 + 32) * 2], ai1 = atab[(g * 64 + p32 + 32) * 2 + 1];
    bf16x8 bb[4], cm[4];
#pragma unroll
    for (int q = 0; q < 4; ++q) {
        bb[q] = *(const bf16x8*)(ws + WS_TAB + TAB_BB + (((size_t)g * 4 + q) * 64 + lane) * 16);
        cm[q] = *(const bf16x8*)(ws + WS_TAB + TAB_CM + (((size_t)g * 4 + q) * 64 + lane) * 16);
    }
    const bf16* U = (const bf16*)(ws + WS_U);
    bf16* YG = (bf16*)(ws + WS_YG);
    const int a_seq = (p32 >> 2) & 1, a_ti = (p32 & 3) + 4 * (p32 >> 3);
    const int tbase = wave * 256;
    const bf16* ua = U + ((size_t)(2 * bp + a_seq) * SEQ + tbase + a_ti) * 512 + g * 16 + 8 * hf;
    const int ho = lane & 15, i4 = 4 * (lane >> 4);
    const float dsk = P.in[10][g * 16 + ho];
    const f32x16 z16 = {0.f, 0.f, 0.f, 0.f, 0.f, 0.f, 0.f, 0.f, 0.f, 0.f, 0.f, 0.f, 0.f, 0.f, 0.f, 0.f};
    float s0r = 0.f, s0i = 0.f, s1r = 0.f, s1i = 0.f;
    {
        bf16x8 afr[16];
#pragma unroll
        for (int blk = 0; blk < 16; ++blk) afr[blk] = *(const bf16x8*)(ua + (size_t)(blk * 16) * 512);
#pragma unroll
        for (int blk = 0; blk < 16; ++blk) {
            const bf16x8 af = afr[blk];
            const f32x16 b0r = mfma32_h(af, bb[0], z16, 0, 0, 0);
            const f32x16 b0i = mfma32_h(af, bb[1], z16, 0, 0, 0);
            const f32x16 b1r = mfma32_h(af, bb[2], z16, 0, 0, 0);
            const f32x16 b1i = mfma32_h(af, bb[3], z16, 0, 0, 0);
#pragma unroll
            for (int i = 0; i < 16; ++i) {
                float n0r = __builtin_fmaf(ar0, s0r, __builtin_fmaf(-ai0, s0i, b0r[i])); asm volatile("" : "+v"(n0r));
                float n0i = __builtin_fmaf(ar0, s0i, __builtin_fmaf(ai0, s0r, b0i[i]));  asm volatile("" : "+v"(n0i));
                float n1r = __builtin_fmaf(ar1, s1r, __builtin_fmaf(-ai1, s1i, b1r[i])); asm volatile("" : "+v"(n1r));
                float n1i = __builtin_fmaf(ar1, s1i, __builtin_fmaf(ai1, s1r, b1i[i]));  asm volatile("" : "+v"(n1i));
                s0r = n0r; s0i = n0i; s1r = n1r; s1i = n1i;
            }
        }
    }
    Lbuf[wave * 64 + lane] = (f32x4){s0r, s0i, s1r, s1i};
    __syncthreads();
    {
        float pr0 = ar0, pi0 = ai0, pr1 = ar1, pi1 = ai1;
#pragma unroll
        for (int i = 0; i < 8; ++i) {
            const float t0r = pr0 * pr0 - pi0 * pi0, t0i = 2.0f * pr0 * pi0, t1r = pr1 * pr1 - pi1 * pi1, t1i = 2.0f * pr1 * pi1;
            pr0 = t0r; pi0 = t0i; pr1 = t1r; pi1 = t1i;
        }
        s0r = 0.f; s0i = 0.f; s1r = 0.f; s1i = 0.f;
        for (int j = 0; j < wave; ++j) {
            const f32x4 L = Lbuf[j * 64 + lane];
            const float n0r = pr0 * s0r - pi0 * s0i + L.x, n0i = pr0 * s0i + pi0 * s0r + L.y;
            const float n1r = pr1 * s1r - pi1 * s1i + L.z, n1i = pr1 * s1i + pi1 * s1r + L.w;
            s0r = n0r; s0i = n0i; s1r = n1r; s1i = n1i;
        }
    }
    {
        bf16x8 af = *(const bf16x8*)ua;
        unsigned char* wrow = sbuf + (hf * 16) * 272 + 4 * p32;
        unsigned char* uw = ubuf + (a_seq * 16 + a_ti) * 32 + hf * 16;
        const int orow = lane >> 1, ohalf = lane & 1;
        bf16* yg_out = YG + ((size_t)(2 * bp + (orow >> 4)) * SEQ + tbase + (orow & 15)) * 512 + g * 16 + ohalf * 8;
        for (int blk = 0; blk < 16; ++blk) {
            const bf16x8 afn = *(const bf16x8*)(ua + (size_t)((blk < 15 ? blk + 1 : blk) * 16) * 512);
            *(bf16x8*)uw = af;
            const f32x16 b0r = mfma32_h(af, bb[0], z16, 0, 0, 0);
            const f32x16 b0i = mfma32_h(af, bb[1], z16, 0, 0, 0);
            const f32x16 b1r = mfma32_h(af, bb[2], z16, 0, 0, 0);
            const f32x16 b1i = mfma32_h(af, bb[3], z16, 0, 0, 0);
#pragma unroll
            for (int i = 0; i < 16; ++i) {
                float n0r = __builtin_fmaf(ar0, s0r, __builtin_fmaf(-ai0, s0i, b0r[i])); asm volatile("" : "+v"(n0r));
                float n0i = __builtin_fmaf(ar0, s0i, __builtin_fmaf(ai0, s0r, b0i[i]));  asm volatile("" : "+v"(n0i));
                float n1r = __builtin_fmaf(ar1, s1r, __builtin_fmaf(-ai1, s1i, b1r[i])); asm volatile("" : "+v"(n1r));
                float n1i = __builtin_fmaf(ar1, s1i, __builtin_fmaf(ai1, s1r, b1i[i]));  asm volatile("" : "+v"(n1i));
                s0r = n0r; s0i = n0i; s1r = n1r; s1i = n1i;
                *(unsigned*)(wrow + i * 272) = pk2(s0r, s0i);
                *(unsigned*)(wrow + i * 272 + 128) = pk2(s1r, s1i);
            }
            asm volatile("s_waitcnt lgkmcnt(0)" ::: "memory");
#pragma unroll
            for (int mb = 0; mb < 2; ++mb) {
                f32x4 y = {0.f, 0.f, 0.f, 0.f};
#pragma unroll
                for (int ks = 0; ks < 4; ++ks) {
                    const bf16x8 sf = *(const bf16x8*)(sbuf + (mb * 16 + (lane & 15)) * 272 + ks * 64 + (lane >> 4) * 16);
                    y = mfma16_h(sf, cm[ks], y, 0, 0, 0);
                }
#pragma unroll
                for (int r = 0; r < 4; ++r) {
                    const int ro = ((mb * 16 + i4 + r) * 32 + ho * 2);
                    const float yv = y[r] + dsk * bf2f(*(const bf16*)(ubuf + ro));
                    *(bf16*)(ybuf + ro) = (bf16)(pk2(geluf_(yv), 0.f) & 0xffffu);
                }
            }
            asm volatile("s_waitcnt lgkmcnt(0)" ::: "memory");
            const u32x4 yo = *(const u32x4*)(ybuf + orow * 32 + ohalf * 16);
            *(u32x4*)(yg_out + (size_t)(blk * 16) * 512) = yo;
            asm volatile("s_waitcnt lgkmcnt(0)" ::: "memory");
            af = afn;
        }
    }
    __syncthreads();
}

__device__ __forceinline__ void conv_phase(const Params& P, unsigned char* lds) {
    unsigned char* ws = P.ws;
    int tid_ = threadIdx.x; asm volatile("" : "+v"(tid_));
    const int tid = tid_, lane = tid & 63, wave = tid >> 6;
    const bf16* V = (const bf16*)(ws + WS_V);
    bf16* CV = (bf16*)(ws + WS_CV);
    unsigned char* vt = lds;
    float* ct = (float*)(lds + 63488);
    const int G = gridDim.x, nitems = T / 32;
    const int ch = tid;
    float w0[CW];
#pragma unroll
    for (int k = 0; k < CW; ++k) w0[k] = P.in[13][k * 512 + ch];
    const float cb0 = P.in[14][ch];
    const f32x4 g0 = *(const f32x4*)(P.in[15] + lane * 4), g1 = *(const f32x4*)(P.in[15] + 256 + lane * 4);
    const f32x4 b0 = *(const f32x4*)(P.in[16] + lane * 4), b1 = *(const f32x4*)(P.in[16] + 256 + lane * 4);
    u32x4 pf[8];
#define CONV_FETCH(item_) do { const int tokb_ = (item_) * 32, tloc_ = tokb_ & (SEQ - 1); \
        _Pragma("unroll") for (int n = 0; n < 8; ++n) { const int q = tid + n * NTHREADS; const int r = q >> 6, c16 = q & 63; \
            pf[n] = (u32x4){0u, 0u, 0u, 0u}; \
            if (q < 62 * 64 && tloc_ - 30 + r >= 0) pf[n] = *(const u32x4*)(V + (size_t)(tokb_ - 30 + r) * 512 + c16 * 8); } } while (0)
    int item = blockIdx.x;
    if (item < nitems) CONV_FETCH(item);
    for (; item < nitems; item += G) {
        const int tokb = item * 32;
#pragma unroll
        for (int n = 0; n < 8; ++n) { const int q = tid + n * NTHREADS; if (q < 62 * 64) *(u32x4*)(vt + (q >> 6) * 1024 + (q & 63) * 16) = pf[n]; }
        __syncthreads();
        if (item + G < nitems) CONV_FETCH(item + G);
#pragma unroll 1
        for (int jc = 0; jc < 4; ++jc) {
            const int base = jc * 8;
            float a0[8];
#pragma unroll
            for (int j = 0; j < 8; ++j) a0[j] = cb0;
#pragma unroll
            for (int r = 0; r < 38; ++r) {
                const float x0 = bf2f(*(const bf16*)(vt + (base + r) * 1024 + ch * 2));
#pragma unroll
                for (int j = 0; j < 8; ++j) {
                    const int k = r - j;
                    if (k >= 0 && k < CW) a0[j] += w0[k] * x0;
                }
            }
#pragma unroll
            for (int j = 0; j < 8; ++j) ct[(base + j) * 512 + ch] = a0[j];
        }
        __syncthreads();
#pragma unroll
        for (int rr = 0; rr < 4; ++rr) {
            const int row = wave * 4 + rr;
            const f32x4 c0 = *(const f32x4*)(ct + row * 512 + lane * 4), c1 = *(const f32x4*)(ct + row * 512 + 256 + lane * 4);
            const float mean = wave_sum((c0.x + c0.y) + (c0.z + c0.w) + (c1.x + c1.y) + (c1.z + c1.w)) * (1.0f / 512.0f);
            const f32x4 d0 = c0 - mean, d1 = c1 - mean;
            const float var = wave_sum((d0.x * d0.x + d0.y * d0.y) + (d0.z * d0.z + d0.w * d0.w) + (d1.x * d1.x + d1.y * d1.y) + (d1.z * d1.z + d1.w * d1.w)) * (1.0f / 512.0f);
            const float rstd = 1.0f / sqrtf(var + LN_EPS);
            const f32x4 y0 = d0 * rstd * g0 + b0, y1 = d1 * rstd * g1 + b1;
            u32x2 o0, o1;
            o0.x = pk2(siluf_(y0.x), siluf_(y0.y)); o0.y = pk2(siluf_(y0.z), siluf_(y0.w));
            o1.x = pk2(siluf_(y1.x), siluf_(y1.y)); o1.y = pk2(siluf_(y1.z), siluf_(y1.w));
            bf16* orow = CV + (size_t)(tokb + row) * 512;
            *(u32x2*)(orow + lane * 4) = o0; *(u32x2*)(orow + 256 + lane * 4) = o1;
        }
        __syncthreads();
    }
#undef CONV_FETCH
}

__device__ __forceinline__ void ln1_rows(const Params& P) {
    const int tid = threadIdx.x, lane = tid & 63, wave = tid >> 6;
    const int gw = blockIdx.x * 8 + wave, NGW = gridDim.x * 8;
    const float* PRE = P.out; bf16* HB = (bf16*)(P.ws + WS_HB);
    const float* lg = P.in[21]; const float* lb = P.in[22];
    f32x4 g[4], b[4];
#pragma unroll
    for (int j = 0; j < 4; ++j) { g[j] = *(const f32x4*)(lg + j * 256 + lane * 4); b[j] = *(const f32x4*)(lb + j * 256 + lane * 4); }
    for (int row = gw; row < T; row += NGW) {
        const float* xr = PRE + (size_t)row * 1024;
        f32x4 v[4]; float s = 0.f;
#pragma unroll
        for (int j = 0; j < 4; ++j) { v[j] = *(const f32x4*)(xr + j * 256 + lane * 4); s += (v[j].x + v[j].y) + (v[j].z + v[j].w); }
        const float mean = wave_sum(s) * (1.0f / 1024.0f); float s2 = 0.f;
#pragma unroll
        for (int j = 0; j < 4; ++j) { v[j] = v[j] - mean; s2 += (v[j].x * v[j].x + v[j].y * v[j].y) + (v[j].z * v[j].z + v[j].w * v[j].w); }
        const float rstd = 1.0f / sqrtf(wave_sum(s2) * (1.0f / 1024.0f) + LN_EPS);
        bf16* orow = HB + (size_t)row * 1024;
#pragma unroll
        for (int j = 0; j < 4; ++j) {
            const f32x4 y = v[j] * rstd * g[j] + b[j];
            u32x2 w; w.x = pk2(y.x, y.y); w.y = pk2(y.z, y.w);
            *(u32x2*)(orow + j * 256 + lane * 4) = w;
        }
    }
}
__device__ __forceinline__ void final_rows(const Params& P) {
    int tid_ = threadIdx.x; asm volatile("" : "+v"(tid_));
    const int tid = tid_, lane = tid & 63, wave = tid >> 6;
    const int gw = blockIdx.x * 8 + wave, NGW = gridDim.x * 8;
    const bf16* HB = (const bf16*)(P.ws + WS_HB); const bf16* YM = (const bf16*)(P.ws + WS_YM);
    const float* lg = P.in[30]; const float* lb = P.in[31];
    f32x4 g[4], b[4];
#pragma unroll
    for (int j = 0; j < 4; ++j) { g[j] = *(const f32x4*)(lg + j * 256 + lane * 4); b[j] = *(const f32x4*)(lb + j * 256 + lane * 4); }
#pragma unroll 2
    for (int row = gw; row < T; row += NGW) {
        f32x4 v[4]; float s = 0.f;
#pragma unroll
        for (int j = 0; j < 4; ++j) {
            const u32x2 h = *(const u32x2*)(HB + (size_t)row * 1024 + j * 256 + lane * 4);
            const u32x2 y0 = *(const u32x2*)(YM + (size_t)(2 * row) * 1024 + j * 256 + lane * 4);
            const u32x2 y1 = *(const u32x2*)(YM + (size_t)(2 * row + 1) * 1024 + j * 256 + lane * 4);
            v[j].x = ALPHA * bflo(h.x) + bflo(y0.x) + bflo(y1.x); v[j].y = ALPHA * bfhi(h.x) + bfhi(y0.x) + bfhi(y1.x);
            v[j].z = ALPHA * bflo(h.y) + bflo(y0.y) + bflo(y1.y); v[j].w = ALPHA * bfhi(h.y) + bfhi(y0.y) + bfhi(y1.y);
            s += (v[j].x + v[j].y) + (v[j].z + v[j].w);
        }
        const float mean = wave_sum(s) * (1.0f / 1024.0f); float s2 = 0.f;
#pragma unroll
        for (int j = 0; j < 4; ++j) { v[j] = v[j] - mean; s2 += (v[j].x * v[j].x + v[j].y * v[j].y) + (v[j].z * v[j].z + v[j].w * v[j].w); }
        const float rstd = 1.0f / sqrtf(wave_sum(s2) * (1.0f / 1024.0f) + LN_EPS);
        float* orow = P.out + (size_t)row * 1024;
#pragma unroll
        for (int j = 0; j < 4; ++j) *(f32x4*)(orow + j * 256 + lane * 4) = v[j] * rstd * g[j] + b[j];
    }
}
struct EpiZlds {
    float* Zs;
    __device__ __forceinline__ void operator()(const f32x4 (&acc)[4][4], int r_in, int c_in) const {
        if (c_in >= 64) return;
#pragma unroll
        for (int mi = 0; mi < 4; ++mi)
#pragma unroll
            for (int ni = 0; ni < 3; ++ni) {
                const int c = c_in + ni * 16;
                if (c < 40) *(f32x4*)(Zs + (r_in + mi * 16) * 40 + c) = acc[mi][ni];
            }
    }
};
__device__ __forceinline__ void ln_route_phase(const Params& P, unsigned char* lds) {
    unsigned char* ws = P.ws;
    int tid_ = threadIdx.x; asm volatile("" : "+v"(tid_));
    const int tid = tid_, lane = tid & 63, wave = tid >> 6, r = lane & 15, q = lane >> 4;
    const bf16* PREB = (const bf16*)(ws + WS_PREB); bf16* HB = (bf16*)(ws + WS_HB);
    int* CNT = (int*)(ws + WS_CTL); int* TOK = (int*)(ws + WS_TOK); float* GATE = (float*)(ws + WS_GATE);
    const float* lg = P.in[21]; const float* lb = P.in[22];
    const float* brg = P.in[24]; const float* bre = P.in[26];
    unsigned char* wl = lds;
    float* gl = (float*)(lds + 74304);
    float* zt = (float*)(lds + 82496 + wave * 3328);
    int* hist = (int*)(lds + 109120); int* base = hist + 32;
    for (int t = blockIdx.x; t < T / 128; t += gridDim.x) {
        asm volatile("" ::: "memory");
        int q8 = q * 8, ro = r * 1024 + q * 8;
        asm volatile("" : "+v"(q8), "+v"(ro));
#pragma unroll
        for (int i = 0; i < 9; ++i) {
            const int h = i * 8 + wave, wrow = h >> 1, half = h & 1;
            glds16((const bf16*)(ws + WS_WR) + wrow * 1024 + half * 512 + lane * 8, wl + wrow * 2064 + half * 1024 + lane * 16);
        }
        glds16(tid < 256 ? lg + tid * 4 : lb + (tid - 256) * 4, (unsigned char*)gl + tid * 16);
        const unsigned char* wrp0 = wl + (ro >> 10) * 2064 + q8 * 2;
        const unsigned char* wrp2 = wl + (32 + ((ro >> 10) & 3)) * 2064 + q8 * 2;
        const float* lgq = gl + q8; const float* lbq = gl + 1024 + q8;
        if (tid < 32) hist[tid] = 0;
        const size_t row = (size_t)t * 128 + wave * 16 + r;
        const bf16* prow = PREB + row * 1024 + q8;
        u32x4 pv[32];
#pragma unroll
        for (int s = 0; s < 32; ++s) pv[s] = *(const u32x4*)(prow + s * 32);
        float sm = 0.f;
#pragma unroll
        for (int s = 0; s < 32; ++s)
            sm += ((bflo(pv[s].x) + bfhi(pv[s].x)) + (bflo(pv[s].y) + bfhi(pv[s].y))) + ((bflo(pv[s].z) + bfhi(pv[s].z)) + (bflo(pv[s].w) + bfhi(pv[s].w)));
        sm += __shfl_xor(sm, 16); sm += __shfl_xor(sm, 32);
        const float mean = sm * (1.0f / 1024.0f);
#pragma unroll
        for (int s = 0; s < 32; ++s) asm volatile("" : "+v"(pv[s]));
        float s2 = 0.f;
#pragma unroll
        for (int s = 0; s < 32; ++s) {
            const float d0 = bflo(pv[s].x) - mean, d1 = bfhi(pv[s].x) - mean, d2 = bflo(pv[s].y) - mean, d3 = bfhi(pv[s].y) - mean;
            const float d4 = bflo(pv[s].z) - mean, d5 = bfhi(pv[s].z) - mean, d6 = bflo(pv[s].w) - mean, d7 = bfhi(pv[s].w) - mean;
            s2 += ((d0 * d0 + d1 * d1) + (d2 * d2 + d3 * d3)) + ((d4 * d4 + d5 * d5) + (d6 * d6 + d7 * d7));
        }
        s2 += __shfl_xor(s2, 16); s2 += __shfl_xor(s2, 32);
        const float rstd = 1.0f / sqrtf(s2 * (1.0f / 1024.0f) + LN_EPS);
#pragma unroll
        for (int s = 0; s < 32; ++s) asm volatile("" : "+v"(pv[s]));
        asm volatile("s_waitcnt vmcnt(0)" ::: "memory");
        __syncthreads();
        f32x4 acc[3];
#pragma unroll
        for (int i = 0; i < 3; ++i) acc[i] = (f32x4){0.f, 0.f, 0.f, 0.f};
        bf16* hrow = HB + row * 1024 + q8;
#pragma unroll
        for (int s = 0; s < 32; ++s) {
            const f32x4 g0 = *(const f32x4*)(lgq + s * 32), g1 = *(const f32x4*)(lgq + s * 32 + 4);
            const f32x4 b0 = *(const f32x4*)(lbq + s * 32), b1 = *(const f32x4*)(lbq + s * 32 + 4);
            const f32x4 v0 = {bflo(pv[s].x), bfhi(pv[s].x), bflo(pv[s].y), bfhi(pv[s].y)}, v1 = {bflo(pv[s].z), bfhi(pv[s].z), bflo(pv[s].w), bfhi(pv[s].w)};
            const f32x4 y0 = (v0 - mean) * rstd * g0 + b0, y1 = (v1 - mean) * rstd * g1 + b1;
            u32x4 w; w.x = pk2(y0.x, y0.y); w.y = pk2(y0.z, y0.w); w.z = pk2(y1.x, y1.y); w.w = pk2(y1.z, y1.w);
            *(u32x4*)(hrow + s * 32) = w;
            const bf16x8 a = __builtin_bit_cast(bf16x8, w);
            acc[0] = mfma16_h(*(const bf16x8*)(wrp0 + s * 64), a, acc[0], 0, 0, 0);
            acc[1] = mfma16_h(*(const bf16x8*)(wrp0 + 16 * 2064 + s * 64), a, acc[1], 0, 0, 0);
            acc[2] = mfma16_h(*(const bf16x8*)(wrp2 + s * 64), a, acc[2], 0, 0, 0);
        }
#pragma unroll
        for (int nt = 0; nt < 3; ++nt) *(f32x4*)(zt + r * 52 + nt * 16 + 4 * q) = acc[nt];
        __syncthreads();
        const size_t tok = (size_t)t * 128 + wave * 16 + lane;
        int e0 = 0, e1 = 0, r0 = 0, r1 = 0;
        if (lane < 16) {
            const float* z = zt + lane * 52;
            float zg[4];
#pragma unroll
            for (int i = 0; i < 4; ++i) zg[i] = z[i] + brg[i];
            int gs = 0; float mx = zg[0];
#pragma unroll
            for (int i = 1; i < 4; ++i) if (zg[i] > mx) { mx = zg[i]; gs = i; }
            float den = 0.f;
#pragma unroll
            for (int i = 0; i < 4; ++i) den += __expf(zg[i] - mx);
            const float pgrp = 1.0f / den;
            float ze[8];
#pragma unroll
            for (int i = 0; i < 8; ++i) ze[i] = z[4 + gs * 8 + i] + bre[gs * 8 + i];
            int i0 = 0; float v0 = ze[0];
#pragma unroll
            for (int i = 1; i < 8; ++i) if (ze[i] > v0) { v0 = ze[i]; i0 = i; }
            int i1 = -1; float v1 = -3.0e38f;
#pragma unroll
            for (int i = 0; i < 8; ++i) if (i != i0 && ze[i] > v1) { v1 = ze[i]; i1 = i; }
            const float sx = __expf(v1 - v0);
            const float g0 = pgrp / (1.0f + sx), g1 = pgrp * sx / (1.0f + sx);
            e0 = gs * 8 + i0; e1 = gs * 8 + i1;
            GATE[tok * 2] = g0; GATE[tok * 2 + 1] = g1;
            r0 = atomicAdd(&hist[e0], 1); r1 = atomicAdd(&hist[e1], 1);
        }
        __syncthreads();
        if (tid < 32) base[tid] = atomicAdd(&CNT[tid], hist[tid]);
        __syncthreads();
        if (lane < 16) {
            TOK[(size_t)e0 * T + base[e0] + r0] = (int)(tok * 2);
            TOK[(size_t)e1 * T + base[e1] + r1] = (int)(tok * 2 + 1);
        }
        __syncthreads();
    }
}

#define LAS __attribute__((address_space(3)))
#define XB_TMO      128
#define XB_XCNT(j)  (256  + 64 * (j))
#define XB_XSUB(j)  (1280 + 64 * (j))
#define XB_XGEN(j)  (2304 + 64 * (j))
#define XB_TOP      3328
#define XB_TOPGEN   3392
#define XCD_BAR_WORDS 3456
#define XB_SPIN_CAP (1u << 20)
__device__ __forceinline__ unsigned xb_ld(unsigned* p)              { return __hip_atomic_load(p, __ATOMIC_RELAXED, __HIP_MEMORY_SCOPE_AGENT); }
__device__ __forceinline__ unsigned xb_add(unsigned* p, unsigned v) { return __hip_atomic_fetch_add(p, v, __ATOMIC_RELAXED, __HIP_MEMORY_SCOPE_AGENT); }
__device__ __forceinline__ unsigned xb_xcc_id() { return (unsigned)__builtin_amdgcn_s_getreg((3 << 11) | 20) & 0xFu; }
#define XB_SPIN(cond, bar) do { unsigned _sp = 0; while (cond) { __builtin_amdgcn_s_sleep(1); \
    if ((++_sp & 255u) == 0u) { if (xb_ld(&(bar)[XB_TMO])) break; if (_sp > XB_SPIN_CAP) { atomicAdd(&(bar)[XB_TMO], 1u); break; } } } } while (0)
struct XcdBarrier { unsigned* bar; unsigned x; volatile LAS unsigned* st; };
__device__ __forceinline__ XcdBarrier xcd_barrier_post(unsigned* bar, volatile LAS unsigned* st) {
    XcdBarrier b; b.bar = bar; b.x = xb_xcc_id(); b.st = st;
    if (threadIdx.x == 0) (void)xb_add(&bar[XB_XCNT(b.x)], 1u);
    return b;
}
__device__ __forceinline__ void xcd_barrier_complete(unsigned* bar, unsigned x, unsigned& nloc, unsigned& nx) {
    const unsigned G = gridDim.x * gridDim.y * gridDim.z;
    unsigned sum, cnt, mine, sp = 0u;
    for (;;) {
        sum = 0u; cnt = 0u; mine = 0u;
#pragma unroll
        for (unsigned j = 0; j < 16; ++j) { const unsigned c = xb_ld(&bar[XB_XCNT(j)]); sum += c; cnt += (c > 0u) ? 1u : 0u; mine = (j == x) ? c : mine; }
        if (sum == G) break;
        __builtin_amdgcn_s_sleep(1);
        if ((++sp & 255u) == 0u) { if (xb_ld(&bar[XB_TMO])) break; if (sp > XB_SPIN_CAP) { atomicAdd(&bar[XB_TMO], 1u); break; } }
    }
    nloc = mine > 0u ? mine : 1u; nx = cnt > 0u ? cnt : 1u;
}
__device__ __forceinline__ void xcd_barrier(const XcdBarrier& b) {
    asm volatile("s_waitcnt vmcnt(0)" ::: "memory");
    __syncthreads();
    if (threadIdx.x == 0) {
        unsigned* bar = b.bar;
        __builtin_amdgcn_s_waitcnt(0);
        unsigned nloc = b.st[0], nx = b.st[1];
        if (nloc == 0u) { xcd_barrier_complete(bar, b.x, nloc, nx); b.st[0] = nloc; b.st[1] = nx; }
        const unsigned old = xb_add(&bar[XB_XSUB(b.x)], 1u);
        const unsigned gen = old / nloc;
        if (old + 1u == (gen + 1u) * nloc) {
            __builtin_amdgcn_fence(__ATOMIC_RELEASE, "agent");
            asm volatile("s_waitcnt vmcnt(0)" ::: "memory");
            const unsigned og = xb_add(&bar[XB_TOP], 1u);
            const unsigned tg = og / nx;
            if (og + 1u == (tg + 1u) * nx) xb_add(&bar[XB_TOPGEN], 1u);
            else XB_SPIN(xb_ld(&bar[XB_TOPGEN]) == tg, bar);
            __builtin_amdgcn_fence(__ATOMIC_ACQUIRE, "agent");
            xb_add(&bar[XB_XGEN(b.x)], 1u);
            asm volatile("s_waitcnt vmcnt(0)" ::: "memory");
        } else {
            XB_SPIN(xb_ld(&bar[XB_XGEN(b.x)]) == gen, bar);
            __builtin_amdgcn_fence(__ATOMIC_ACQUIRE, "agent");
            asm volatile("s_waitcnt vmcnt(0)" ::: "memory");
        }
    }
    __syncthreads();
}

__device__ __forceinline__ void run_phase(const Params& P, unsigned char* lds, int ph) {
    unsigned char* ws = P.ws;
    const int G = gridDim.x, bid = blockIdx.x;
    switch (ph) {
    case 0: phase_prep(P, lds); break;
    case 1: {
        pg8::Gemm g{(const pg8::bf16_t*)(ws + WS_XB), (const pg8::bf16_t*)(ws + WS_WIN), T, DIN, D};
        pg8::StaticOrder S; S.init(T, DIN, G, bid);
        pg8::EpiProj E{(const float*)(ws + WS_TAB + TAB_BINP), (bf16*)(ws + WS_U), (bf16*)(ws + WS_V), (bf16*)(ws + WS_SGS), (bf16*)(ws + WS_SGC)};
        pg8::gemm_phase<pg8::EpiProj, pg8::StaticOrder, true, true>((PG8_LAS unsigned char*)lds, g, S, E);
    } break;
    case 2: {
        for (int it = bid; it < 256; it += G) s5_block_item(P, lds, it);
        conv_phase(P, lds);
    } break;
    case 3: {
        static_assert(WS_CV == WS_YG + (size_t)T * DSSM * 2 && WS_WCOUT == WS_WGLU + (size_t)2 * D * DSSM * 2 && DSSM == DCONV && T / 256 == 128, "virtual operands must be contiguous");
        pg8::Gemm g{(const pg8::bf16_t*)(ws + WS_YG), (const pg8::bf16_t*)(ws + WS_WGLU), 2 * T, 3 * D, DSSM};
        pg8::TripleOrder S; S.so.init(T, D, G, bid);
        pg8::EpiCG E{{P.in[18], (const bf16*)(ws + WS_SGC), (bf16*)(ws + WS_M1)},
                     {(const float*)(ws + WS_TAB + TAB_BGLUP), (const bf16*)(ws + WS_SGS), (const bf16*)(ws + WS_M1), (bf16*)(ws + WS_MERGED)}};
        pg8::gemm_phase<pg8::EpiCG, pg8::TripleOrder, true, true>((PG8_LAS unsigned char*)lds, g, S, E);
    } break;
    case 5: {
        pg8::Gemm g{(const pg8::bf16_t*)(ws + WS_MERGED), (const pg8::bf16_t*)(ws + WS_WOUT), T, D, D};
        pg8::StaticOrder S; S.init(T, D, G, bid);
        pg8::EpiOut E{P.in[20], (const bf16*)(ws + WS_XB), (bf16*)(ws + WS_PREB), ALPHA};
        pg8::gemm_phase<pg8::EpiOut, pg8::StaticOrder, true, true>((PG8_LAS unsigned char*)lds, g, S, E);
    } break;
    case 6: ln_route_phase(P, lds); break;
    case 9: {
        const int* CNT = (const int*)(ws + WS_CTL);
        PG8_LAS int* tab = (PG8_LAS int*)((PG8_LAS unsigned char*)lds + LDS_MISC + 64);
        if (threadIdx.x == 0) {
            int up = 0, bp = 0;
            for (int e = 0; e < NEXP; ++e) { const int cnt = CNT[e], nb = (cnt + 255) >> 8; tab[e] = up; tab[64 + e] = bp; tab[128 + e] = cnt; up += nb * 2; bp += nb; }
            tab[32] = up; tab[96] = bp;
        }
        __syncthreads();
        pg8::Gemm g{(const pg8::bf16_t*)(ws + WS_HB), (const pg8::bf16_t*)(ws + WS_WGU), 0, NEXP * 512, D};
        pg8::MoeOrder S{tab, G, bid, 1};
        pg8::MoeRows R{tab, (const int*)(ws + WS_TOK), T, (unsigned)(D * 2)};
        pg8::EpiGUP E{(bf16*)(ws + WS_HID)};
        pg8::gemm_phase_gather<pg8::EpiGUP, pg8::MoeOrder, pg8::MoeRows>((PG8_LAS unsigned char*)lds, g, S, E, R);
        __syncthreads();
    } break;
    case 10: {
        const int* CNT = (const int*)(ws + WS_CTL);
        PG8_LAS int* tab = (PG8_LAS int*)((PG8_LAS unsigned char*)lds + LDS_MISC + 64);
        if (threadIdx.x == 0) {
            int up = 0, bp = 0;
            for (int e = 0; e < NEXP; ++e) { const int cnt = CNT[e], nb = (cnt + 255) >> 8; tab[e] = up; tab[64 + e] = bp; tab[128 + e] = cnt; up += nb * 4; bp += nb; }
            tab[32] = up; tab[96] = bp;
        }
        __syncthreads();
        pg8::Gemm g{(const pg8::bf16_t*)(ws + WS_HID), (const pg8::bf16_t*)(ws + WS_WD), 0, NEXP * D, DFF};
        pg8::MoeOrder S{tab, G, bid, 2};
        pg8::EpiDownP E{tab, (const int*)(ws + WS_TOK), (const float*)(ws + WS_GATE), (bf16*)(ws + WS_YM), (bf16*)(ws + WS_Z), T};
        pg8::gemm_phase<pg8::EpiDownP, pg8::MoeOrder, true, true>((PG8_LAS unsigned char*)lds, g, S, E);
    } break;
    case 11: final_rows(P); break;
    default: break;
    }
}

#if ONE_LAUNCH
__global__ void __launch_bounds__(NTHREADS) fwd_kernel(Params P) {
    extern __shared__ __attribute__((aligned(16))) unsigned char lds[];
    if (P.ph_hi < 0) cg::this_grid().sync();
    volatile LAS unsigned* misc = (volatile LAS unsigned*)(LAS unsigned char*)(lds + LDS_MISC);
    if (threadIdx.x < 4) misc[threadIdx.x] = 0u;
    __syncthreads();
    XcdBarrier bar = xcd_barrier_post((unsigned*)(P.ws + WS_CTL) + CTL_BAR, misc);
#define GSYNC() xcd_barrier(bar)
    run_phase(P, lds, 0); GSYNC();
    run_phase(P, lds, 1); GSYNC();
    run_phase(P, lds, 2); GSYNC();
    run_phase(P, lds, 3); GSYNC();
    run_phase(P, lds, 5); GSYNC();
    run_phase(P, lds, 6); GSYNC();
    run_phase(P, lds, 9); GSYNC();
    run_phase(P, lds, 10); GSYNC();
    run_phase(P, lds, 11);
}
#else
template <int PH>
__global__ void __launch_bounds__(NTHREADS) phase_kernel(Params P) {
    extern __shared__ __attribute__((aligned(16))) unsigned char lds[];
    run_phase(P, lds, PH);
}
template <int PH> static void launch_phase(int grid, const Params& p, hipStream_t stream) {
    static bool init = false;
    if (!init) { (void)hipFuncSetAttribute((const void*)phase_kernel<PH>, hipFuncAttributeMaxDynamicSharedMemorySize, LDS_BYTES); init = true; }
    hipLaunchKernelGGL(phase_kernel<PH>, dim3(grid), dim3(NTHREADS), LDS_BYTES, stream, p);
}
#endif

extern "C" void kernel_launch(void* const* d_in, const int* in_sizes, int n_in, void* d_out, int out_size, void* d_ws, size_t ws_size, hipStream_t stream) {
    static int grid = 0;
    if (grid == 0) {
        if (n_in != 32 || in_sizes[0] != T * D || out_size != T * D || ws_size < WS_END) {
            fprintf(stderr, "kernel_launch: unexpected shapes (n_in %d, in0 %d, out %d, ws %zu)\n", n_in, n_in > 0 ? in_sizes[0] : -1, out_size, ws_size);
            grid = -1; return;
        }
        int dev = 0, cus = 0, per_cu = 1;
        (void)hipGetDevice(&dev);
        (void)hipDeviceGetAttribute(&cus, hipDeviceAttributeMultiprocessorCount, dev);
#if ONE_LAUNCH
        (void)hipFuncSetAttribute((const void*)fwd_kernel, hipFuncAttributeMaxDynamicSharedMemorySize, LDS_BYTES);
        (void)hipOccupancyMaxActiveBlocksPerMultiprocessor(&per_cu, (const void*)fwd_kernel, NTHREADS, LDS_BYTES);
        if (per_cu < 1) per_cu = 1;
#endif
        grid = cus * per_cu;
        (void)hipGetLastError();
    }
    if (grid < 0) return;
    if (hipMemsetAsync((char*)d_ws + WS_CTL, 0, CTL_ZERO_BYTES, stream) != hipSuccess) { fprintf(stderr, "kernel_launch: memset failed\n"); return; }
    Params p{};
    for (int i = 0; i < 32; ++i) p.in[i] = (const float*)d_in[i];
    p.out = (float*)d_out; p.ws = (unsigned char*)d_ws;
#if ONE_LAUNCH
    p.ph_lo = 0; p.ph_hi = NPHASE;
    void* args[] = {&p};
    hipError_t e = hipLaunchCooperativeKernel((const void*)fwd_kernel, dim3(grid), dim3(NTHREADS), args, LDS_BYTES, stream);
    if (e != hipSuccess) fprintf(stderr, "cooperative launch failed: %s (grid %d)\n", hipGetErrorString(e), grid);
#else
    p.ph_lo = 0; p.ph_hi = NPHASE;
    launch_phase<0>(grid, p, stream); launch_phase<1>(grid, p, stream); launch_phase<2>(grid, p, stream); launch_phase<3>(grid, p, stream);
    launch_phase<4>(grid, p, stream); launch_phase<5>(grid, p, stream); launch_phase<6>(grid, p, stream); launch_phase<7>(grid, p, stream);
    launch_phase<8>(grid, p, stream); launch_phase<9>(grid, p, stream); launch_phase<10>(grid, p, stream); launch_phase<11>(grid, p, stream);
#endif
}
```

```cpp
#include <hip/hip_runtime.h>
#include <hip/hip_cooperative_groups.h>
#include <cstdio>
#include <cstdint>
namespace cg = cooperative_groups;

#ifndef ONE_LAUNCH
#define ONE_LAUNCH 1
#endif

typedef unsigned short bf16;
typedef short bf16x8 __attribute__((ext_vector_type(8)));
typedef float f32x4 __attribute__((ext_vector_type(4)));
typedef float f32x16 __attribute__((ext_vector_type(16)));
typedef unsigned u32x2 __attribute__((ext_vector_type(2)));
typedef unsigned u32x4 __attribute__((ext_vector_type(4)));

constexpr int T = 32768, D = 1024, SEQ = 2048, NB = 16;
constexpr int DIN = 3584, DSSM = 512, NGRP = 32, NST = 64, NH = 16, DCONV = 512, CW = 31;
constexpr int NEXP = 32, DFF = 256;
constexpr float LN_EPS = 1e-5f;
constexpr float ALPHA = 1.189207115002721f;
constexpr int NPHASE = 12;
constexpr int NTHREADS = 512;
constexpr int LDS_BYTES = 131072 + 2048, LDS_MISC = 131072;
constexpr int CTL_BAR = 4096;
constexpr size_t CTL_ZERO_BYTES = 65536;

constexpr size_t MiB = 1u << 20;
constexpr size_t WS_CTL = 0;
constexpr size_t WS_TAB = 1 * MiB;
constexpr size_t TAB_BINP = 0, TAB_BGLUP = 16384, TAB_A = 32768, TAB_BB = 65536, TAB_CM = 65536 + 131072;
constexpr size_t WS_WIN = 2 * MiB, WS_WGLU = 9 * MiB, WS_WCOUT = 11 * MiB, WS_WOUT = 12 * MiB, WS_WR = 14 * MiB;
constexpr size_t WS_WGU = 16 * MiB, WS_WD = 48 * MiB;
constexpr size_t WS_M1 = 128 * MiB, WS_PREB = 256 * MiB;
constexpr size_t WS_XB = 64 * MiB, WS_U = 128 * MiB, WS_V = 160 * MiB, WS_YM = 64 * MiB;
constexpr size_t WS_SGS = 192 * MiB, WS_HB = 192 * MiB, WS_SGC = 256 * MiB;
constexpr size_t WS_YG = 320 * MiB, WS_CV = 352 * MiB, WS_MERGED = 384 * MiB;
constexpr size_t WS_HID = 448 * MiB, WS_Z = 488 * MiB, WS_TOK = 496 * MiB, WS_GATE = 500 * MiB, WS_END = 501 * MiB;

struct Params {
    const float* in[32];
    float* out;
    unsigned char* ws;
    int ph_lo, ph_hi;
};

typedef float f32x2_t __attribute__((ext_vector_type(2)));
typedef _Float16 h2_t __attribute__((ext_vector_type(2)));
typedef _Float16 h8_t __attribute__((ext_vector_type(8)));
__device__ __forceinline__ unsigned pk2(float lo, float hi) { const f32x2_t v = {lo, hi}; const h2_t h = __builtin_convertvector(v, h2_t); return __builtin_bit_cast(unsigned, h); }
__device__ __forceinline__ unsigned f2bf(float f) { return pk2(f, 0.f) & 0xffffu; }
__device__ __forceinline__ float bflo(unsigned w) { return (float)__builtin_bit_cast(h2_t, w).x; }
__device__ __forceinline__ float bfhi(unsigned w) { return (float)__builtin_bit_cast(h2_t, w).y; }
__device__ __forceinline__ float bf2f(bf16 b) { return (float)__builtin_bit_cast(_Float16, b); }
__device__ __forceinline__ f32x4 mfma16_h(bf16x8 a, bf16x8 b, f32x4 c, int, int, int) { return __builtin_amdgcn_mfma_f32_16x16x32_f16(__builtin_bit_cast(h8_t, a), __builtin_bit_cast(h8_t, b), c, 0, 0, 0); }
__device__ __forceinline__ f32x16 mfma32_h(bf16x8 a, bf16x8 b, f32x16 c, int, int, int) { return __builtin_amdgcn_mfma_f32_32x32x16_f16(__builtin_bit_cast(h8_t, a), __builtin_bit_cast(h8_t, b), c, 0, 0, 0); }
__device__ __forceinline__ float sigmoidf_(float z) { return __builtin_amdgcn_rcpf(1.0f + __expf(-z)); }
__device__ __forceinline__ float siluf_(float z) { return z * sigmoidf_(z); }
__device__ __forceinline__ float geluf_(float x) { const float z = 1.5957691216057308f * (x + 0.044715f * x * x * x); return x * sigmoidf_(z); }
__device__ __forceinline__ float wave_sum(float v) {
    v += __builtin_bit_cast(float, __builtin_amdgcn_update_dpp(0, __builtin_bit_cast(int, v), 0xB1, 0xF, 0xF, true));
    v += __builtin_bit_cast(float, __builtin_amdgcn_update_dpp(0, __builtin_bit_cast(int, v), 0x4E, 0xF, 0xF, true));
    v += __builtin_bit_cast(float, __builtin_amdgcn_update_dpp(0, __builtin_bit_cast(int, v), 0x141, 0xF, 0xF, true));
    v += __builtin_bit_cast(float, __builtin_amdgcn_update_dpp(0, __builtin_bit_cast(int, v), 0x140, 0xF, 0xF, true));
    const int iv = __builtin_bit_cast(int, v);
    const float r0 = __builtin_bit_cast(float, __builtin_amdgcn_readlane(iv, 0)), r1 = __builtin_bit_cast(float, __builtin_amdgcn_readlane(iv, 16));
    const float r2 = __builtin_bit_cast(float, __builtin_amdgcn_readlane(iv, 32)), r3 = __builtin_bit_cast(float, __builtin_amdgcn_readlane(iv, 48));
    return (r0 + r1) + (r2 + r3);
}
__device__ __forceinline__ void glds16(const void* g, void* l) {
    __builtin_amdgcn_global_load_lds((const __attribute__((address_space(1))) unsigned*)g, (__attribute__((address_space(3))) unsigned*)l, 16, 0, 0);
}

namespace pg8 {
#define PG8_LAS __attribute__((address_space(3)))
typedef unsigned short bf16_t;
typedef short bf16x8 __attribute__((ext_vector_type(8)));
typedef float f32x4 __attribute__((ext_vector_type(4)));
typedef unsigned u32x4 __attribute__((ext_vector_type(4)));
constexpr int BM = 256, BK = 64, HALF = 128, HTB = HALF * BK * 2  , STAGE_BYTES = 8 * HTB, NXCD = 8, WGM = 8;

__host__ __device__ __forceinline__ int lds_byte(int r, int c) { const int st = (r >> 4) * 2 + (c >> 5), rr = r & 15, cc = c & 31, ob = rr * 64 + cc * 2; return st * 1024 + (ob ^ (((ob >> 9) & 1) << 5)); }
__host__ __device__ __forceinline__ void stage_rc(int b, int& R, int& C) { const int st = b / 1024, sb = b % 1024, swz = sb ^ (((sb >> 9) & 1) << 5); R = (st >> 1) * 16 + swz / 64; C = (st & 1) * 32 + (swz % 64) / 2; }
__host__ __device__ __forceinline__ int perm32(int rho) { const int n = rho >> 4, i = rho & 15; return 8 * (i >> 2) + 4 * n + (i & 3); }

struct Unit { int pm, pn; };
struct Gemm { const bf16_t* A; const bf16_t* Bt; int M, N, K; };

struct StaticOrder {
    int nM, nN, nwg, G, c;
    __host__ __device__ void init(int M, int N, int G_, int c_) { nM = M / BM; nN = N / BM; nwg = nM * nN; G = G_; c = c_; }
    __host__ __device__ bool next(int i, Unit& u) const {
        const long L = (long)i * G + c; if (L >= nwg) return false;
        int wgid = (int)L; { const int q = nwg / NXCD, r = nwg % NXCD, xcd = wgid % NXCD, off = wgid / NXCD; wgid = (xcd < r ? xcd * (q + 1) : r * (q + 1) + (xcd - r) * q) + off; }
        const int nig = WGM * nN, gid = wgid / nig, fm = gid * WGM, gsz = (nM - fm) < WGM ? (nM - fm) : WGM;
        u.pm = fm + ((wgid % nig) % gsz); u.pn = (wgid % nig) / gsz; return true;
    }
    __device__ __forceinline__ void a_ready(const Unit&) const {}
    __device__ __forceinline__ void done(const Unit&) const {}
};

__device__ __forceinline__ unsigned pk2_(float lo, float hi) { return ::pk2(lo, hi); }
__device__ __forceinline__ float sg_(float z) { return __builtin_amdgcn_rcpf(1.0f + __expf(-z)); }
__device__ __forceinline__ float lo_(unsigned w) { return ::bflo(w); }
__device__ __forceinline__ float hi_(unsigned w) { return ::bfhi(w); }
typedef unsigned u32x2 __attribute__((ext_vector_type(2)));
struct EpiProj {
    static constexpr bool PERM = true, AFTER_DRAIN = false;
    const float* binp; bf16_t* U; bf16_t* V; bf16_t* SGS; bf16_t* SGC;
    __device__ __forceinline__ void operator()(const f32x4 (&acc)[2][2][4][2], const Unit& u, int wr, int wc, int fr, int fq) const {
        const int row0 = u.pm * BM + wr * 64 + fr, colt = u.pn * BM, c0 = colt + wc * 32 + 8 * fq;
        f32x4 bv[2][2];
#pragma unroll
        for (int bj = 0; bj < 2; ++bj)
#pragma unroll
            for (int n = 0; n < 2; ++n) bv[bj][n] = *(const f32x4*)(binp + c0 + bj * HALF + 4 * n);
#pragma unroll
        for (int ai = 0; ai < 2; ++ai)
#pragma unroll
            for (int m = 0; m < 4; ++m) {
                const size_t row = (size_t)(row0 + ai * HALF + m * 16);
#pragma unroll
                for (int bj = 0; bj < 2; ++bj) {
                    const int c8 = c0 + bj * HALF;
                    const f32x4 v0 = acc[ai][bj][m][0] + bv[bj][0], v1 = acc[ai][bj][m][1] + bv[bj][1];
                    if (colt < 512) {
                        u32x4 w; w.x = pk2_(v0.x, v0.y); w.y = pk2_(v0.z, v0.w); w.z = pk2_(v1.x, v1.y); w.w = pk2_(v1.z, v1.w);
                        *(u32x4*)(U + row * 512 + c8) = w;
                    } else if (colt < 1536) {
                        if (bj == 0) {
                            const f32x4 g0 = acc[ai][1][m][0] + bv[1][0], g1 = acc[ai][1][m][1] + bv[1][1];
                            u32x4 w; w.x = pk2_(v0.x * sg_(g0.x), v0.y * sg_(g0.y)); w.y = pk2_(v0.z * sg_(g0.z), v0.w * sg_(g0.w));
                            w.z = pk2_(v1.x * sg_(g1.x), v1.y * sg_(g1.y)); w.w = pk2_(v1.z * sg_(g1.z), v1.w * sg_(g1.w));
                            *(u32x4*)(V + row * 512 + ((colt - 512) >> 1) + wc * 32 + 8 * fq) = w;
                        }
                    } else {
                        u32x4 w; w.x = pk2_(sg_(v0.x), sg_(v0.y)); w.y = pk2_(sg_(v0.z), sg_(v0.w)); w.z = pk2_(sg_(v1.x), sg_(v1.y)); w.w = pk2_(sg_(v1.z), sg_(v1.w));
                        if (colt < 2560) *(u32x4*)(SGS + row * 1024 + (c8 - 1536)) = w; else *(u32x4*)(SGC + row * 1024 + (c8 - 2560)) = w;
                    }
                }
            }
    }
};
struct EpiCout {
    static constexpr bool PERM = true, AFTER_DRAIN = false;
    const float* bias; const bf16_t* SGC; bf16_t* M1;
    __device__ __forceinline__ void operator()(const f32x4 (&acc)[2][2][4][2], const Unit& u, int wr, int wc, int fr, int fq) const {
        const int row0 = u.pm * BM + wr * 64 + fr, c0 = u.pn * BM + wc * 32 + 8 * fq;
        f32x4 bv[2][2];
#pragma unroll
        for (int bj = 0; bj < 2; ++bj)
#pragma unroll
            for (int n = 0; n < 2; ++n) bv[bj][n] = *(const f32x4*)(bias + c0 + bj * HALF + 4 * n);
#pragma unroll
        for (int ai = 0; ai < 2; ++ai) {
            u32x4 gv[4][2];
#pragma unroll
            for (int m = 0; m < 4; ++m)
#pragma unroll
                for (int bj = 0; bj < 2; ++bj) gv[m][bj] = *(const u32x4*)(SGC + (size_t)(row0 + ai * HALF + m * 16) * 1024 + c0 + bj * HALF);
            asm volatile("" ::: "memory");
#pragma unroll
            for (int m = 0; m < 4; ++m) {
                const size_t row = (size_t)(row0 + ai * HALF + m * 16);
#pragma unroll
                for (int bj = 0; bj < 2; ++bj) {
                    const int c8 = c0 + bj * HALF;
                    const f32x4 v0 = acc[ai][bj][m][0] + bv[bj][0], v1 = acc[ai][bj][m][1] + bv[bj][1];
                    const u32x4 g = gv[m][bj];
                    u32x4 w; w.x = pk2_(v0.x * lo_(g.x), v0.y * hi_(g.x)); w.y = pk2_(v0.z * lo_(g.y), v0.w * hi_(g.y));
                    w.z = pk2_(v1.x * lo_(g.z), v1.y * hi_(g.z)); w.w = pk2_(v1.z * lo_(g.w), v1.w * hi_(g.w));
                    *(u32x4*)(M1 + row * 1024 + c8) = w;
                }
            }
            asm volatile("" ::: "memory");
        }
    }
};
struct EpiGlu {
    static constexpr bool PERM = true, AFTER_DRAIN = false;
    const float* bglup; const bf16_t* SGS; const bf16_t* M1; bf16_t* MERGED;
    __device__ __forceinline__ void operator()(const f32x4 (&acc)[2][2][4][2], const Unit& u, int wr, int wc, int fr, int fq) const {
        const int row0 = u.pm * BM + wr * 64 + fr, c0 = u.pn * BM + wc * 32 + 8 * fq, mc = u.pn * HALF + wc * 32 + 8 * fq;
        f32x4 bv[2][2];
#pragma unroll
        for (int bj = 0; bj < 2; ++bj)
#pragma unroll
            for (int n = 0; n < 2; ++n) bv[bj][n] = *(const f32x4*)(bglup + c0 + bj * HALF + 4 * n);
#pragma unroll
        for (int ai = 0; ai < 2; ++ai) {
            u32x4 gv[4], qv[4];
#pragma unroll
            for (int m = 0; m < 4; ++m) {
                const size_t off = (size_t)(row0 + ai * HALF + m * 16) * 1024 + mc;
                gv[m] = *(const u32x4*)(SGS + off); qv[m] = *(const u32x4*)(M1 + off);
            }
            asm volatile("" ::: "memory");
#pragma unroll
            for (int m = 0; m < 4; ++m) {
                const size_t off = (size_t)(row0 + ai * HALF + m * 16) * 1024 + mc;
                const f32x4 a0 = acc[ai][0][m][0] + bv[0][0], a1 = acc[ai][0][m][1] + bv[0][1];
                const f32x4 b0 = acc[ai][1][m][0] + bv[1][0], b1 = acc[ai][1][m][1] + bv[1][1];
                const u32x4 g = gv[m], q = qv[m];
                u32x4 w;
                w.x = pk2_(lo_(q.x) + lo_(g.x) * (a0.x * sg_(b0.x)), hi_(q.x) + hi_(g.x) * (a0.y * sg_(b0.y)));
                w.y = pk2_(lo_(q.y) + lo_(g.y) * (a0.z * sg_(b0.z)), hi_(q.y) + hi_(g.y) * (a0.w * sg_(b0.w)));
                w.z = pk2_(lo_(q.z) + lo_(g.z) * (a1.x * sg_(b1.x)), hi_(q.z) + hi_(g.z) * (a1.y * sg_(b1.y)));
                w.w = pk2_(lo_(q.w) + lo_(g.w) * (a1.z * sg_(b1.z)), hi_(q.w) + hi_(g.w) * (a1.w * sg_(b1.w)));
                *(u32x4*)(MERGED + off) = w;
            }
            asm volatile("" ::: "memory");
        }
    }
};
struct TripleOrder {
    StaticOrder so;
    __device__ __forceinline__ bool next(int i, Unit& u) const {
        const int tr = i / 3, sub = i - tr * 3; Unit v;
        if (!so.next(tr, v)) return false;
        if (sub == 0) { u.pm = 128 + v.pm; u.pn = 8 + v.pn; } else { u.pm = v.pm; u.pn = 2 * v.pn + sub - 1; }
        return true;
    }
    __device__ __forceinline__ void a_ready(const Unit&) const {}
    __device__ __forceinline__ void done(const Unit&) const {}
};
struct EpiCG {
    static constexpr bool PERM = true, AFTER_DRAIN = false;
    EpiCout c; EpiGlu g;
    __device__ __forceinline__ void operator()(const f32x4 (&acc)[2][2][4][2], const Unit& u, int wr, int wc, int fr, int fq) const {
        if (u.pm >= 128) { const Unit v{u.pm - 128, u.pn - 8}; c(acc, v, wr, wc, fr, fq); }
        else g(acc, u, wr, wc, fr, fq);
    }
};
struct EpiOut {
    static constexpr bool PERM = true, AFTER_DRAIN = false;
    const float* bias; const bf16_t* XB; bf16_t* PREB; float alpha;
    __device__ __forceinline__ void operator()(const f32x4 (&acc)[2][2][4][2], const Unit& u, int wr, int wc, int fr, int fq) const {
        const int row0 = u.pm * BM + wr * 64 + fr, c0 = u.pn * BM + wc * 32 + 8 * fq;
        u32x4 xv[2][4][2];
#pragma unroll
        for (int ai = 0; ai < 2; ++ai)
#pragma unroll
            for (int m = 0; m < 4; ++m)
#pragma unroll
                for (int bj = 0; bj < 2; ++bj) xv[ai][m][bj] = *(const u32x4*)(XB + (size_t)(row0 + ai * HALF + m * 16) * 1024 + c0 + bj * HALF);
        asm volatile("" ::: "memory");
#pragma unroll
        for (int bj = 0; bj < 2; ++bj) {
            const int c8 = c0 + bj * HALF;
            const f32x4 bv0 = *(const f32x4*)(bias + c8), bv1 = *(const f32x4*)(bias + c8 + 4);
#pragma unroll
            for (int ai = 0; ai < 2; ++ai)
#pragma unroll
                for (int m = 0; m < 4; ++m) {
                    int ro_ = row0 + ai * HALF + m * 16; asm volatile("" : "+v"(ro_));
                    const u32x4 x = xv[ai][m][bj];
                    const f32x4 x0 = {lo_(x.x), hi_(x.x), lo_(x.y), hi_(x.y)}, x1 = {lo_(x.z), hi_(x.z), lo_(x.w), hi_(x.w)};
                    const f32x4 v0 = acc[ai][bj][m][0] + bv0 + x0 * alpha, v1 = acc[ai][bj][m][1] + bv1 + x1 * alpha;
                    u32x4 w; w.x = pk2_(v0.x, v0.y); w.y = pk2_(v0.z, v0.w); w.z = pk2_(v1.x, v1.y); w.w = pk2_(v1.z, v1.w);
                    *(u32x4*)(PREB + (size_t)ro_ * 1024 + c8) = w;
                }
            asm volatile("" ::: "memory");
        }
    }
};

struct MoeOrder {
    const PG8_LAS int* tab; int G, c, sh;
    __device__ __forceinline__ bool next(int i, Unit& u) const {
        const int L = i * G + c;
        if (L >= __builtin_amdgcn_readfirstlane(tab[32])) return false;
        int e = 0;
#pragma unroll 1
        while (L >= __builtin_amdgcn_readfirstlane(tab[e + 1])) ++e;
        const int ll = L - __builtin_amdgcn_readfirstlane(tab[e]);
        u.pm = __builtin_amdgcn_readfirstlane(tab[64 + e]) + (ll >> sh); u.pn = (e << sh) + (ll & ((1 << sh) - 1)); return true;
    }
    __device__ __forceinline__ void a_ready(const Unit&) const {}
    __device__ __forceinline__ void done(const Unit&) const {}
};
struct EpiDownP {
    static constexpr bool PERM = true, AFTER_DRAIN = false;
    const PG8_LAS int* tab; const int* TOK; const float* GATE; bf16_t* YM; bf16_t* dump; int Ttok;
    __device__ __forceinline__ void operator()(const f32x4 (&acc)[2][2][4][2], const Unit& u, int wr, int wc, int fr, int fq) const {
        const int e = u.pn >> 2, j = u.pn & 3;
        const int cnt = __builtin_amdgcn_readfirstlane(tab[128 + e]), idx0 = (u.pm - __builtin_amdgcn_readfirstlane(tab[64 + e])) * BM + wr * 64 + fr;
        const int* tl = TOK + (size_t)e * Ttok;
        const int c0 = j * BM + wc * 32 + 8 * fq;
        int entv[2][4]; float gtv[2][4];
#pragma unroll
        for (int ai = 0; ai < 2; ++ai)
#pragma unroll
            for (int m = 0; m < 4; ++m) { const int idx = idx0 + ai * HALF + m * 16; entv[ai][m] = tl[idx < cnt ? idx : 0]; }
#pragma unroll
        for (int ai = 0; ai < 2; ++ai)
#pragma unroll
            for (int m = 0; m < 4; ++m) gtv[ai][m] = GATE[entv[ai][m]];
        asm volatile("" ::: "memory");
#pragma unroll
        for (int ai = 0; ai < 2; ++ai)
#pragma unroll
            for (int m = 0; m < 4; ++m) {
                const int idx = idx0 + ai * HALF + m * 16;
                const bool ok = idx < cnt;
                const int ent = entv[ai][m];
                const float g = gtv[ai][m];
                bf16_t* const dst = (ok ? YM + (size_t)ent * 1024 : dump) + c0;
#pragma unroll
                for (int bj = 0; bj < 2; ++bj) {
                    const f32x4 v0 = acc[ai][bj][m][0] * g, v1 = acc[ai][bj][m][1] * g;
                    u32x4 w; w.x = pk2_(v0.x, v0.y); w.y = pk2_(v0.z, v0.w); w.z = pk2_(v1.x, v1.y); w.w = pk2_(v1.z, v1.w);
                    *(u32x4*)(dst + bj * HALF) = w;
                }
                asm volatile("" ::: "memory");
            }
    }
};

struct MoeRows {
    const PG8_LAS int* tab; const int* TOK; int Ttok; unsigned rowbytes;
    __device__ __forceinline__ unsigned rowoff(const Unit& u, int h, int R) const {
        const int e = u.pn >> 1;
        const int idx = (u.pm - __builtin_amdgcn_readfirstlane(tab[64 + e])) * BM + h * HALF + R;
        const int raw = TOK[(size_t)e * Ttok + idx];
        const int tok = idx < __builtin_amdgcn_readfirstlane(tab[128 + e]) ? (raw >> 1) : 0;
        return (unsigned)tok * rowbytes;
    }
};
struct EpiGUP {
    static constexpr bool PERM = true, AFTER_DRAIN = false;
    bf16_t* HID;
    __device__ __forceinline__ void operator()(const f32x4 (&acc)[2][2][4][2], const Unit& u, int wr, int wc, int fr, int fq) const {
        const int row0 = u.pm * BM + wr * 64 + fr, hc = (u.pn & 1) * HALF + wc * 32 + 8 * fq;
#pragma unroll
        for (int ai = 0; ai < 2; ++ai)
#pragma unroll
            for (int m = 0; m < 4; ++m) {
                const size_t row = (size_t)(row0 + ai * HALF + m * 16);
                const f32x4 g0 = acc[ai][0][m][0], g1 = acc[ai][0][m][1], u0 = acc[ai][1][m][0], u1 = acc[ai][1][m][1];
                u32x4 w; w.x = pk2_(g0.x * sg_(g0.x) * u0.x, g0.y * sg_(g0.y) * u0.y); w.y = pk2_(g0.z * sg_(g0.z) * u0.z, g0.w * sg_(g0.w) * u0.w);
                w.z = pk2_(g1.x * sg_(g1.x) * u1.x, g1.y * sg_(g1.y) * u1.y); w.w = pk2_(g1.z * sg_(g1.z) * u1.z, g1.w * sg_(g1.w) * u1.w);
                *(u32x4*)(HID + row * 256 + hc) = w;
            }
    }
};

template <class Epi, class Sched, bool ALIGN_EPI = false, bool SP2 = false>
__device__ __forceinline__ void gemm_phase(PG8_LAS unsigned char* lds, const Gemm g, const Sched& S, const Epi& E) {
    int tid_ = threadIdx.x; asm volatile("" : "+v"(tid_));
    const int tid = tid_, wid = __builtin_amdgcn_readfirstlane(tid >> 6), lane = tid & 63, wr = wid >> 2, wc = wid & 3, fr = lane & 15, fq = lane >> 4;
    const int K = g.K, nt = K / BK;
    unsigned voffA[2], voffB[2];
#pragma unroll
    for (int i = 0; i < 2; ++i) { int R, C; stage_rc(tid * 16 + i * 8192, R, C); const int Rb = Epi::PERM ? ((R & ~31) + perm32(R & 31)) : R;
        voffA[i] = (unsigned)(R * K + C) * 2u; voffB[i] = (unsigned)(Rb * K + C) * 2u; }
    const size_t kstep = (size_t)(BK * 2);
    const size_t hstep = (size_t)HALF * K * 2;
    const size_t tstep = 2 * hstep;
    const unsigned ldsw = (unsigned)wid * 1024u;
    const int aoff = lds_byte(wr * 64 + fr, fq * 8), boff = lds_byte(wc * 32 + fr, fq * 8);
#define PG8_SA(b, h) (((b) * 2 + (h)) * HTB)
#define PG8_SB(b, h) ((4 + (b) * 2 + (h)) * HTB)
#define PG8_STAGE(bufoff, gbase, voff) do { _Pragma("unroll") for (int _i = 0; _i < 2; ++_i) \
        __builtin_amdgcn_global_load_lds((const unsigned*)((const char*)(gbase) + (voff)[_i]), (PG8_LAS unsigned*)(lds + (bufoff) + ldsw + _i * 8192), 16, 0, 0); } while (0)
#define PG8_LDA(dst, b, h) do { _Pragma("unroll") for (int m = 0; m < 4; ++m) _Pragma("unroll") for (int k = 0; k < 2; ++k) dst[m][k] = *(const PG8_LAS bf16x8*)(lds + PG8_SA(b, h) + aoff + m * 2048 + k * 1024); } while (0)
#define PG8_LDB(dst, b, h) do { _Pragma("unroll") for (int n = 0; n < 2; ++n) _Pragma("unroll") for (int k = 0; k < 2; ++k) dst[n][k] = *(const PG8_LAS bf16x8*)(lds + PG8_SB(b, h) + boff + n * 2048 + k * 1024); } while (0)
#define PG8_MMA(ai, bj, At, Bt) do { __builtin_amdgcn_s_setprio(1); _Pragma("unroll") for (int m = 0; m < 4; ++m) _Pragma("unroll") for (int n = 0; n < 2; ++n) _Pragma("unroll") for (int k = 0; k < 2; ++k) \
        acc[ai][bj][m][n] = mfma16_h(Bt[n][k], At[m][k], acc[ai][bj][m][n], 0, 0, 0); __builtin_amdgcn_s_setprio(0); } while (0)
#define PG8_WAIT_V(n) asm volatile("s_waitcnt vmcnt(" #n ")" ::: "memory")
#define PG8_WAIT_L(n) asm volatile("s_waitcnt lgkmcnt(" #n ")" ::: "memory")
#define PG8_BAR __builtin_amdgcn_s_barrier()
#define PG8_SCHED __builtin_amdgcn_sched_barrier(0)
    Unit cur, nxt; int ui = 0;
    if (!S.next(0, cur)) return;
    f32x4 acc[2][2][4][2];
#pragma unroll
    for (int a = 0; a < 2; ++a)
#pragma unroll
        for (int b = 0; b < 2; ++b)
#pragma unroll
            for (int m = 0; m < 4; ++m)
#pragma unroll
                for (int n = 0; n < 2; ++n) acc[a][b][m][n] = (f32x4){0.f, 0.f, 0.f, 0.f};
    bf16x8 At[4][2], B0[2][2], B1[2][2];
    const char* cA = (const char*)g.A + (size_t)cur.pm * tstep; const char* cB = (const char*)g.Bt + (size_t)cur.pn * tstep;
    S.a_ready(cur);
    if constexpr (SP2) {
        PG8_STAGE(PG8_SB(0, 0), cB, voffB); PG8_STAGE(PG8_SB(0, 1), cB + hstep, voffB); PG8_STAGE(PG8_SA(0, 0), cA, voffA); PG8_STAGE(PG8_SA(0, 1), cA + hstep, voffA);
        if (wr == 1) PG8_BAR;
        PG8_WAIT_V(2); PG8_BAR;
        PG8_STAGE(PG8_SB(1, 0), cB + kstep, voffB); PG8_STAGE(PG8_SA(1, 0), cA + kstep, voffA); PG8_STAGE(PG8_SB(1, 1), cB + hstep + kstep, voffB);
        PG8_WAIT_V(6); PG8_BAR;
    } else {
        PG8_STAGE(PG8_SB(0, 0), cB, voffB); PG8_STAGE(PG8_SA(0, 0), cA, voffA); PG8_STAGE(PG8_SB(0, 1), cB + hstep, voffB); PG8_STAGE(PG8_SA(0, 1), cA + hstep, voffA);
        if (wr == 1) PG8_BAR;
        PG8_WAIT_V(4); PG8_BAR;
        PG8_STAGE(PG8_SB(1, 0), cB + kstep, voffB); PG8_STAGE(PG8_SA(1, 0), cA + kstep, voffA); PG8_STAGE(PG8_SB(1, 1), cB + hstep + kstep, voffB);
        PG8_WAIT_V(6); PG8_BAR;
    }
    for (;;) {
        const bool has_next = S.next(ui + 1, nxt);
        const char* nA = has_next ? (const char*)g.A + (size_t)nxt.pm * tstep : cA; const char* nB = has_next ? (const char*)g.Bt + (size_t)nxt.pn * tstep : cB;
        for (int t = 0; t < nt; t += 2) {
            const bool last = (t == nt - 2);
            const char* a1 = cA + (size_t)(t + 1) * kstep;
            const char* a2 = last ? nA : cA + (size_t)(t + 2) * kstep; const char* b2 = last ? nB : cB + (size_t)(t + 2) * kstep;
            const char* a3 = a2 + kstep; const char* b3 = b2 + kstep;
            if (last && has_next) S.a_ready(nxt);
            if constexpr (SP2) {
            PG8_LDB(B0, 0, 0); PG8_LDB(B1, 0, 1); PG8_SCHED; PG8_LDA(At, 0, 0); PG8_STAGE(PG8_SA(1, 1), a1 + hstep, voffA);
            PG8_WAIT_V(8); PG8_WAIT_L(0); PG8_BAR; PG8_MMA(0, 0, At, B0); PG8_MMA(0, 1, At, B1); PG8_BAR; PG8_SCHED;
            PG8_LDA(At, 0, 1); PG8_STAGE(PG8_SB(0, 0), b2, voffB); PG8_STAGE(PG8_SB(0, 1), b2 + hstep, voffB); PG8_STAGE(PG8_SA(0, 0), a2, voffA);
            PG8_WAIT_V(8); PG8_WAIT_L(0); PG8_BAR; PG8_MMA(1, 0, At, B0); PG8_MMA(1, 1, At, B1); PG8_BAR; PG8_SCHED;
            PG8_LDB(B0, 1, 0); PG8_LDB(B1, 1, 1); PG8_SCHED; PG8_LDA(At, 1, 0); PG8_STAGE(PG8_SA(0, 1), a2 + hstep, voffA);
            PG8_WAIT_V(8); PG8_WAIT_L(0); PG8_BAR; PG8_MMA(0, 0, At, B0); PG8_MMA(0, 1, At, B1); PG8_BAR; PG8_SCHED;
            PG8_LDA(At, 1, 1); PG8_STAGE(PG8_SB(1, 0), b3, voffB); PG8_STAGE(PG8_SB(1, 1), b3 + hstep, voffB); PG8_STAGE(PG8_SA(1, 0), a3, voffA);
            PG8_WAIT_V(8); PG8_WAIT_L(0); PG8_BAR; PG8_MMA(1, 0, At, B0); PG8_MMA(1, 1, At, B1); PG8_BAR; PG8_SCHED;
            } else {
            PG8_LDB(B0, 0, 0); PG8_SCHED; PG8_LDA(At, 0, 0); PG8_STAGE(PG8_SA(1, 1), a1 + hstep, voffA);
            PG8_WAIT_L(8); PG8_BAR; PG8_WAIT_L(0); PG8_MMA(0, 0, At, B0); PG8_BAR; PG8_SCHED;
            PG8_LDB(B1, 0, 1); PG8_STAGE(PG8_SB(0, 0), b2, voffB);
            PG8_BAR; PG8_WAIT_L(0); PG8_MMA(0, 1, At, B1); PG8_BAR;
            PG8_LDA(At, 0, 1); PG8_STAGE(PG8_SA(0, 0), a2, voffA);
            PG8_BAR; PG8_WAIT_L(0); PG8_MMA(1, 0, At, B0); PG8_BAR; PG8_SCHED;
            PG8_STAGE(PG8_SB(0, 1), b2 + hstep, voffB);
            PG8_WAIT_V(6); PG8_BAR; PG8_MMA(1, 1, At, B1); PG8_BAR;
            PG8_LDB(B0, 1, 0); PG8_SCHED; PG8_LDA(At, 1, 0); PG8_STAGE(PG8_SA(0, 1), a2 + hstep, voffA);
            PG8_WAIT_L(8); PG8_BAR; PG8_WAIT_L(0); PG8_MMA(0, 0, At, B0); PG8_BAR; PG8_SCHED;
            PG8_LDB(B1, 1, 1); PG8_STAGE(PG8_SB(1, 0), b3, voffB);
            PG8_BAR; PG8_WAIT_L(0); PG8_MMA(0, 1, At, B1); PG8_BAR;
            PG8_LDA(At, 1, 1); PG8_STAGE(PG8_SA(1, 0), a3, voffA);
            PG8_BAR; PG8_WAIT_L(0); PG8_MMA(1, 0, At, B0); PG8_BAR; PG8_SCHED;
            PG8_STAGE(PG8_SB(1, 1), b3 + hstep, voffB);
            PG8_WAIT_V(6); PG8_BAR; PG8_MMA(1, 1, At, B1); PG8_BAR;
            }
        }
        if constexpr (ALIGN_EPI) { if (wr == 0) PG8_BAR; }
        if constexpr (!Epi::AFTER_DRAIN) { E(acc, cur, wr, wc, fr, fq); S.done(cur); }
        if (!has_next) break;
#pragma unroll
        for (int a = 0; a < 2; ++a)
#pragma unroll
            for (int b = 0; b < 2; ++b)
#pragma unroll
                for (int m = 0; m < 4; ++m)
#pragma unroll
                    for (int n = 0; n < 2; ++n) acc[a][b][m][n] = (f32x4){0.f, 0.f, 0.f, 0.f};
        cur = nxt; cA = nA; cB = nB; ++ui;
        if constexpr (ALIGN_EPI) { if (wr == 1) PG8_BAR; }
    }
    PG8_WAIT_V(0);
    if constexpr (!ALIGN_EPI) { if (wr == 0) PG8_BAR; }
    PG8_BAR;
    if constexpr (Epi::AFTER_DRAIN) { E.fused(acc, cur, wr, wc, fr, fq, lds, wid, lane); S.done(cur); }
#undef PG8_SA
#undef PG8_SB
#undef PG8_STAGE
#undef PG8_LDA
#undef PG8_LDB
#undef PG8_MMA
#undef PG8_WAIT_V
#undef PG8_WAIT_L
#undef PG8_BAR
#undef PG8_SCHED
}
template <class Epi, class Sched, class Rows>
__device__ __forceinline__ void gemm_phase_gather(PG8_LAS unsigned char* lds, const Gemm g, const Sched& S, const Epi& E, const Rows& rows) {
    constexpr bool ALIGN_EPI = true, SP2 = true;
    int tid_ = threadIdx.x; asm volatile("" : "+v"(tid_));
    const int tid = tid_, wid = __builtin_amdgcn_readfirstlane(tid >> 6), lane = tid & 63, wr = wid >> 2, wc = wid & 3, fr = lane & 15, fq = lane >> 4;
    const int K = g.K, nt = K / BK;
    unsigned voffB[2], cofs[2]; int RA[2];
#pragma unroll
    for (int i = 0; i < 2; ++i) { int R, C; stage_rc(tid * 16 + i * 8192, R, C); const int Rb = Epi::PERM ? ((R & ~31) + perm32(R & 31)) : R;
        RA[i] = R; cofs[i] = (unsigned)C * 2u; voffB[i] = (unsigned)(Rb * K + C) * 2u; }
    unsigned vC[2][2], vN[2][2];
#define PG8_LOADOFFS(v, un) do { _Pragma("unroll") for (int _h = 0; _h < 2; ++_h) _Pragma("unroll") for (int _i = 0; _i < 2; ++_i) (v)[_h][_i] = rows.rowoff((un), _h, RA[_i]) + cofs[_i]; } while (0)
    const size_t kstep = (size_t)(BK * 2);
    const size_t hstep = (size_t)HALF * K * 2;
    const size_t tstep = 2 * hstep;
    const unsigned ldsw = (unsigned)wid * 1024u;
    const int aoff = lds_byte(wr * 64 + fr, fq * 8), boff = lds_byte(wc * 32 + fr, fq * 8);
#define PG8_SA(b, h) (((b) * 2 + (h)) * HTB)
#define PG8_SB(b, h) ((4 + (b) * 2 + (h)) * HTB)
#define PG8_STAGE(bufoff, gbase, voff) do { _Pragma("unroll") for (int _i = 0; _i < 2; ++_i) \
        __builtin_amdgcn_global_load_lds((const unsigned*)((const char*)(gbase) + (voff)[_i]), (PG8_LAS unsigned*)(lds + (bufoff) + ldsw + _i * 8192), 16, 0, 0); } while (0)
#define PG8_LDA(dst, b, h) do { _Pragma("unroll") for (int m = 0; m < 4; ++m) _Pragma("unroll") for (int k = 0; k < 2; ++k) dst[m][k] = *(const PG8_LAS bf16x8*)(lds + PG8_SA(b, h) + aoff + m * 2048 + k * 1024); } while (0)
#define PG8_LDB(dst, b, h) do { _Pragma("unroll") for (int n = 0; n < 2; ++n) _Pragma("unroll") for (int k = 0; k < 2; ++k) dst[n][k] = *(const PG8_LAS bf16x8*)(lds + PG8_SB(b, h) + boff + n * 2048 + k * 1024); } while (0)
#define PG8_MMA(ai, bj, At, Bt) do { __builtin_amdgcn_s_setprio(1); _Pragma("unroll") for (int m = 0; m < 4; ++m) _Pragma("unroll") for (int n = 0; n < 2; ++n) _Pragma("unroll") for (int k = 0; k < 2; ++k) \
        acc[ai][bj][m][n] = mfma16_h(Bt[n][k], At[m][k], acc[ai][bj][m][n], 0, 0, 0); __builtin_amdgcn_s_setprio(0); } while (0)
#define PG8_WAIT_V(n) asm volatile("s_waitcnt vmcnt(" #n ")" ::: "memory")
#define PG8_WAIT_L(n) asm volatile("s_waitcnt lgkmcnt(" #n ")" ::: "memory")
#define PG8_BAR __builtin_amdgcn_s_barrier()
#define PG8_SCHED __builtin_amdgcn_sched_barrier(0)
    Unit cur, nxt; int ui = 0;
    if (!S.next(0, cur)) return;
    f32x4 acc[2][2][4][2];
#pragma unroll
    for (int a = 0; a < 2; ++a)
#pragma unroll
        for (int b = 0; b < 2; ++b)
#pragma unroll
            for (int m = 0; m < 4; ++m)
#pragma unroll
                for (int n = 0; n < 2; ++n) acc[a][b][m][n] = (f32x4){0.f, 0.f, 0.f, 0.f};
    bf16x8 At[4][2], B0[2][2], B1[2][2];
    const char* const Ab = (const char*)g.A; const char* cB = (const char*)g.Bt + (size_t)cur.pn * tstep;
    PG8_LOADOFFS(vC, cur);
    S.a_ready(cur);
    if constexpr (SP2) {
        PG8_STAGE(PG8_SB(0, 0), cB, voffB); PG8_STAGE(PG8_SB(0, 1), cB + hstep, voffB); PG8_STAGE(PG8_SA(0, 0), Ab, vC[0]); PG8_STAGE(PG8_SA(0, 1), Ab, vC[1]);
        if (wr == 1) PG8_BAR;
        PG8_WAIT_V(2); PG8_BAR;
        PG8_STAGE(PG8_SB(1, 0), cB + kstep, voffB); PG8_STAGE(PG8_SA(1, 0), Ab + kstep, vC[0]); PG8_STAGE(PG8_SB(1, 1), cB + hstep + kstep, voffB);
        PG8_WAIT_V(6); PG8_BAR;
    }
    for (;;) {
        const bool has_next = S.next(ui + 1, nxt);
        const char* nB = has_next ? (const char*)g.Bt + (size_t)nxt.pn * tstep : cB;
        if (has_next) { PG8_LOADOFFS(vN, nxt); } else { vN[0][0] = vC[0][0]; vN[0][1] = vC[0][1]; vN[1][0] = vC[1][0]; vN[1][1] = vC[1][1]; }
        for (int t = 0; t < nt; t += 2) {
            const bool last = (t == nt - 2);
            const char* a1 = Ab + (size_t)(t + 1) * kstep;
            const char* a2 = last ? Ab : Ab + (size_t)(t + 2) * kstep; const char* b2 = last ? nB : cB + (size_t)(t + 2) * kstep;
            const char* a3 = a2 + kstep; const char* b3 = b2 + kstep;
            unsigned s2h0[2], s2h1[2]; s2h0[0] = last ? vN[0][0] : vC[0][0]; s2h0[1] = last ? vN[0][1] : vC[0][1]; s2h1[0] = last ? vN[1][0] : vC[1][0]; s2h1[1] = last ? vN[1][1] : vC[1][1];
            if (last && has_next) S.a_ready(nxt);
            if constexpr (SP2) {
            PG8_LDB(B0, 0, 0); PG8_LDB(B1, 0, 1); PG8_SCHED; PG8_LDA(At, 0, 0); PG8_STAGE(PG8_SA(1, 1), a1, vC[1]);
            PG8_WAIT_V(8); PG8_WAIT_L(0); PG8_BAR; PG8_MMA(0, 0, At, B0); PG8_MMA(0, 1, At, B1); PG8_BAR; PG8_SCHED;
            PG8_LDA(At, 0, 1); PG8_STAGE(PG8_SB(0, 0), b2, voffB); PG8_STAGE(PG8_SB(0, 1), b2 + hstep, voffB); PG8_STAGE(PG8_SA(0, 0), a2, s2h0);
            PG8_WAIT_V(8); PG8_WAIT_L(0); PG8_BAR; PG8_MMA(1, 0, At, B0); PG8_MMA(1, 1, At, B1); PG8_BAR; PG8_SCHED;
            PG8_LDB(B0, 1, 0); PG8_LDB(B1, 1, 1); PG8_SCHED; PG8_LDA(At, 1, 0); PG8_STAGE(PG8_SA(0, 1), a2, s2h1);
            PG8_WAIT_V(8); PG8_WAIT_L(0); PG8_BAR; PG8_MMA(0, 0, At, B0); PG8_MMA(0, 1, At, B1); PG8_BAR; PG8_SCHED;
            PG8_LDA(At, 1, 1); PG8_STAGE(PG8_SB(1, 0), b3, voffB); PG8_STAGE(PG8_SB(1, 1), b3 + hstep, voffB); PG8_STAGE(PG8_SA(1, 0), a3, s2h0);
            PG8_WAIT_V(8); PG8_WAIT_L(0); PG8_BAR; PG8_MMA(1, 0, At, B0); PG8_MMA(1, 1, At, B1); PG8_BAR; PG8_SCHED;
            }
        }
        if constexpr (ALIGN_EPI) { if (wr == 0) PG8_BAR; }
        if constexpr (!Epi::AFTER_DRAIN) { E(acc, cur, wr, wc, fr, fq); S.done(cur); }
        if (!has_next) break;
#pragma unroll
        for (int a = 0; a < 2; ++a)
#pragma unroll
            for (int b = 0; b < 2; ++b)
#pragma unroll
                for (int m = 0; m < 4; ++m)
#pragma unroll
                    for (int n = 0; n < 2; ++n) acc[a][b][m][n] = (f32x4){0.f, 0.f, 0.f, 0.f};
        cur = nxt; cB = nB; ++ui; vC[0][0] = vN[0][0]; vC[0][1] = vN[0][1]; vC[1][0] = vN[1][0]; vC[1][1] = vN[1][1];
        if constexpr (ALIGN_EPI) { if (wr == 1) PG8_BAR; }
    }
    PG8_WAIT_V(0);
    if constexpr (!ALIGN_EPI) { if (wr == 0) PG8_BAR; }
    PG8_BAR;
    if constexpr (Epi::AFTER_DRAIN) { E.fused(acc, cur, wr, wc, fr, fq, lds, wid, lane); S.done(cur); }
#undef PG8_LOADOFFS
#undef PG8_SA
#undef PG8_SB
#undef PG8_STAGE
#undef PG8_LDA
#undef PG8_LDB
#undef PG8_MMA
#undef PG8_WAIT_V
#undef PG8_WAIT_L
#undef PG8_BAR
#undef PG8_SCHED
}
}

template <int NI, class RowPtr, class Epi>
__device__ __forceinline__ void gemm_tile(unsigned char* lds, const RowPtr& rowptr, const bf16* Bt, const int K, const Epi& epi) {
    const int tid = threadIdx.x, lane = tid & 63, wave = tid >> 6, wm = wave >> 2, wn = wave & 3, fr = lane & 15, fq = lane >> 4;
    const int sr = tid >> 3, cp = tid & 7;
    const int sw = (cp ^ (sr & 7)) << 3;
    const bf16* ap0 = rowptr(sr) + sw;
    const bf16* ap1 = rowptr(sr + 64) + sw;
    const bf16* bp = Bt + (size_t)sr * K + sw;
    const size_t bstep = (size_t)64 * K;
    f32x4 acc[4][NI];
#pragma unroll
    for (int i = 0; i < 4; ++i)
#pragma unroll
        for (int j = 0; j < NI; ++j) acc[i][j] = (f32x4){0.f, 0.f, 0.f, 0.f};
    const int nt = K >> 6;
    {
        unsigned char* Ab = lds; unsigned char* Bb = lds + 16384;
        glds16(ap0, Ab + tid * 16); glds16(ap1, Ab + 8192 + tid * 16);
#pragma unroll
        for (int i = 0; i < NI; ++i) glds16(bp + i * bstep, Bb + i * 8192 + tid * 16);
    }
    const int aoff = (wm * 64 + fr) * 128, boff = (wn * 16 * NI + fr) * 128;
    for (int kt = 0; kt < nt; ++kt) {
        asm volatile("s_waitcnt vmcnt(0)" ::: "memory");
        __syncthreads();
        if (kt + 1 < nt) {
            unsigned char* Ab = lds + ((kt + 1) & 1) * 49152; unsigned char* Bb = Ab + 16384;
            const int ko = (kt + 1) * 64;
            glds16(ap0 + ko, Ab + tid * 16); glds16(ap1 + ko, Ab + 8192 + tid * 16);
#pragma unroll
            for (int i = 0; i < NI; ++i) glds16(bp + i * bstep + ko, Bb + i * 8192 + tid * 16);
        }
        const unsigned char* Ab = lds + (kt & 1) * 49152; const unsigned char* Bb = Ab + 16384;
#pragma unroll
        for (int ks = 0; ks < 2; ++ks) {
            const int so = ((ks * 4 + fq) ^ (fr & 7)) << 4;
            bf16x8 af[4], bfr[NI];
#pragma unroll
            for (int i = 0; i < 4; ++i) af[i] = *(const bf16x8*)(Ab + aoff + i * 2048 + so);
#pragma unroll
            for (int i = 0; i < NI; ++i) bfr[i] = *(const bf16x8*)(Bb + boff + i * 2048 + so);
#pragma unroll
            for (int mi = 0; mi < 4; ++mi)
#pragma unroll
                for (int ni = 0; ni < NI; ++ni) acc[mi][ni] = mfma16_h(bfr[ni], af[mi], acc[mi][ni], 0, 0, 0);
        }
    }
    __syncthreads();
    epi(acc, wm * 64 + fr, wn * 16 * NI + 4 * fq);
}

template <class F>
__device__ __forceinline__ void transpose_item(const float* W, int K, int N, bf16* WT, float* scr, int item, int lane, const F& rowmap) {
    const int nblk = N / 32, kb = item / nblk, nb = item % nblk, k0 = 64 * kb, n0 = 32 * nb;
#pragma unroll 8
    for (int i = 0; i < 32; ++i) { const int kk = 2 * i + (lane >> 5); scr[kk * 33 + (lane & 31)] = W[(size_t)(k0 + kk) * N + n0 + (lane & 31)]; }
    asm volatile("s_waitcnt lgkmcnt(0)" ::: "memory");
    const int c = lane & 7;
#pragma unroll
    for (int j = 0; j < 4; ++j) {
        const int n = (lane >> 3) + 8 * j; const float* s = scr + (8 * c) * 33 + n;
        u32x4 o; o.x = pk2(s[0 * 33], s[1 * 33]); o.y = pk2(s[2 * 33], s[3 * 33]); o.z = pk2(s[4 * 33], s[5 * 33]); o.w = pk2(s[6 * 33], s[7 * 33]);
        *(u32x4*)(WT + (size_t)rowmap(n0 + n) * K + k0 + 8 * c) = o;
    }
    asm volatile("s_waitcnt lgkmcnt(0)" ::: "memory");
}

__device__ __forceinline__ void sincos_d(double x, double& s, double& c) {
    const double k = rint(x * 0.63661977236758134308);
    const double r = (x - k * 1.57079632679489655800) - k * 6.123233995736766036e-17;
    const double r2 = r * r;
    double sp = 1.0 / 121645100408832000.0;
    sp = sp * r2 * (-1.0) + 1.0 / 355687428096000.0;
    sp = sp * r2 * (-1.0) + 1.0 / 1307674368000.0;
    sp = sp * r2 * (-1.0) + 1.0 / 6227020800.0;
    sp = sp * r2 * (-1.0) + 1.0 / 39916800.0;
    sp = sp * r2 * (-1.0) + 1.0 / 362880.0;
    sp = sp * r2 * (-1.0) + 1.0 / 5040.0;
    sp = sp * r2 * (-1.0) + 1.0 / 120.0;
    sp = sp * r2 * (-1.0) + 1.0 / 6.0;
    sp = sp * r2 * (-1.0) + 1.0;
    const double sr = sp * r;
    double cpn = 1.0 / 6402373705728000.0;
    cpn = cpn * r2 * (-1.0) + 1.0 / 20922789888000.0;
    cpn = cpn * r2 * (-1.0) + 1.0 / 87178291200.0;
    cpn = cpn * r2 * (-1.0) + 1.0 / 479001600.0;
    cpn = cpn * r2 * (-1.0) + 1.0 / 3628800.0;
    cpn = cpn * r2 * (-1.0) + 1.0 / 40320.0;
    cpn = cpn * r2 * (-1.0) + 1.0 / 720.0;
    cpn = cpn * r2 * (-1.0) + 1.0 / 24.0;
    cpn = cpn * r2 * (-1.0) + 0.5;
    const double cr = 1.0 - cpn * r2;
    const int q = ((int)k) & 3;
    s = (q == 0) ? sr : (q == 1) ? cr : (q == 2) ? -sr : -cr;
    c = (q == 0) ? cr : (q == 1) ? -sr : (q == 2) ? -cr : sr;
}
__device__ __forceinline__ double exp_small_d(double x) {
    const double y = x * 0.125;
    double p = 1.0 / 479001600.0;
    p = p * y + 1.0 / 39916800.0; p = p * y + 1.0 / 3628800.0; p = p * y + 1.0 / 362880.0; p = p * y + 1.0 / 40320.0;
    p = p * y + 1.0 / 5040.0; p = p * y + 1.0 / 720.0; p = p * y + 1.0 / 120.0; p = p * y + 1.0 / 24.0;
    p = p * y + 1.0 / 6.0; p = p * y + 0.5; p = p * y + 1.0; p = p * y + 1.0;
    p = p * p; p = p * p; p = p * p;
    return p;
}

__device__ __forceinline__ void phase_prep(const Params& P, unsigned char* lds) {
    int tid_ = threadIdx.x; asm volatile("" : "+v"(tid_));
    const int tid = tid_, lane = tid & 63, wave = tid >> 6;
    const int G = gridDim.x;
    const int gw = blockIdx.x * 8 + wave, NGW = G * 8;
    const size_t gtid = (size_t)blockIdx.x * NTHREADS + tid, NGT = (size_t)G * NTHREADS;
    unsigned char* ws = P.ws;
    if (blockIdx.x == 0 && tid < 64) ((int*)(ws + WS_CTL))[tid] = 0;
    {
        const f32x4* x4 = (const f32x4*)P.in[0]; u32x4* o = (u32x4*)(ws + WS_XB);
        const size_t n8 = (size_t)T * D / 8;
        for (size_t i = gtid; i < n8; i += NGT) { const f32x4 v = x4[2 * i], u = x4[2 * i + 1]; u32x4 w; w.x = pk2(v.x, v.y); w.y = pk2(v.z, v.w); w.z = pk2(u.x, u.y); w.w = pk2(u.z, u.w); o[i] = w; }
    }
    {
        float* scr = (float*)(lds + wave * 8704);
        constexpr int I_IN = 16 * 112, I_GLU = 8 * 64, I_COUT = 8 * 32, I_OUT = 16 * 32, I_RG = 16 * 1  , I_G = 16 * 8, I_D = 4 * 32;
        (void)I_RG;
        constexpr int TOTAL = I_IN + I_GLU + I_COUT + I_OUT + NEXP * (2 * I_G + I_D) + 16  ;
        for (int it = gw; it < TOTAL; it += NGW) {
            int r = it;
            if (r < I_IN) {
                transpose_item(P.in[1], D, DIN, (bf16*)(ws + WS_WIN), scr, r, lane,
                               [](int c) { return c < 512 ? c : (c < 1024 ? 512 + (((c - 512) >> 7) << 8) + ((c - 512) & 127) : (c < 1536 ? 512 + (((c - 1024) >> 7) << 8) + 128 + ((c - 1024) & 127) : c)); });
                continue;
            }
            r -= I_IN;
            if (r < I_GLU) { transpose_item(P.in[11], DSSM, 2 * D, (bf16*)(ws + WS_WGLU), scr, r, lane, [](int c) { return c < 1024 ? ((c >> 7) << 8) + (c & 127) : (((c - 1024) >> 7) << 8) + 128 + ((c - 1024) & 127); }); continue; }
            r -= I_GLU;
            if (r < I_COUT) { transpose_item(P.in[17], DCONV, D, (bf16*)(ws + WS_WCOUT), scr, r, lane, [](int c) { return c; }); continue; }
            r -= I_COUT;
            if (r < I_OUT) { transpose_item(P.in[19], D, D, (bf16*)(ws + WS_WOUT), scr, r, lane, [](int c) { return c; }); continue; }
            r -= I_OUT;
            if (r < NEXP * I_G) { const int e = r / I_G; transpose_item(P.in[27] + (size_t)e * D * DFF, D, DFF, (bf16*)(ws + WS_WGU) + (size_t)e * 512 * D, scr, r % I_G, lane, [](int c) { return ((c >> 7) << 8) + (c & 127); }); continue; }
            r -= NEXP * I_G;
            if (r < NEXP * I_G) { const int e = r / I_G; transpose_item(P.in[28] + (size_t)e * D * DFF, D, DFF, (bf16*)(ws + WS_WGU) + (size_t)e * 512 * D, scr, r % I_G, lane, [](int c) { return ((c >> 7) << 8) + 128 + (c & 127); }); continue; }
            r -= NEXP * I_G;
            if (r < NEXP * I_D) { const int e = r / I_D; transpose_item(P.in[29] + (size_t)e * DFF * D, DFF, D, (bf16*)(ws + WS_WD) + (size_t)e * D * DFF, scr, r % I_D, lane, [](int c) { return c; }); continue; }
            r -= NEXP * I_D;
            transpose_item(P.in[25], D, NEXP, (bf16*)(ws + WS_WR), scr, r, lane, [](int c) { return 4 + c; });
        }
    }
    {
        bf16* wr = (bf16*)(ws + WS_WR);
        for (size_t i = gtid; i < (size_t)4 * D; i += NGT) { const int n = (int)(i / D), k = (int)(i % D); wr[(size_t)n * D + k] = (bf16)f2bf(P.in[23][(size_t)k * 4 + n]); }
        for (size_t i = gtid; i < (size_t)(256 - 36) * D / 2; i += NGT) ((unsigned*)(wr + (size_t)36 * D))[i] = 0u;
    }
    {
        float* binp = (float*)(ws + WS_TAB + TAB_BINP); float* bglup = (float*)(ws + WS_TAB + TAB_BGLUP);
        for (size_t i = gtid; i < (size_t)DIN; i += NGT) { const int c = (int)i; const int r = c < 512 ? c : (c < 1024 ? 512 + (((c - 512) >> 7) << 8) + ((c - 512) & 127) : (c < 1536 ? 512 + (((c - 1024) >> 7) << 8) + 128 + ((c - 1024) & 127) : c)); binp[r] = P.in[2][c]; }
        for (size_t i = gtid; i < (size_t)2 * D; i += NGT) { const int c = (int)i; const int r = c < 1024 ? ((c >> 7) << 8) + (c & 127) : (((c - 1024) >> 7) << 8) + 128 + ((c - 1024) & 127); bglup[r] = P.in[12][c]; }
    }
    if (gtid < (size_t)NGRP * NST) {
        const int g = (int)gtid >> 6, p = (int)gtid & 63;
        const double lr = (double)P.in[3][g * 64 + p], li = (double)P.in[4][g * 64 + p];
        const double dt = (double)expf(P.in[5][g]);
        const double mag = exp_small_d(lr * dt);
        double sn, cs; sincos_d(li * dt, sn, cs);
        const double ar = mag * cs, ai = mag * sn;
        const double den = lr * lr + li * li;
        const double fr_ = ((ar - 1.0) * lr + ai * li) / den, fi_ = (ai * lr - (ar - 1.0) * li) / den;
        float* atab = (float*)(ws + WS_TAB + TAB_A);
        atab[(g * 64 + p) * 2 + 0] = (float)ar; atab[(g * 64 + p) * 2 + 1] = (float)ai;
        bf16* bb = (bf16*)(ws + WS_TAB + TAB_BB); bf16* cm = (bf16*)(ws + WS_TAB + TAB_CM);
        const int sh = p >> 5, p32 = p & 31;
        for (int h = 0; h < NH; ++h) {
            const double bre = (double)P.in[6][(g * 64 + p) * 16 + h], bim = (double)P.in[7][(g * 64 + p) * 16 + h];
            const double vre = fr_ * bre - fi_ * bim, vim = fr_ * bim + fi_ * bre;
            const int ln = p32 + 32 * (h >> 3), j = h & 7;
            bb[(((size_t)g * 4 + sh * 2 + 0) * 64 + ln) * 8 + j] = (bf16)f2bf((float)vre);
            bb[(((size_t)g * 4 + sh * 2 + 1) * 64 + ln) * 8 + j] = (bf16)f2bf((float)vim);
        }
        for (int ho = 0; ho < NH; ++ho) {
            const float cre = P.in[8][g * 1024 + ho * 64 + p], cim = P.in[9][g * 1024 + ho * 64 + p];
#pragma unroll
            for (int ri = 0; ri < 2; ++ri) {
                const int k = 2 * p + ri, ks = k >> 5, kk = k & 31, ln = ho + 16 * (kk >> 3), j = kk & 7;
                cm[(((size_t)g * 4 + ks) * 64 + ln) * 8 + j] = (bf16)f2bf(ri == 0 ? cre : -cim);
            }
        }
    }
}

struct EpiProj {
    const float* binp; bf16* U; bf16* V; bf16* SGS; bf16* SGC; int row0, col0;
    __device__ __forceinline__ void operator()(const f32x4 (&acc)[4][4], int r_in, int c_in) const {
#pragma unroll
        for (int mi = 0; mi < 4; ++mi) {
            const size_t row = (size_t)(row0 + r_in + mi * 16);
#pragma unroll
            for (int ni = 0; ni < 4; ++ni) {
                const int col = col0 + c_in + ni * 16;
                const f32x4 b = *(const f32x4*)(binp + col);
                const f32x4 v = acc[mi][ni] + b;
                if (col0 < 512) {
                    u32x2 w; w.x = pk2(v.x, v.y); w.y = pk2(v.z, v.w); *(u32x2*)(U + row * 512 + col) = w;
                } else if (col0 < 1536) {
                    const float v0 = v.x * sigmoidf_(v.y), v1 = v.z * sigmoidf_(v.w);
                    *(unsigned*)(V + row * 512 + ((col - 512) >> 1)) = pk2(v0, v1);
                } else if (col0 < 2560) {
                    u32x2 w; w.x = pk2(sigmoidf_(v.x), sigmoidf_(v.y)); w.y = pk2(sigmoidf_(v.z), sigmoidf_(v.w)); *(u32x2*)(SGS + row * 1024 + (col - 1536)) = w;
                } else {
                    u32x2 w; w.x = pk2(sigmoidf_(v.x), sigmoidf_(v.y)); w.y = pk2(sigmoidf_(v.z), sigmoidf_(v.w)); *(u32x2*)(SGC + row * 1024 + (col - 2560)) = w;
                }
            }
        }
    }
};
struct EpiCout {
    const float* bias; const bf16* SGC; bf16* MERGED; int row0, col0;
    __device__ __forceinline__ void operator()(const f32x4 (&acc)[4][4], int r_in, int c_in) const {
#pragma unroll
        for (int mi = 0; mi < 4; ++mi) {
            const size_t row = (size_t)(row0 + r_in + mi * 16);
#pragma unroll
            for (int ni = 0; ni < 4; ++ni) {
                const int col = col0 + c_in + ni * 16;
                const f32x4 v = acc[mi][ni] + *(const f32x4*)(bias + col);
                const u32x2 g = *(const u32x2*)(SGC + row * 1024 + col);
                u32x2 w; w.x = pk2(v.x * bflo(g.x), v.y * bfhi(g.x)); w.y = pk2(v.z * bflo(g.y), v.w * bfhi(g.y));
                *(u32x2*)(MERGED + row * 1024 + col) = w;
            }
        }
    }
};
struct EpiGlu {
    const float* bglup; const bf16* SGS; bf16* MERGED; int row0, col0;
    __device__ __forceinline__ void operator()(const f32x4 (&acc)[4][4], int r_in, int c_in) const {
#pragma unroll
        for (int mi = 0; mi < 4; ++mi) {
            const size_t row = (size_t)(row0 + r_in + mi * 16);
#pragma unroll
            for (int ni = 0; ni < 4; ++ni) {
                const int col = col0 + c_in + ni * 16;
                const f32x4 v = acc[mi][ni] + *(const f32x4*)(bglup + col);
                const int mc = col >> 1;
                const float s0 = v.x * sigmoidf_(v.y), s1 = v.z * sigmoidf_(v.w);
                const unsigned g = *(const unsigned*)(SGS + row * 1024 + mc);
                const unsigned m = *(const unsigned*)(MERGED + row * 1024 + mc);
                *(unsigned*)(MERGED + row * 1024 + mc) = pk2(bflo(m) + bflo(g) * s0, bfhi(m) + bfhi(g) * s1);
            }
        }
    }
};
struct EpiOut {
    const float* bias; const float* X; float* PRE; int row0, col0;
    __device__ __forceinline__ void operator()(const f32x4 (&acc)[4][4], int r_in, int c_in) const {
#pragma unroll
        for (int mi = 0; mi < 4; ++mi) {
            const size_t row = (size_t)(row0 + r_in + mi * 16);
#pragma unroll
            for (int ni = 0; ni < 4; ++ni) {
                const int col = col0 + c_in + ni * 16;
                const f32x4 xv = *(const f32x4*)(X + row * 1024 + col);
                *(f32x4*)(PRE + row * 1024 + col) = acc[mi][ni] + *(const f32x4*)(bias + col) + xv * ALPHA;
            }
        }
    }
};
struct EpiZ {
    float* Z; int row0;
    __device__ __forceinline__ void operator()(const f32x4 (&acc)[4][1], int r_in, int c_in) const {
#pragma unroll
        for (int mi = 0; mi < 4; ++mi) *(f32x4*)(Z + (size_t)(row0 + r_in + mi * 16) * 64 + c_in) = acc[mi][0];
    }
};
struct EpiGU {
    bf16* HID; int prow0, col0;
    __device__ __forceinline__ void operator()(const f32x4 (&acc)[4][4], int r_in, int c_in) const {
#pragma unroll
        for (int mi = 0; mi < 4; ++mi) {
            const size_t row = (size_t)(prow0 + r_in + mi * 16);
#pragma unroll
            for (int ni = 0; ni < 4; ++ni) {
                const int col = col0 + c_in + ni * 16;
                const f32x4 v = acc[mi][ni];
                *(unsigned*)(HID + row * 256 + (col >> 1)) = pk2(siluf_(v.x) * v.y, siluf_(v.z) * v.w);
            }
        }
    }
};
struct EpiDown {
    bf16* YM; const int* toklist; const float* GATE; int idx0, cnt, col0;
    __device__ __forceinline__ void operator()(const f32x4 (&acc)[4][4], int r_in, int c_in) const {
#pragma unroll
        for (int mi = 0; mi < 4; ++mi) {
            const int idx = idx0 + r_in + mi * 16;
            if (idx < cnt) {
                const int ent = toklist[idx];
                const float g = GATE[ent];
#pragma unroll
                for (int ni = 0; ni < 4; ++ni) {
                    const int col = col0 + c_in + ni * 16;
                    const f32x4 v = acc[mi][ni] * g;
                    u32x2 w; w.x = pk2(v.x, v.y); w.y = pk2(v.z, v.w);
                    *(u32x2*)(YM + (size_t)ent * 1024 + col) = w;
                }
            }
        }
    }
};

struct RowsDense { const bf16* base; size_t ld; __device__ __forceinline__ const bf16* operator()(int r) const { return base + (size_t)r * ld; } };
struct RowsGather {
    const bf16* HB; const int* toklist; int idx0, cnt;
    __device__ __forceinline__ const bf16* operator()(int r) const { const int idx = idx0 + r; const int tok = idx < cnt ? (toklist[idx] >> 1) : 0; return HB + (size_t)tok * 1024; }
};

constexpr int S5_WREG = 10752, S5_LBUF = 8 * S5_WREG;
__device__ __forceinline__ void s5_block_item(const Params& P, unsigned char* lds, int item) {
    unsigned char* ws = P.ws;
    int tid_ = threadIdx.x; asm volatile("" : "+v"(tid_));
    const int tid = tid_, lane = tid & 63, wave = __builtin_amdgcn_readfirstlane(tid >> 6);
    unsigned char* sbuf = lds + wave * S5_WREG; unsigned char* ubuf = sbuf + 8704; unsigned char* ybuf = sbuf + 9728;
    f32x4* Lbuf = (f32x4*)(lds + S5_LBUF);
    const int g = item & 31, bp = item >> 5;
    const int p32 = lane & 31, hf = lane >> 5;
    const float* atab = (const float*)(ws + WS_TAB + TAB_A);
    const float ar0 = atab[(g * 64 + p32) * 2], ai0 = atab[(g * 64 + p32) * 2 + 1];
    const float ar1 = atab[(g * 64 + p32 + 32) * 2], ai1 = atab[(g * 64 + p32 + 32) * 2 + 1];
    bf16x8 bb[4], cm[4];
#pragma unroll
    for (int q = 0; q < 4; ++q) {
        bb[q] = *(const bf16x8*)(ws + WS_TAB + TAB_BB + (((size_t)g * 4 + q) * 64 + lane) * 16);
        cm[q] = *(const bf16x8*)(ws + WS_TAB + TAB_CM + (((size_t)g * 4 + q) * 64 + lane) * 16);
    }
    const bf16* U = (const bf16*)(ws + WS_U);
    bf16* YG = (bf16*)(ws + WS_YG);
    const int a_seq = (p32 >> 2) & 1, a_ti = (p32 & 3) + 4 * (p32 >> 3);
    const int tbase = wave * 256;
    const bf16* ua = U + ((size_t)(2 * bp + a_seq) * SEQ + tbase + a_ti) * 512 + g * 16 + 8 * hf;
    const int ho = lane & 15, i4 = 4 * (lane >> 4);
    const float dsk = P.in[10][g * 16 + ho];
    const f32x16 z16 = {0.f, 0.f, 0.f, 0.f, 0.f, 0.f, 0.f, 0.f, 0.f, 0.f, 0.f, 0.f, 0.f, 0.f, 0.f, 0.f};
    float s0r = 0.f, s0i = 0.f, s1r = 0.f, s1i = 0.f;
    {
        bf16x8 afr[16];
#pragma unroll
        for (int blk = 0; blk < 16; ++blk) afr[blk] = *(const bf16x8*)(ua + (size_t)(blk * 16) * 512);
#pragma unroll
        for (int blk = 0; blk < 16; ++blk) {
            const bf16x8 af = afr[blk];
            const f32x16 b0r = mfma32_h(af, bb[0], z16, 0, 0, 0);
            const f32x16 b0i = mfma32_h(af, bb[1], z16, 0, 0, 0);
            const f32x16 b1r = mfma32_h(af, bb[2], z16, 0, 0, 0);
            const f32x16 b1i = mfma32_h(af, bb[3], z16, 0, 0, 0);
#pragma unroll
            for (int i = 0; i < 16; ++i) {
                float n0r = __builtin_fmaf(ar0, s0r, __builtin_fmaf(-ai0, s0i, b0r[i])); asm volatile("" : "+v"(n0r));
                float n0i = __builtin_fmaf(ar0, s0i, __builtin_fmaf(ai0, s0r, b0i[i]));  asm volatile("" : "+v"(n0i));
                float n1r = __builtin_fmaf(ar1, s1r, __builtin_fmaf(-ai1, s1i, b1r[i])); asm volatile("" : "+v"(n1r));
                float n1i = __builtin_fmaf(ar1, s1i, __builtin_fmaf(ai1, s1r, b1i[i]));  asm volatile("" : "+v"(n1i));
                s0r = n0r; s0i = n0i; s1r = n1r; s1i = n1i;
            }
        }
    }
    Lbuf[wave * 64 + lane] = (f32x4){s0r, s0i, s1r, s1i};
    __syncthreads();
    {
        float pr0 = ar0, pi0 = ai0, pr1 = ar1, pi1 = ai1;
#pragma unroll
        for (int i = 0; i < 8; ++i) {
            const float t0r = pr0 * pr0 - pi0 * pi0, t0i = 2.0f * pr0 * pi0, t1r = pr1 * pr1 - pi1 * pi1, t1i = 2.0f * pr1 * pi1;
            pr0 = t0r; pi0 = t0i; pr1 = t1r; pi1 = t1i;
        }
        s0r = 0.f; s0i = 0.f; s1r = 0.f; s1i = 0.f;
        for (int j = 0; j < wave; ++j) {
            const f32x4 L = Lbuf[j * 64 + lane];
            const float n0r = pr0 * s0r - pi0 * s0i + L.x, n0i = pr0 * s0i + pi0 * s0r + L.y;
            const float n1r = pr1 * s1r - pi1 * s1i + L.z, n1i = pr1 * s1i + pi1 * s1r + L.w;
            s0r = n0r; s0i = n0i; s1r = n1r; s1i = n1i;
        }
    }
    {
        bf16x8 af = *(const bf16x8*)ua;
        unsigned char* wrow = sbuf + (hf * 16) * 272 + 4 * p32;
        unsigned char* uw = ubuf + (a_seq * 16 + a_ti) * 32 + hf * 16;
        const int orow = lane >> 1, ohalf = lane & 1;
        bf16* yg_out = YG + ((size_t)(2 * bp + (orow >> 4)) * SEQ + tbase + (orow & 15)) * 512 + g * 16 + ohalf * 8;
        for (int blk = 0; blk < 16; ++blk) {
            const bf16x8 afn = *(const bf16x8*)(ua + (size_t)((blk < 15 ? blk + 1 : blk) * 16) * 512);
            *(bf16x8*)uw = af;
            const f32x16 b0r = mfma32_h(af, bb[0], z16, 0, 0, 0);
            const f32x16 b0i = mfma32_h(af, bb[1], z16, 0, 0, 0);
            const f32x16 b1r = mfma32_h(af, bb[2], z16, 0, 0, 0);
            const f32x16 b1i = mfma32_h(af, bb[3], z16, 0, 0, 0);
#pragma unroll
            for (int i = 0; i < 16; ++i) {
                float n0r = __builtin_fmaf(ar0, s0r, __builtin_fmaf(-ai0, s0i, b0r[i])); asm volatile("" : "+v"(n0r));
                float n0i = __builtin_fmaf(ar0, s0i, __builtin_fmaf(ai0, s0r, b0i[i]));  asm volatile("" : "+v"(n0i));
                float n1r = __builtin_fmaf(ar1, s1r, __builtin_fmaf(-ai1, s1i, b1r[i])); asm volatile("" : "+v"(n1r));
                float n1i = __builtin_fmaf(ar1, s1i, __builtin_fmaf(ai1, s1r, b1i[i]));  asm volatile("" : "+v"(n1i));
                s0r = n0r; s0i = n0i; s1r = n1r; s1i = n1i;
                *(unsigned*)(wrow + i * 272) = pk2(s0r, s0i);
                *(unsigned*)(wrow + i * 272 + 128) = pk2(s1r, s1i);
            }
            asm volatile("s_waitcnt lgkmcnt(0)" ::: "memory");
#pragma unroll
            for (int mb = 0; mb < 2; ++mb) {
                f32x4 y = {0.f, 0.f, 0.f, 0.f};
#pragma unroll
                for (int ks = 0; ks < 4; ++ks) {
                    const bf16x8 sf = *(const bf16x8*)(sbuf + (mb * 16 + (lane & 15)) * 272 + ks * 64 + (lane >> 4) * 16);
                    y = mfma16_h(sf, cm[ks], y, 0, 0, 0);
                }
#pragma unroll
                for (int r = 0; r < 4; ++r) {
                    const int ro = ((mb * 16 + i4 + r) * 32 + ho * 2);
                    const float yv = y[r] + dsk * bf2f(*(const bf16*)(ubuf + ro));
                    *(bf16*)(ybuf + ro) = (bf16)(pk2(geluf_(yv), 0.f) & 0xffffu);
                }
            }
            asm volatile("s_waitcnt lgkmcnt(0)" ::: "memory");
            const u32x4 yo = *(const u32x4*)(ybuf + orow * 32 + ohalf * 16);
            *(u32x4*)(yg_out + (size_t)(blk * 16) * 512) = yo;
            asm volatile("s_waitcnt lgkmcnt(0)" ::: "memory");
            af = afn;
        }
    }
    __syncthreads();
}

__device__ __forceinline__ void conv_phase(const Params& P, unsigned char* lds) {
    unsigned char* ws = P.ws;
    int tid_ = threadIdx.x; asm volatile("" : "+v"(tid_));
    const int tid = tid_, lane = tid & 63, wave = tid >> 6;
    const bf16* V = (const bf16*)(ws + WS_V);
    bf16* CV = (bf16*)(ws + WS_CV);
    unsigned char* vt = lds;
    float* ct = (float*)(lds + 63488);
    const int G = gridDim.x, nitems = T / 32;
    const int ch = tid;
    float w0[CW];
#pragma unroll
    for (int k = 0; k < CW; ++k) w0[k] = P.in[13][k * 512 + ch];
    const float cb0 = P.in[14][ch];
    const f32x4 g0 = *(const f32x4*)(P.in[15] + lane * 4), g1 = *(const f32x4*)(P.in[15] + 256 + lane * 4);
    const f32x4 b0 = *(const f32x4*)(P.in[16] + lane * 4), b1 = *(const f32x4*)(P.in[16] + 256 + lane * 4);
    u32x4 pf[8];
#define CONV_FETCH(item_) do { const int tokb_ = (item_) * 32, tloc_ = tokb_ & (SEQ - 1); \
        _Pragma("unroll") for (int n = 0; n < 8; ++n) { const int q = tid + n * NTHREADS; const int r = q >> 6, c16 = q & 63; \
            pf[n] = (u32x4){0u, 0u, 0u, 0u}; \
            if (q < 62 * 64 && tloc_ - 30 + r >= 0) pf[n] = *(const u32x4*)(V + (size_t)(tokb_ - 30 + r) * 512 + c16 * 8); } } while (0)
    int item = blockIdx.x;
    if (item < nitems) CONV_FETCH(item);
    for (; item < nitems; item += G) {
        const int tokb = item * 32;
#pragma unroll
        for (int n = 0; n < 8; ++n) { const int q = tid + n * NTHREADS; if (q < 62 * 64) *(u32x4*)(vt + (q >> 6) * 1024 + (q & 63) * 16) = pf[n]; }
        __syncthreads();
        if (item + G < nitems) CONV_FETCH(item + G);
#pragma unroll 1
        for (int jc = 0; jc < 4; ++jc) {
            const int base = jc * 8;
            float a0[8];
#pragma unroll
            for (int j = 0; j < 8; ++j) a0[j] = cb0;
#pragma unroll
            for (int r = 0; r < 38; ++r) {
                const float x0 = bf2f(*(const bf16*)(vt + (base + r) * 1024 + ch * 2));
#pragma unroll
                for (int j = 0; j < 8; ++j) {
                    const int k = r - j;
                    if (k >= 0 && k < CW) a0[j] += w0[k] * x0;
                }
            }
#pragma unroll
            for (int j = 0; j < 8; ++j) ct[(base + j) * 512 + ch] = a0[j];
        }
        __syncthreads();
#pragma unroll
        for (int rr = 0; rr < 4; ++rr) {
            const int row = wave * 4 + rr;
            const f32x4 c0 = *(const f32x4*)(ct + row * 512 + lane * 4), c1 = *(const f32x4*)(ct + row * 512 + 256 + lane * 4);
            const float mean = wave_sum((c0.x + c0.y) + (c0.z + c0.w) + (c1.x + c1.y) + (c1.z + c1.w)) * (1.0f / 512.0f);
            const f32x4 d0 = c0 - mean, d1 = c1 - mean;
            const float var = wave_sum((d0.x * d0.x + d0.y * d0.y) + (d0.z * d0.z + d0.w * d0.w) + (d1.x * d1.x + d1.y * d1.y) + (d1.z * d1.z + d1.w * d1.w)) * (1.0f / 512.0f);
            const float rstd = 1.0f / sqrtf(var + LN_EPS);
            const f32x4 y0 = d0 * rstd * g0 + b0, y1 = d1 * rstd * g1 + b1;
            u32x2 o0, o1;
            o0.x = pk2(siluf_(y0.x), siluf_(y0.y)); o0.y = pk2(siluf_(y0.z), siluf_(y0.w));
            o1.x = pk2(siluf_(y1.x), siluf_(y1.y)); o1.y = pk2(siluf_(y1.z), siluf_(y1.w));
            bf16* orow = CV + (size_t)(tokb + row) * 512;
            *(u32x2*)(orow + lane * 4) = o0; *(u32x2*)(orow + 256 + lane * 4) = o1;
        }
        __syncthreads();
    }
#undef CONV_FETCH
}

__device__ __forceinline__ void ln1_rows(const Params& P) {
    const int tid = threadIdx.x, lane = tid & 63, wave = tid >> 6;
    const int gw = blockIdx.x * 8 + wave, NGW = gridDim.x * 8;
    const float* PRE = P.out; bf16* HB = (bf16*)(P.ws + WS_HB);
    const float* lg = P.in[21]; const float* lb = P.in[22];
    f32x4 g[4], b[4];
#pragma unroll
    for (int j = 0; j < 4; ++j) { g[j] = *(const f32x4*)(lg + j * 256 + lane * 4); b[j] = *(const f32x4*)(lb + j * 256 + lane * 4); }
    for (int row = gw; row < T; row += NGW) {
        const float* xr = PRE + (size_t)row * 1024;
        f32x4 v[4]; float s = 0.f;
#pragma unroll
        for (int j = 0; j < 4; ++j) { v[j] = *(const f32x4*)(xr + j * 256 + lane * 4); s += (v[j].x + v[j].y) + (v[j].z + v[j].w); }
        const float mean = wave_sum(s) * (1.0f / 1024.0f); float s2 = 0.f;
#pragma unroll
        for (int j = 0; j < 4; ++j) { v[j] = v[j] - mean; s2 += (v[j].x * v[j].x + v[j].y * v[j].y) + (v[j].z * v[j].z + v[j].w * v[j].w); }
        const float rstd = 1.0f / sqrtf(wave_sum(s2) * (1.0f / 1024.0f) + LN_EPS);
        bf16* orow = HB + (size_t)row * 1024;
#pragma unroll
        for (int j = 0; j < 4; ++j) {
            const f32x4 y = v[j] * rstd * g[j] + b[j];
            u32x2 w; w.x = pk2(y.x, y.y); w.y = pk2(y.z, y.w);
            *(u32x2*)(orow + j * 256 + lane * 4) = w;
        }
    }
}
__device__ __forceinline__ void final_rows(const Params& P) {
    int tid_ = threadIdx.x; asm volatile("" : "+v"(tid_));
    const int tid = tid_, lane = tid & 63, wave = tid >> 6;
    const int gw = blockIdx.x * 8 + wave, NGW = gridDim.x * 8;
    const bf16* HB = (const bf16*)(P.ws + WS_HB); const bf16* YM = (const bf16*)(P.ws + WS_YM);
    const float* lg = P.in[30]; const float* lb = P.in[31];
    f32x4 g[4], b[4];
#pragma unroll
    for (int j = 0; j < 4; ++j) { g[j] = *(const f32x4*)(lg + j * 256 + lane * 4); b[j] = *(const f32x4*)(lb + j * 256 + lane * 4); }
#pragma unroll 2
    for (int row = gw; row < T; row += NGW) {
        f32x4 v[4]; float s = 0.f;
#pragma unroll
        for (int j = 0; j < 4; ++j) {
            const u32x2 h = *(const u32x2*)(HB + (size_t)row * 1024 + j * 256 + lane * 4);
            const u32x2 y0 = *(const u32x2*)(YM + (size_t)(2 * row) * 1024 + j * 256 + lane * 4);
            const u32x2 y1 = *(const u32x2*)(YM + (size_t)(2 * row + 1) * 1024 + j * 256 + lane * 4);
            v[j].x = ALPHA * bflo(h.x) + bflo(y0.x) + bflo(y1.x); v[j].y = ALPHA * bfhi(h.x) + bfhi(y0.x) + bfhi(y1.x);
            v[j].z = ALPHA * bflo(h.y) + bflo(y0.y) + bflo(y1.y); v[j].w = ALPHA * bfhi(h.y) + bfhi(y0.y) + bfhi(y1.y);
            s += (v[j].x + v[j].y) + (v[j].z + v[j].w);
        }
        const float mean = wave_sum(s) * (1.0f / 1024.0f); float s2 = 0.f;
#pragma unroll
        for (int j = 0; j < 4; ++j) { v[j] = v[j] - mean; s2 += (v[j].x * v[j].x + v[j].y * v[j].y) + (v[j].z * v[j].z + v[j].w * v[j].w); }
        const float rstd = 1.0f / sqrtf(wave_sum(s2) * (1.0f / 1024.0f) + LN_EPS);
        float* orow = P.out + (size_t)row * 1024;
#pragma unroll
        for (int j = 0; j < 4; ++j) *(f32x4*)(orow + j * 256 + lane * 4) = v[j] * rstd * g[j] + b[j];
    }
}
struct EpiZlds {
    float* Zs;
    __device__ __forceinline__ void operator()(const f32x4 (&acc)[4][4], int r_in, int c_in) const {
        if (c_in >= 64) return;
#pragma unroll
        for (int mi = 0; mi < 4; ++mi)
#pragma unroll
            for (int ni = 0; ni < 3; ++ni) {
                const int c = c_in + ni * 16;
                if (c < 40) *(f32x4*)(Zs + (r_in + mi * 16) * 40 + c) = acc[mi][ni];
            }
    }
};
__device__ __forceinline__ void ln_route_phase(const Params& P, unsigned char* lds) {
    unsigned char* ws = P.ws;
    int tid_ = threadIdx.x; asm volatile("" : "+v"(tid_));
    const int tid = tid_, lane = tid & 63, wave = tid >> 6, r = lane & 15, q = lane >> 4;
    const bf16* PREB = (const bf16*)(ws + WS_PREB); bf16* HB = (bf16*)(ws + WS_HB);
    int* CNT = (int*)(ws + WS_CTL); int* TOK = (int*)(ws + WS_TOK); float* GATE = (float*)(ws + WS_GATE);
    const float* lg = P.in[21]; const float* lb = P.in[22];
    const float* brg = P.in[24]; const float* bre = P.in[26];
    unsigned char* wl = lds;
    float* gl = (float*)(lds + 74304);
    float* zt = (float*)(lds + 82496 + wave * 3328);
    int* hist = (int*)(lds + 109120); int* base = hist + 32;
    for (int t = blockIdx.x; t < T / 128; t += gridDim.x) {
        asm volatile("" ::: "memory");
        int q8 = q * 8, ro = r * 1024 + q * 8;
        asm volatile("" : "+v"(q8), "+v"(ro));
#pragma unroll
        for (int i = 0; i < 9; ++i) {
            const int h = i * 8 + wave, wrow = h >> 1, half = h & 1;
            glds16((const bf16*)(ws + WS_WR) + wrow * 1024 + half * 512 + lane * 8, wl + wrow * 2064 + half * 1024 + lane * 16);
        }
        glds16(tid < 256 ? lg + tid * 4 : lb + (tid - 256) * 4, (unsigned char*)gl + tid * 16);
        const unsigned char* wrp0 = wl + (ro >> 10) * 2064 + q8 * 2;
        const unsigned char* wrp2 = wl + (32 + ((ro >> 10) & 3)) * 2064 + q8 * 2;
        const float* lgq = gl + q8; const float* lbq = gl + 1024 + q8;
        if (tid < 32) hist[tid] = 0;
        const size_t row = (size_t)t * 128 + wave * 16 + r;
        const bf16* prow = PREB + row * 1024 + q8;
        u32x4 pv[32];
#pragma unroll
        for (int s = 0; s < 32; ++s) pv[s] = *(const u32x4*)(prow + s * 32);
        float sm = 0.f;
#pragma unroll
        for (int s = 0; s < 32; ++s)
            sm += ((bflo(pv[s].x) + bfhi(pv[s].x)) + (bflo(pv[s].y) + bfhi(pv[s].y))) + ((bflo(pv[s].z) + bfhi(pv[s].z)) + (bflo(pv[s].w) + bfhi(pv[s].w)));
        sm += __shfl_xor(sm, 16); sm += __shfl_xor(sm, 32);
        const float mean = sm * (1.0f / 1024.0f);
#pragma unroll
        for (int s = 0; s < 32; ++s) asm volatile("" : "+v"(pv[s]));
        float s2 = 0.f;
#pragma unroll
        for (int s = 0; s < 32; ++s) {
            const float d0 = bflo(pv[s].x) - mean, d1 = bfhi(pv[s].x) - mean, d2 = bflo(pv[s].y) - mean, d3 = bfhi(pv[s].y) - mean;
            const float d4 = bflo(pv[s].z) - mean, d5 = bfhi(pv[s].z) - mean, d6 = bflo(pv[s].w) - mean, d7 = bfhi(pv[s].w) - mean;
            s2 += ((d0 * d0 + d1 * d1) + (d2 * d2 + d3 * d3)) + ((d4 * d4 + d5 * d5) + (d6 * d6 + d7 * d7));
        }
        s2 += __shfl_xor(s2, 16); s2 += __shfl_xor(s2, 32);
        const float rstd = 1.0f / sqrtf(s2 * (1.0f / 1024.0f) + LN_EPS);
#pragma unroll
        for (int s = 0; s < 32; ++s) asm volatile("" : "+v"(pv[s]));
        asm volatile("s_waitcnt vmcnt(0)" ::: "memory");
        __syncthreads();
        f32x4 acc[3];
#pragma unroll
        for (int i = 0; i < 3; ++i) acc[i] = (f32x4){0.f, 0.f, 0.f, 0.f};
        bf16* hrow = HB + row * 1024 + q8;
#pragma unroll
        for (int s = 0; s < 32; ++s) {
            const f32x4 g0 = *(const f32x4*)(lgq + s * 32), g1 = *(const f32x4*)(lgq + s * 32 + 4);
            const f32x4 b0 = *(const f32x4*)(lbq + s * 32), b1 = *(const f32x4*)(lbq + s * 32 + 4);
            const f32x4 v0 = {bflo(pv[s].x), bfhi(pv[s].x), bflo(pv[s].y), bfhi(pv[s].y)}, v1 = {bflo(pv[s].z), bfhi(pv[s].z), bflo(pv[s].w), bfhi(pv[s].w)};
            const f32x4 y0 = (v0 - mean) * rstd * g0 + b0, y1 = (v1 - mean) * rstd * g1 + b1;
            u32x4 w; w.x = pk2(y0.x, y0.y); w.y = pk2(y0.z, y0.w); w.z = pk2(y1.x, y1.y); w.w = pk2(y1.z, y1.w);
            *(u32x4*)(hrow + s * 32) = w;
            const bf16x8 a = __builtin_bit_cast(bf16x8, w);
            acc[0] = mfma16_h(*(const bf16x8*)(wrp0 + s * 64), a, acc[0], 0, 0, 0);
            acc[1] = mfma16_h(*(const bf16x8*)(wrp0 + 16 * 2064 + s * 64), a, acc[1], 0, 0, 0);
            acc[2] = mfma16_h(*(const bf16x8*)(wrp2 + s * 64), a, acc[2], 0, 0, 0);
        }
#pragma unroll
        for (int nt = 0; nt < 3; ++nt) *(f32x4*)(zt + r * 52 + nt * 16 + 4 * q) = acc[nt];
        __syncthreads();
        const size_t tok = (size_t)t * 128 + wave * 16 + lane;
        int e0 = 0, e1 = 0, r0 = 0, r1 = 0;
        if (lane < 16) {
            const float* z = zt + lane * 52;
            float zg[4];
#pragma unroll
            for (int i = 0; i < 4; ++i) zg[i] = z[i] + brg[i];
            int gs = 0; float mx = zg[0];
#pragma unroll
            for (int i = 1; i < 4; ++i) if (zg[i] > mx) { mx = zg[i]; gs = i; }
            float den = 0.f;
#pragma unroll
            for (int i = 0; i < 4; ++i) den += __expf(zg[i] - mx);
            const float pgrp = 1.0f / den;
            float ze[8];
#pragma unroll
            for (int i = 0; i < 8; ++i) ze[i] = z[4 + gs * 8 + i] + bre[gs * 8 + i];
            int i0 = 0; float v0 = ze[0];
#pragma unroll
            for (int i = 1; i < 8; ++i) if (ze[i] > v0) { v0 = ze[i]; i0 = i; }
            int i1 = -1; float v1 = -3.0e38f;
#pragma unroll
            for (int i = 0; i < 8; ++i) if (i != i0 && ze[i] > v1) { v1 = ze[i]; i1 = i; }
            const float sx = __expf(v1 - v0);
            const float g0 = pgrp / (1.0f + sx), g1 = pgrp * sx / (1.0f + sx);
            e0 = gs * 8 + i0; e1 = gs * 8 + i1;
            GATE[tok * 2] = g0; GATE[tok * 2 + 1] = g1;
            r0 = atomicAdd(&hist[e0], 1); r1 = atomicAdd(&hist[e1], 1);
        }
        __syncthreads();
        if (tid < 32) base[tid] = atomicAdd(&CNT[tid], hist[tid]);
        __syncthreads();
        if (lane < 16) {
            TOK[(size_t)e0 * T + base[e0] + r0] = (int)(tok * 2);
            TOK[(size_t)e1 * T + base[e1] + r1] = (int)(tok * 2 + 1);
        }
        __syncthreads();
    }
}

#define LAS __attribute__((address_space(3)))
#define XB_TMO      128
#define XB_XCNT(j)  (256  + 64 * (j))
#define XB_XSUB(j)  (1280 + 64 * (j))
#define XB_XGEN(j)  (2304 + 64 * (j))
#define XB_TOP      3328
#define XB_TOPGEN   3392
#define XCD_BAR_WORDS 3456
#define XB_SPIN_CAP (1u << 20)
__device__ __forceinline__ unsigned xb_ld(unsigned* p)              { return __hip_atomic_load(p, __ATOMIC_RELAXED, __HIP_MEMORY_SCOPE_AGENT); }
__device__ __forceinline__ unsigned xb_add(unsigned* p, unsigned v) { return __hip_atomic_fetch_add(p, v, __ATOMIC_RELAXED, __HIP_MEMORY_SCOPE_AGENT); }
__device__ __forceinline__ unsigned xb_xcc_id() { return (unsigned)__builtin_amdgcn_s_getreg((3 << 11) | 20) & 0xFu; }
#define XB_SPIN(cond, bar) do { unsigned _sp = 0; while (cond) { __builtin_amdgcn_s_sleep(1); \
    if ((++_sp & 255u) == 0u) { if (xb_ld(&(bar)[XB_TMO])) break; if (_sp > XB_SPIN_CAP) { atomicAdd(&(bar)[XB_TMO], 1u); break; } } } } while (0)
struct XcdBarrier { unsigned* bar; unsigned x; volatile LAS unsigned* st; };
__device__ __forceinline__ XcdBarrier xcd_barrier_post(unsigned* bar, volatile LAS unsigned* st) {
    XcdBarrier b; b.bar = bar; b.x = xb_xcc_id(); b.st = st;
    if (threadIdx.x == 0) (void)xb_add(&bar[XB_XCNT(b.x)], 1u);
    return b;
}
__device__ __forceinline__ void xcd_barrier_complete(unsigned* bar, unsigned x, unsigned& nloc, unsigned& nx) {
    const unsigned G = gridDim.x * gridDim.y * gridDim.z;
    unsigned sum, cnt, mine, sp = 0u;
    for (;;) {
        sum = 0u; cnt = 0u; mine = 0u;
#pragma unroll
        for (unsigned j = 0; j < 16; ++j) { const unsigned c = xb_ld(&bar[XB_XCNT(j)]); sum += c; cnt += (c > 0u) ? 1u : 0u; mine = (j == x) ? c : mine; }
        if (sum == G) break;
        __builtin_amdgcn_s_sleep(1);
        if ((++sp & 255u) == 0u) { if (xb_ld(&bar[XB_TMO])) break; if (sp > XB_SPIN_CAP) { atomicAdd(&bar[XB_TMO], 1u); break; } }
    }
    nloc = mine > 0u ? mine : 1u; nx = cnt > 0u ? cnt : 1u;
}
__device__ __forceinline__ void xcd_barrier(const XcdBarrier& b) {
    asm volatile("s_waitcnt vmcnt(0)" ::: "memory");
    __syncthreads();
    if (threadIdx.x == 0) {
        unsigned* bar = b.bar;
        __builtin_amdgcn_s_waitcnt(0);
        unsigned nloc = b.st[0], nx = b.st[1];
        if (nloc == 0u) { xcd_barrier_complete(bar, b.x, nloc, nx); b.st[0] = nloc; b.st[1] = nx; }
        const unsigned old = xb_add(&bar[XB_XSUB(b.x)], 1u);
        const unsigned gen = old / nloc;
        if (old + 1u == (gen + 1u) * nloc) {
            __builtin_amdgcn_fence(__ATOMIC_RELEASE, "agent");
            asm volatile("s_waitcnt vmcnt(0)" ::: "memory");
            const unsigned og = xb_add(&bar[XB_TOP], 1u);
            const unsigned tg = og / nx;
            if (og + 1u == (tg + 1u) * nx) xb_add(&bar[XB_TOPGEN], 1u);
            else XB_SPIN(xb_ld(&bar[XB_TOPGEN]) == tg, bar);
            __builtin_amdgcn_fence(__ATOMIC_ACQUIRE, "agent");
            xb_add(&bar[XB_XGEN(b.x)], 1u);
            asm volatile("s_waitcnt vmcnt(0)" ::: "memory");
        } else {
            XB_SPIN(xb_ld(&bar[XB_XGEN(b.x)]) == gen, bar);
            __builtin_amdgcn_fence(__ATOMIC_ACQUIRE, "agent");
            asm volatile("s_waitcnt vmcnt(0)" ::: "memory");
        }
    }
    __syncthreads();
}

__device__ __forceinline__ void run_phase(const Params& P, unsigned char* lds, int ph) {
    unsigned char* ws = P.ws;
    const int G = gridDim.x, bid = blockIdx.x;
    switch (ph) {
    case 0: phase_prep(P, lds); break;
    case 1: {
        pg8::Gemm g{(const pg8::bf16_t*)(ws + WS_XB), (const pg8::bf16_t*)(ws + WS_WIN), T, DIN, D};
        pg8::StaticOrder S; S.init(T, DIN, G, bid);
        pg8::EpiProj E{(const float*)(ws + WS_TAB + TAB_BINP), (bf16*)(ws + WS_U), (bf16*)(ws + WS_V), (bf16*)(ws + WS_SGS), (bf16*)(ws + WS_SGC)};
        pg8::gemm_phase<pg8::EpiProj, pg8::StaticOrder, true, true>((PG8_LAS unsigned char*)lds, g, S, E);
    } break;
    case 2: {
        for (int it = bid; it < 256; it += G) s5_block_item(P, lds, it);
        conv_phase(P, lds);
    } break;
    case 3: {
        static_assert(WS_CV == WS_YG + (size_t)T * DSSM * 2 && WS_WCOUT == WS_WGLU + (size_t)2 * D * DSSM * 2 && DSSM == DCONV && T / 256 == 128, "virtual operands must be contiguous");
        pg8::Gemm g{(const pg8::bf16_t*)(ws + WS_YG), (const pg8::bf16_t*)(ws + WS_WGLU), 2 * T, 3 * D, DSSM};
        pg8::TripleOrder S; S.so.init(T, D, G, bid);
        pg8::EpiCG E{{P.in[18], (const bf16*)(ws + WS_SGC), (bf16*)(ws + WS_M1)},
                     {(const float*)(ws + WS_TAB + TAB_BGLUP), (const bf16*)(ws + WS_SGS), (const bf16*)(ws + WS_M1), (bf16*)(ws + WS_MERGED)}};
        pg8::gemm_phase<pg8::EpiCG, pg8::TripleOrder, true, true>((PG8_LAS unsigned char*)lds, g, S, E);
    } break;
    case 5: {
        pg8::Gemm g{(const pg8::bf16_t*)(ws + WS_MERGED), (const pg8::bf16_t*)(ws + WS_WOUT), T, D, D};
        pg8::StaticOrder S; S.init(T, D, G, bid);
        pg8::EpiOut E{P.in[20], (const bf16*)(ws + WS_XB), (bf16*)(ws + WS_PREB), ALPHA};
        pg8::gemm_phase<pg8::EpiOut, pg8::StaticOrder, true, true>((PG8_LAS unsigned char*)lds, g, S, E);
    } break;
    case 6: ln_route_phase(P, lds); break;
    case 9: {
        const int* CNT = (const int*)(ws + WS_CTL);
        PG8_LAS int* tab = (PG8_LAS int*)((PG8_LAS unsigned char*)lds + LDS_MISC + 64);
        if (threadIdx.x == 0) {
            int up = 0, bp = 0;
            for (int e = 0; e < NEXP; ++e) { const int cnt = CNT[e], nb = (cnt + 255) >> 8; tab[e] = up; tab[64 + e] = bp; tab[128 + e] = cnt; up += nb * 2; bp += nb; }
            tab[32] = up; tab[96] = bp;
        }
        __syncthreads();
        pg8::Gemm g{(const pg8::bf16_t*)(ws + WS_HB), (const pg8::bf16_t*)(ws + WS_WGU), 0, NEXP * 512, D};
        pg8::MoeOrder S{tab, G, bid, 1};
        pg8::MoeRows R{tab, (const int*)(ws + WS_TOK), T, (unsigned)(D * 2)};
        pg8::EpiGUP E{(bf16*)(ws + WS_HID)};
        pg8::gemm_phase_gather<pg8::EpiGUP, pg8::MoeOrder, pg8::MoeRows>((PG8_LAS unsigned char*)lds, g, S, E, R);
        __syncthreads();
    } break;
    case 10: {
        const int* CNT = (const int*)(ws + WS_CTL);
        PG8_LAS int* tab = (PG8_LAS int*)((PG8_LAS unsigned char*)lds + LDS_MISC + 64);
        if (threadIdx.x == 0) {
            int up = 0, bp = 0;
            for (int e = 0; e < NEXP; ++e) { const int cnt = CNT[e], nb = (cnt + 255) >> 8; tab[e] = up; tab[64 + e] = bp; tab[128 + e] = cnt; up += nb * 4; bp += nb; }
            tab[32] = up; tab[96] = bp;
        }
        __syncthreads();
        pg8::Gemm g{(const pg8::bf16_t*)(ws + WS_HID), (const pg8::bf16_t*)(ws + WS_WD), 0, NEXP * D, DFF};
        pg8::MoeOrder S{tab, G, bid, 2};
        pg8::EpiDownP E{tab, (const int*)(ws + WS_TOK), (const float*)(ws + WS_GATE), (bf16*)(ws + WS_YM), (bf16*)(ws + WS_Z), T};
        pg8::gemm_phase<pg8::EpiDownP, pg8::MoeOrder, true, true>((PG8_LAS unsigned char*)lds, g, S, E);
    } break;
    case 11: final_rows(P); break;
    default: break;
    }
}

#if ONE_LAUNCH
__global__ void __launch_bounds__(NTHREADS) fwd_kernel(Params P) {
    extern __shared__ __attribute__((aligned(16))) unsigned char lds[];
    if (P.ph_hi < 0) cg::this_grid().sync();
    volatile LAS unsigned* misc = (volatile LAS unsigned*)(LAS unsigned char*)(lds + LDS_MISC);
    if (threadIdx.x < 4) misc[threadIdx.x] = 0u;
    __syncthreads();
    XcdBarrier bar = xcd_barrier_post((unsigned*)(P.ws + WS_CTL) + CTL_BAR, misc);
#define GSYNC() xcd_barrier(bar)
    run_phase(P, lds, 0); GSYNC();
    run_phase(P, lds, 1); GSYNC();
    run_phase(P, lds, 2); GSYNC();
    run_phase(P, lds, 3); GSYNC();
    run_phase(P, lds, 5); GSYNC();
    run_phase(P, lds, 6); GSYNC();
    run_phase(P, lds, 9); GSYNC();
    run_phase(P, lds, 10); GSYNC();
    run_phase(P, lds, 11);
}
#else
template <int PH>
__global__ void __launch_bounds__(NTHREADS) phase_kernel(Params P) {
    extern __shared__ __attribute__((aligned(16))) unsigned char lds[];
    run_phase(P, lds, PH);
}
template <int PH> static void launch_phase(int grid, const Params& p, hipStream_t stream) {
    static bool init = false;
    if (!init) { (void)hipFuncSetAttribute((const void*)phase_kernel<PH>, hipFuncAttributeMaxDynamicSharedMemorySize, LDS_BYTES); init = true; }
    hipLaunchKernelGGL(phase_kernel<PH>, dim3(grid), dim3(NTHREADS), LDS_BYTES, stream, p);
}
#endif

extern "C" void kernel_launch(void* const* d_in, const int* in_sizes, int n_in, void* d_out, int out_size, void* d_ws, size_t ws_size, hipStream_t stream) {
    static int grid = 0;
    if (grid == 0) {
        if (n_in != 32 || in_sizes[0] != T * D || out_size != T * D || ws_size < WS_END) {
            fprintf(stderr, "kernel_launch: unexpected shapes (n_in %d, in0 %d, out %d, ws %zu)\n", n_in, n_in > 0 ? in_sizes[0] : -1, out_size, ws_size);
            grid = -1; return;
        }
        int dev = 0, cus = 0, per_cu = 1;
        (void)hipGetDevice(&dev);
        (void)hipDeviceGetAttribute(&cus, hipDeviceAttributeMultiprocessorCount, dev);
#if ONE_LAUNCH
        (void)hipFuncSetAttribute((const void*)fwd_kernel, hipFuncAttributeMaxDynamicSharedMemorySize, LDS_BYTES);
        (void)hipOccupancyMaxActiveBlocksPerMultiprocessor(&per_cu, (const void*)fwd_kernel, NTHREADS, LDS_BYTES);
        if (per_cu < 1) per_cu = 1;
#endif
        grid = cus * per_cu;
        (void)hipGetLastError();
    }
    if (grid < 0) return;
    if (hipMemsetAsync((char*)d_ws + WS_CTL, 0, CTL_ZERO_BYTES, stream) != hipSuccess) { fprintf(stderr, "kernel_launch: memset failed\n"); return; }
    Params p{};
    for (int i = 0; i < 32; ++i) p.in[i] = (const float*)d_in[i];
    p.out = (float*)d_out; p.ws = (unsigned char*)d_ws;
#if ONE_LAUNCH
    p.ph_lo = 0; p.ph_hi = NPHASE;
    void* args[] = {&p};
    hipError_t e = hipLaunchCooperativeKernel((const void*)fwd_kernel, dim3(grid), dim3(NTHREADS), args, LDS_BYTES, stream);
    if (e != hipSuccess) fprintf(stderr, "cooperative launch failed: %s (grid %d)\n", hipGetErrorString(e), grid);
#else
    p.ph_lo = 0; p.ph_hi = NPHASE;
    launch_phase<0>(grid, p, stream); launch_phase<1>(grid, p, stream); launch_phase<2>(grid, p, stream); launch_phase<3>(grid, p, stream);
    launch_phase<4>(grid, p, stream); launch_phase<5>(grid, p, stream); launch_phase<6>(grid, p, stream); launch_phase<7>(grid, p, stream);
    launch_phase<8>(grid, p, stream); launch_phase<9>(grid, p, stream); launch_phase<10>(grid, p, stream); launch_phase<11>(grid, p, stream);
#endif
}
```

```cpp
#include <hip/hip_runtime.h>
#include <hip/hip_cooperative_groups.h>
#include <cstdio>
#include <cstdint>
namespace cg = cooperative_groups;

#ifndef ONE_LAUNCH
#define ONE_LAUNCH 1
#endif

typedef unsigned short bf16;
typedef short bf16x8 __attribute__((ext_vector_type(8)));
typedef float f32x4 __attribute__((ext_vector_type(4)));
typedef float f32x16 __attribute__((ext_vector_type(16)));
typedef unsigned u32x2 __attribute__((ext_vector_type(2)));
typedef unsigned u32x4 __attribute__((ext_vector_type(4)));

constexpr int T = 32768, D = 1024, SEQ = 2048, NB = 16;
constexpr int DIN = 3584, DSSM = 512, NGRP = 32, NST = 64, NH = 16, DCONV = 512, CW = 31;
constexpr int NEXP = 32, DFF = 256;
constexpr float LN_EPS = 1e-5f;
constexpr float ALPHA = 1.189207115002721f;
constexpr int NPHASE = 12;
constexpr int NTHREADS = 512;
constexpr int LDS_BYTES = 131072 + 2048, LDS_MISC = 131072;
constexpr int CTL_BAR = 4096;
constexpr size_t CTL_ZERO_BYTES = 65536;

constexpr size_t MiB = 1u << 20;
constexpr size_t WS_CTL = 0;
constexpr size_t WS_TAB = 1 * MiB;
constexpr size_t TAB_BINP = 0, TAB_BGLUP = 16384, TAB_A = 32768, TAB_BB = 65536, TAB_CM = 65536 + 131072;
constexpr size_t WS_WIN = 2 * MiB, WS_WGLU = 9 * MiB, WS_WCOUT = 11 * MiB, WS_WOUT = 12 * MiB, WS_WR = 14 * MiB;
constexpr size_t WS_WGU = 16 * MiB, WS_WD = 48 * MiB;
constexpr size_t WS_M1 = 128 * MiB, WS_PREB = 256 * MiB;
constexpr size_t WS_XB = 64 * MiB, WS_U = 128 * MiB, WS_V = 160 * MiB, WS_YM = 64 * MiB;
constexpr size_t WS_SGS = 192 * MiB, WS_HB = 192 * MiB, WS_SGC = 256 * MiB;
constexpr size_t WS_YG = 320 * MiB, WS_CV = 352 * MiB, WS_MERGED = 384 * MiB;
constexpr size_t WS_HID = 448 * MiB, WS_Z = 488 * MiB, WS_TOK = 496 * MiB, WS_GATE = 500 * MiB, WS_END = 501 * MiB;

struct Params {
    const float* in[32];
    float* out;
    unsigned char* ws;
    int ph_lo, ph_hi;
};

typedef float f32x2_t __attribute__((ext_vector_type(2)));
typedef _Float16 h2_t __attribute__((ext_vector_type(2)));
typedef _Float16 h8_t __attribute__((ext_vector_type(8)));
__device__ __forceinline__ unsigned pk2(float lo, float hi) { const f32x2_t v = {lo, hi}; const h2_t h = __builtin_convertvector(v, h2_t); return __builtin_bit_cast(unsigned, h); }
__device__ __forceinline__ unsigned f2bf(float f) { return pk2(f, 0.f) & 0xffffu; }
__device__ __forceinline__ float bflo(unsigned w) { return (float)__builtin_bit_cast(h2_t, w).x; }
__device__ __forceinline__ float bfhi(unsigned w) { return (float)__builtin_bit_cast(h2_t, w).y; }
__device__ __forceinline__ float bf2f(bf16 b) { return (float)__builtin_bit_cast(_Float16, b); }
__device__ __forceinline__ f32x4 mfma16_h(bf16x8 a, bf16x8 b, f32x4 c, int, int, int) { return __builtin_amdgcn_mfma_f32_16x16x32_f16(__builtin_bit_cast(h8_t, a), __builtin_bit_cast(h8_t, b), c, 0, 0, 0); }
__device__ __forceinline__ f32x16 mfma32_h(bf16x8 a, bf16x8 b, f32x16 c, int, int, int) { return __builtin_amdgcn_mfma_f32_32x32x16_f16(__builtin_bit_cast(h8_t, a), __builtin_bit_cast(h8_t, b), c, 0, 0, 0); }
__device__ __forceinline__ float sigmoidf_(float z) { return __builtin_amdgcn_rcpf(1.0f + __expf(-z)); }
__device__ __forceinline__ float siluf_(float z) { return z * sigmoidf_(z); }
__device__ __forceinline__ float geluf_(float x) { const float z = 1.5957691216057308f * (x + 0.044715f * x * x * x); return x * sigmoidf_(z); }
__device__ __forceinline__ float wave_sum(float v) {
    v += __builtin_bit_cast(float, __builtin_amdgcn_update_dpp(0, __builtin_bit_cast(int, v), 0xB1, 0xF, 0xF, true));
    v += __builtin_bit_cast(float, __builtin_amdgcn_update_dpp(0, __builtin_bit_cast(int, v), 0x4E, 0xF, 0xF, true));
    v += __builtin_bit_cast(float, __builtin_amdgcn_update_dpp(0, __builtin_bit_cast(int, v), 0x141, 0xF, 0xF, true));
    v += __builtin_bit_cast(float, __builtin_amdgcn_update_dpp(0, __builtin_bit_cast(int, v), 0x140, 0xF, 0xF, true));
    const int iv = __builtin_bit_cast(int, v);
    const float r0 = __builtin_bit_cast(float, __builtin_amdgcn_readlane(iv, 0)), r1 = __builtin_bit_cast(float, __builtin_amdgcn_readlane(iv, 16));
    const float r2 = __builtin_bit_cast(float, __builtin_amdgcn_readlane(iv, 32)), r3 = __builtin_bit_cast(float, __builtin_amdgcn_readlane(iv, 48));
    return (r0 + r1) + (r2 + r3);
}
__device__ __forceinline__ void glds16(const void* g, void* l) {
    __builtin_amdgcn_global_load_lds((const __attribute__((address_space(1))) unsigned*)g, (__attribute__((address_space(3))) unsigned*)l, 16, 0, 0);
}

namespace pg8 {
#define PG8_LAS __attribute__((address_space(3)))
typedef unsigned short bf16_t;
typedef short bf16x8 __attribute__((ext_vector_type(8)));
typedef float f32x4 __attribute__((ext_vector_type(4)));
typedef unsigned u32x4 __attribute__((ext_vector_type(4)));
constexpr int BM = 256, BK = 64, HALF = 128, HTB = HALF * BK * 2  , STAGE_BYTES = 8 * HTB, NXCD = 8, WGM = 8;

__host__ __device__ __forceinline__ int lds_byte(int r, int c) { const int st = (r >> 4) * 2 + (c >> 5), rr = r & 15, cc = c & 31, ob = rr * 64 + cc * 2; return st * 1024 + (ob ^ (((ob >> 9) & 1) << 5)); }
__host__ __device__ __forceinline__ void stage_rc(int b, int& R, int& C) { const int st = b / 1024, sb = b % 1024, swz = sb ^ (((sb >> 9) & 1) << 5); R = (st >> 1) * 16 + swz / 64; C = (st & 1) * 32 + (swz % 64) / 2; }
__host__ __device__ __forceinline__ int perm32(int rho) { const int n = rho >> 4, i = rho & 15; return 8 * (i >> 2) + 4 * n + (i & 3); }

struct Unit { int pm, pn; };
struct Gemm { const bf16_t* A; const bf16_t* Bt; int M, N, K; };

struct StaticOrder {
    int nM, nN, nwg, G, c;
    __host__ __device__ void init(int M, int N, int G_, int c_) { nM = M / BM; nN = N / BM; nwg = nM * nN; G = G_; c = c_; }
    __host__ __device__ bool next(int i, Unit& u) const {
        const long L = (long)i * G + c; if (L >= nwg) return false;
        int wgid = (int)L; { const int q = nwg / NXCD, r = nwg % NXCD, xcd = wgid % NXCD, off = wgid / NXCD; wgid = (xcd < r ? xcd * (q + 1) : r * (q + 1) + (xcd - r) * q) + off; }
        const int nig = WGM * nN, gid = wgid / nig, fm = gid * WGM, gsz = (nM - fm) < WGM ? (nM - fm) : WGM;
        u.pm = fm + ((wgid % nig) % gsz); u.pn = (wgid % nig) / gsz; return true;
    }
    __device__ __forceinline__ void a_ready(const Unit&) const {}
    __device__ __forceinline__ void done(const Unit&) const {}
};

__device__ __forceinline__ unsigned pk2_(float lo, float hi) { return ::pk2(lo, hi); }
__device__ __forceinline__ float sg_(float z) { return __builtin_amdgcn_rcpf(1.0f + __expf(-z)); }
__device__ __forceinline__ float lo_(unsigned w) { return ::bflo(w); }
__device__ __forceinline__ float hi_(unsigned w) { return ::bfhi(w); }
typedef unsigned u32x2 __attribute__((ext_vector_type(2)));
struct EpiProj {
    static constexpr bool PERM = true, AFTER_DRAIN = false;
    const float* binp; bf16_t* U; bf16_t* V; bf16_t* SGS; bf16_t* SGC;
    __device__ __forceinline__ void operator()(const f32x4 (&acc)[2][2][4][2], const Unit& u, int wr, int wc, int fr, int fq) const {
        const int row0 = u.pm * BM + wr * 64 + fr, colt = u.pn * BM, c0 = colt + wc * 32 + 8 * fq;
        f32x4 bv[2][2];
#pragma unroll
        for (int bj = 0; bj < 2; ++bj)
#pragma unroll
            for (int n = 0; n < 2; ++n) bv[bj][n] = *(const f32x4*)(binp + c0 + bj * HALF + 4 * n);
#pragma unroll
        for (int ai = 0; ai < 2; ++ai)
#pragma unroll
            for (int m = 0; m < 4; ++m) {
                const size_t row = (size_t)(row0 + ai * HALF + m * 16);
#pragma unroll
                for (int bj = 0; bj < 2; ++bj) {
                    const int c8 = c0 + bj * HALF;
                    const f32x4 v0 = acc[ai][bj][m][0] + bv[bj][0], v1 = acc[ai][bj][m][1] + bv[bj][1];
                    if (colt < 512) {
                        u32x4 w; w.x = pk2_(v0.x, v0.y); w.y = pk2_(v0.z, v0.w); w.z = pk2_(v1.x, v1.y); w.w = pk2_(v1.z, v1.w);
                        *(u32x4*)(U + row * 512 + c8) = w;
                    } else if (colt < 1536) {
                        if (bj == 0) {
                            const f32x4 g0 = acc[ai][1][m][0] + bv[1][0], g1 = acc[ai][1][m][1] + bv[1][1];
                            u32x4 w; w.x = pk2_(v0.x * sg_(g0.x), v0.y * sg_(g0.y)); w.y = pk2_(v0.z * sg_(g0.z), v0.w * sg_(g0.w));
                            w.z = pk2_(v1.x * sg_(g1.x), v1.y * sg_(g1.y)); w.w = pk2_(v1.z * sg_(g1.z), v1.w * sg_(g1.w));
                            *(u32x4*)(V + row * 512 + ((colt - 512) >> 1) + wc * 32 + 8 * fq) = w;
                        }
                    } else {
                        u32x4 w; w.x = pk2_(sg_(v0.x), sg_(v0.y)); w.y = pk2_(sg_(v0.z), sg_(v0.w)); w.z = pk2_(sg_(v1.x), sg_(v1.y)); w.w = pk2_(sg_(v1.z), sg_(v1.w));
                        if (colt < 2560) *(u32x4*)(SGS + row * 1024 + (c8 - 1536)) = w; else *(u32x4*)(SGC + row * 1024 + (c8 - 2560)) = w;
                    }
                }
            }
    }
};
struct EpiCout {
    static constexpr bool PERM = true, AFTER_DRAIN = false;
    const float* bias; const bf16_t* SGC; bf16_t* M1;
    __device__ __forceinline__ void operator()(const f32x4 (&acc)[2][2][4][2], const Unit& u, int wr, int wc, int fr, int fq) const {
        const int row0 = u.pm * BM + wr * 64 + fr, c0 = u.pn * BM + wc * 32 + 8 * fq;
        f32x4 bv[2][2];
#pragma unroll
        for (int bj = 0; bj < 2; ++bj)
#pragma unroll
            for (int n = 0; n < 2; ++n) bv[bj][n] = *(const f32x4*)(bias + c0 + bj * HALF + 4 * n);
#pragma unroll
        for (int ai = 0; ai < 2; ++ai) {
            u32x4 gv[4][2];
#pragma unroll
            for (int m = 0; m < 4; ++m)
#pragma unroll
                for (int bj = 0; bj < 2; ++bj) gv[m][bj] = *(const u32x4*)(SGC + (size_t)(row0 + ai * HALF + m * 16) * 1024 + c0 + bj * HALF);
            asm volatile("" ::: "memory");
#pragma unroll
            for (int m = 0; m < 4; ++m) {
                const size_t row = (size_t)(row0 + ai * HALF + m * 16);
#pragma unroll
                for (int bj = 0; bj < 2; ++bj) {
                    const int c8 = c0 + bj * HALF;
                    const f32x4 v0 = acc[ai][bj][m][0] + bv[bj][0], v1 = acc[ai][bj][m][1] + bv[bj][1];
                    const u32x4 g = gv[m][bj];
                    u32x4 w; w.x = pk2_(v0.x * lo_(g.x), v0.y * hi_(g.x)); w.y = pk2_(v0.z * lo_(g.y), v0.w * hi_(g.y));
                    w.z = pk2_(v1.x * lo_(g.z), v1.y * hi_(g.z)); w.w = pk2_(v1.z * lo_(g.w), v1.w * hi_(g.w));
                    *(u32x4*)(M1 + row * 1024 + c8) = w;
                }
            }
            asm volatile("" ::: "memory");
        }
    }
};
struct EpiGlu {
    static constexpr bool PERM = true, AFTER_DRAIN = false;
    const float* bglup; const bf16_t* SGS; const bf16_t* M1; bf16_t* MERGED;
    __device__ __forceinline__ void operator()(const f32x4 (&acc)[2][2][4][2], const Unit& u, int wr, int wc, int fr, int fq) const {
        const int row0 = u.pm * BM + wr * 64 + fr, c0 = u.pn * BM + wc * 32 + 8 * fq, mc = u.pn * HALF + wc * 32 + 8 * fq;
        f32x4 bv[2][2];
#pragma unroll
        for (int bj = 0; bj < 2; ++bj)
#pragma unroll
            for (int n = 0; n < 2; ++n) bv[bj][n] = *(const f32x4*)(bglup + c0 + bj * HALF + 4 * n);
#pragma unroll
        for (int ai = 0; ai < 2; ++ai) {
            u32x4 gv[4], qv[4];
#pragma unroll
            for (int m = 0; m < 4; ++m) {
                const size_t off = (size_t)(row0 + ai * HALF + m * 16) * 1024 + mc;
                gv[m] = *(const u32x4*)(SGS + off); qv[m] = *(const u32x4*)(M1 + off);
            }
            asm volatile("" ::: "memory");
#pragma unroll
            for (int m = 0; m < 4; ++m) {
                const size_t off = (size_t)(row0 + ai * HALF + m * 16) * 1024 + mc;
                const f32x4 a0 = acc[ai][0][m][0] + bv[0][0], a1 = acc[ai][0][m][1] + bv[0][1];
                const f32x4 b0 = acc[ai][1][m][0] + bv[1][0], b1 = acc[ai][1][m][1] + bv[1][1];
                const u32x4 g = gv[m], q = qv[m];
                u32x4 w;
                w.x = pk2_(lo_(q.x) + lo_(g.x) * (a0.x * sg_(b0.x)), hi_(q.x) + hi_(g.x) * (a0.y * sg_(b0.y)));
                w.y = pk2_(lo_(q.y) + lo_(g.y) * (a0.z * sg_(b0.z)), hi_(q.y) + hi_(g.y) * (a0.w * sg_(b0.w)));
                w.z = pk2_(lo_(q.z) + lo_(g.z) * (a1.x * sg_(b1.x)), hi_(q.z) + hi_(g.z) * (a1.y * sg_(b1.y)));
                w.w = pk2_(lo_(q.w) + lo_(g.w) * (a1.z * sg_(b1.z)), hi_(q.w) + hi_(g.w) * (a1.w * sg_(b1.w)));
                *(u32x4*)(MERGED + off) = w;
            }
            asm volatile("" ::: "memory");
        }
    }
};
struct TripleOrder {
    StaticOrder so;
    __device__ __forceinline__ bool next(int i, Unit& u) const {
        const int tr = i / 3, sub = i - tr * 3; Unit v;
        if (!so.next(tr, v)) return false;
        if (sub == 0) { u.pm = 128 + v.pm; u.pn = 8 + v.pn; } else { u.pm = v.pm; u.pn = 2 * v.pn + sub - 1; }
        return true;
    }
    __device__ __forceinline__ void a_ready(const Unit&) const {}
    __device__ __forceinline__ void done(const Unit&) const {}
};
struct EpiCG {
    static constexpr bool PERM = true, AFTER_DRAIN = false;
    EpiCout c; EpiGlu g;
    __device__ __forceinline__ void operator()(const f32x4 (&acc)[2][2][4][2], const Unit& u, int wr, int wc, int fr, int fq) const {
        if (u.pm >= 128) { const Unit v{u.pm - 128, u.pn - 8}; c(acc, v, wr, wc, fr, fq); }
        else g(acc, u, wr, wc, fr, fq);
    }
};
struct EpiOut {
    static constexpr bool PERM = true, AFTER_DRAIN = false;
    const float* bias; const bf16_t* XB; bf16_t* PREB; float alpha;
    __device__ __forceinline__ void operator()(const f32x4 (&acc)[2][2][4][2], const Unit& u, int wr, int wc, int fr, int fq) const {
        const int row0 = u.pm * BM + wr * 64 + fr, c0 = u.pn * BM + wc * 32 + 8 * fq;
        u32x4 xv[2][4][2];
#pragma unroll
        for (int ai = 0; ai < 2; ++ai)
#pragma unroll
            for (int m = 0; m < 4; ++m)
#pragma unroll
                for (int bj = 0; bj < 2; ++bj) xv[ai][m][bj] = *(const u32x4*)(XB + (size_t)(row0 + ai * HALF + m * 16) * 1024 + c0 + bj * HALF);
        asm volatile("" ::: "memory");
#pragma unroll
        for (int bj = 0; bj < 2; ++bj) {
            const int c8 = c0 + bj * HALF;
            const f32x4 bv0 = *(const f32x4*)(bias + c8), bv1 = *(const f32x4*)(bias + c8 + 4);
#pragma unroll
            for (int ai = 0; ai < 2; ++ai)
#pragma unroll
                for (int m = 0; m < 4; ++m) {
                    int ro_ = row0 + ai * HALF + m * 16; asm volatile("" : "+v"(ro_));
                    const u32x4 x = xv[ai][m][bj];
                    const f32x4 x0 = {lo_(x.x), hi_(x.x), lo_(x.y), hi_(x.y)}, x1 = {lo_(x.z), hi_(x.z), lo_(x.w), hi_(x.w)};
                    const f32x4 v0 = acc[ai][bj][m][0] + bv0 + x0 * alpha, v1 = acc[ai][bj][m][1] + bv1 + x1 * alpha;
                    u32x4 w; w.x = pk2_(v0.x, v0.y); w.y = pk2_(v0.z, v0.w); w.z = pk2_(v1.x, v1.y); w.w = pk2_(v1.z, v1.w);
                    *(u32x4*)(PREB + (size_t)ro_ * 1024 + c8) = w;
                }
            asm volatile("" ::: "memory");
        }
    }
};

struct MoeOrder {
    const PG8_LAS int* tab; int G, c, sh;
    __device__ __forceinline__ bool next(int i, Unit& u) const {
        const int L = i * G + c;
        if (L >= __builtin_amdgcn_readfirstlane(tab[32])) return false;
        int e = 0;
#pragma unroll 1
        while (L >= __builtin_amdgcn_readfirstlane(tab[e + 1])) ++e;
        const int ll = L - __builtin_amdgcn_readfirstlane(tab[e]);
        u.pm = __builtin_amdgcn_readfirstlane(tab[64 + e]) + (ll >> sh); u.pn = (e << sh) + (ll & ((1 << sh) - 1)); return true;
    }
    __device__ __forceinline__ void a_ready(const Unit&) const {}
    __device__ __forceinline__ void done(const Unit&) const {}
};
struct EpiDownP {
    static constexpr bool PERM = true, AFTER_DRAIN = false;
    const PG8_LAS int* tab; const int* TOK; const float* GATE; bf16_t* YM; bf16_t* dump; int Ttok;
    __device__ __forceinline__ void operator()(const f32x4 (&acc)[2][2][4][2], const Unit& u, int wr, int wc, int fr, int fq) const {
        const int e = u.pn >> 2, j = u.pn & 3;
        const int cnt = __builtin_amdgcn_readfirstlane(tab[128 + e]), idx0 = (u.pm - __builtin_amdgcn_readfirstlane(tab[64 + e])) * BM + wr * 64 + fr;
        const int* tl = TOK + (size_t)e * Ttok;
        const int c0 = j * BM + wc * 32 + 8 * fq;
        int entv[2][4]; float gtv[2][4];
#pragma unroll
        for (int ai = 0; ai < 2; ++ai)
#pragma unroll
            for (int m = 0; m < 4; ++m) { const int idx = idx0 + ai * HALF + m * 16; entv[ai][m] = tl[idx < cnt ? idx : 0]; }
#pragma unroll
        for (int ai = 0; ai < 2; ++ai)
#pragma unroll
            for (int m = 0; m < 4; ++m) gtv[ai][m] = GATE[entv[ai][m]];
        asm volatile("" ::: "memory");
#pragma unroll
        for (int ai = 0; ai < 2; ++ai)
#pragma unroll
            for (int m = 0; m < 4; ++m) {
                const int idx = idx0 + ai * HALF + m * 16;
                const bool ok = idx < cnt;
                const int ent = entv[ai][m];
                const float g = gtv[ai][m];
                bf16_t* const dst = (ok ? YM + (size_t)ent * 1024 : dump) + c0;
#pragma unroll
                for (int bj = 0; bj < 2; ++bj) {
                    const f32x4 v0 = acc[ai][bj][m][0] * g, v1 = acc[ai][bj][m][1] * g;
                    u32x4 w; w.x = pk2_(v0.x, v0.y); w.y = pk2_(v0.z, v0.w); w.z = pk2_(v1.x, v1.y); w.w = pk2_(v1.z, v1.w);
                    *(u32x4*)(dst + bj * HALF) = w;
                }
                asm volatile("" ::: "memory");
            }
    }
};

struct MoeRows {
    const PG8_LAS int* tab; const int* TOK; int Ttok; unsigned rowbytes;
    __device__ __forceinline__ unsigned rowoff(const Unit& u, int h, int R) const {
        const int e = u.pn >> 1;
        const int idx = (u.pm - __builtin_amdgcn_readfirstlane(tab[64 + e])) * BM + h * HALF + R;
        const int raw = TOK[(size_t)e * Ttok + idx];
        const int tok = idx < __builtin_amdgcn_readfirstlane(tab[128 + e]) ? (raw >> 1) : 0;
        return (unsigned)tok * rowbytes;
    }
};
struct EpiGUP {
    static constexpr bool PERM = true, AFTER_DRAIN = false;
    bf16_t* HID;
    __device__ __forceinline__ void operator()(const f32x4 (&acc)[2][2][4][2], const Unit& u, int wr, int wc, int fr, int fq) const {
        const int row0 = u.pm * BM + wr * 64 + fr, hc = (u.pn & 1) * HALF + wc * 32 + 8 * fq;
#pragma unroll
        for (int ai = 0; ai < 2; ++ai)
#pragma unroll
            for (int m = 0; m < 4; ++m) {
                const size_t row = (size_t)(row0 + ai * HALF + m * 16);
                const f32x4 g0 = acc[ai][0][m][0], g1 = acc[ai][0][m][1], u0 = acc[ai][1][m][0], u1 = acc[ai][1][m][1];
                u32x4 w; w.x = pk2_(g0.x * sg_(g0.x) * u0.x, g0.y * sg_(g0.y) * u0.y); w.y = pk2_(g0.z * sg_(g0.z) * u0.z, g0.w * sg_(g0.w) * u0.w);
                w.z = pk2_(g1.x * sg_(g1.x) * u1.x, g1.y * sg_(g1.y) * u1.y); w.w = pk2_(g1.z * sg_(g1.z) * u1.z, g1.w * sg_(g1.w) * u1.w);
                *(u32x4*)(HID + row * 256 + hc) = w;
            }
    }
};

template <class Epi, class Sched, bool ALIGN_EPI = false, bool SP2 = false>
__device__ __forceinline__ void gemm_phase(PG8_LAS unsigned char* lds, const Gemm g, const Sched& S, const Epi& E) {
    int tid_ = threadIdx.x; asm volatile("" : "+v"(tid_));
    const int tid = tid_, wid = __builtin_amdgcn_readfirstlane(tid >> 6), lane = tid & 63, wr = wid >> 2, wc = wid & 3, fr = lane & 15, fq = lane >> 4;
    const int K = g.K, nt = K / BK;
    unsigned voffA[2], voffB[2];
#pragma unroll
    for (int i = 0; i < 2; ++i) { int R, C; stage_rc(tid * 16 + i * 8192, R, C); const int Rb = Epi::PERM ? ((R & ~31) + perm32(R & 31)) : R;
        voffA[i] = (unsigned)(R * K + C) * 2u; voffB[i] = (unsigned)(Rb * K + C) * 2u; }
    const size_t kstep = (size_t)(BK * 2);
    const size_t hstep = (size_t)HALF * K * 2;
    const size_t tstep = 2 * hstep;
    const unsigned ldsw = (unsigned)wid * 1024u;
    const int aoff = lds_byte(wr * 64 + fr, fq * 8), boff = lds_byte(wc * 32 + fr, fq * 8);
#define PG8_SA(b, h) (((b) * 2 + (h)) * HTB)
#define PG8_SB(b, h) ((4 + (b) * 2 + (h)) * HTB)
#define PG8_STAGE(bufoff, gbase, voff) do { _Pragma("unroll") for (int _i = 0; _i < 2; ++_i) \
        __builtin_amdgcn_global_load_lds((const unsigned*)((const char*)(gbase) + (voff)[_i]), (PG8_LAS unsigned*)(lds + (bufoff) + ldsw + _i * 8192), 16, 0, 0); } while (0)
#define PG8_LDA(dst, b, h) do { _Pragma("unroll") for (int m = 0; m < 4; ++m) _Pragma("unroll") for (int k = 0; k < 2; ++k) dst[m][k] = *(const PG8_LAS bf16x8*)(lds + PG8_SA(b, h) + aoff + m * 2048 + k * 1024); } while (0)
#define PG8_LDB(dst, b, h) do { _Pragma("unroll") for (int n = 0; n < 2; ++n) _Pragma("unroll") for (int k = 0; k < 2; ++k) dst[n][k] = *(const PG8_LAS bf16x8*)(lds + PG8_SB(b, h) + boff + n * 2048 + k * 1024); } while (0)
#define PG8_MMA(ai, bj, At, Bt) do { __builtin_amdgcn_s_setprio(1); _Pragma("unroll") for (int m = 0; m < 4; ++m) _Pragma("unroll") for (int n = 0; n < 2; ++n) _Pragma("unroll") for (int k = 0; k < 2; ++k) \
        acc[ai][bj][m][n] = mfma16_h(Bt[n][k], At[m][k], acc[ai][bj][m][n], 0, 0, 0); __builtin_amdgcn_s_setprio(0); } while (0)
#define PG8_WAIT_V(n) asm volatile("s_waitcnt vmcnt(" #n ")" ::: "memory")
#define PG8_WAIT_L(n) asm volatile("s_waitcnt lgkmcnt(" #n ")" ::: "memory")
#define PG8_BAR __builtin_amdgcn_s_barrier()
#define PG8_SCHED __builtin_amdgcn_sched_barrier(0)
    Unit cur, nxt; int ui = 0;
    if (!S.next(0, cur)) return;
    f32x4 acc[2][2][4][2];
#pragma unroll
    for (int a = 0; a < 2; ++a)
#pragma unroll
        for (int b = 0; b < 2; ++b)
#pragma unroll
            for (int m = 0; m < 4; ++m)
#pragma unroll
                for (int n = 0; n < 2; ++n) acc[a][b][m][n] = (f32x4){0.f, 0.f, 0.f, 0.f};
    bf16x8 At[4][2], B0[2][2], B1[2][2];
    const char* cA = (const char*)g.A + (size_t)cur.pm * tstep; const char* cB = (const char*)g.Bt + (size_t)cur.pn * tstep;
    S.a_ready(cur);
    if constexpr (SP2) {
        PG8_STAGE(PG8_SB(0, 0), cB, voffB); PG8_STAGE(PG8_SB(0, 1), cB + hstep, voffB); PG8_STAGE(PG8_SA(0, 0), cA, voffA); PG8_STAGE(PG8_SA(0, 1), cA + hstep, voffA);
        if (wr == 1) PG8_BAR;
        PG8_WAIT_V(2); PG8_BAR;
        PG8_STAGE(PG8_SB(1, 0), cB + kstep, voffB); PG8_STAGE(PG8_SA(1, 0), cA + kstep, voffA); PG8_STAGE(PG8_SB(1, 1), cB + hstep + kstep, voffB);
        PG8_WAIT_V(6); PG8_BAR;
    } else {
        PG8_STAGE(PG8_SB(0, 0), cB, voffB); PG8_STAGE(PG8_SA(0, 0), cA, voffA); PG8_STAGE(PG8_SB(0, 1), cB + hstep, voffB); PG8_STAGE(PG8_SA(0, 1), cA + hstep, voffA);
        if (wr == 1) PG8_BAR;
        PG8_WAIT_V(4); PG8_BAR;
        PG8_STAGE(PG8_SB(1, 0), cB + kstep, voffB); PG8_STAGE(PG8_SA(1, 0), cA + kstep, voffA); PG8_STAGE(PG8_SB(1, 1), cB + hstep + kstep, voffB);
        PG8_WAIT_V(6); PG8_BAR;
    }
    for (;;) {
        const bool has_next = S.next(ui + 1, nxt);
        const char* nA = has_next ? (const char*)g.A + (size_t)nxt.pm * tstep : cA; const char* nB = has_next ? (const char*)g.Bt + (size_t)nxt.pn * tstep : cB;
        for (int t = 0; t < nt; t += 2) {
            const bool last = (t == nt - 2);
            const char* a1 = cA + (size_t)(t + 1) * kstep;
            const char* a2 = last ? nA : cA + (size_t)(t + 2) * kstep; const char* b2 = last ? nB : cB + (size_t)(t + 2) * kstep;
            const char* a3 = a2 + kstep; const char* b3 = b2 + kstep;
            if (last && has_next) S.a_ready(nxt);
            if constexpr (SP2) {
            PG8_LDB(B0, 0, 0); PG8_LDB(B1, 0, 1); PG8_SCHED; PG8_LDA(At, 0, 0); PG8_STAGE(PG8_SA(1, 1), a1 + hstep, voffA);
            PG8_WAIT_V(8); PG8_WAIT_L(0); PG8_BAR; PG8_MMA(0, 0, At, B0); PG8_MMA(0, 1, At, B1); PG8_BAR; PG8_SCHED;
            PG8_LDA(At, 0, 1); PG8_STAGE(PG8_SB(0, 0), b2, voffB); PG8_STAGE(PG8_SB(0, 1), b2 + hstep, voffB); PG8_STAGE(PG8_SA(0, 0), a2, voffA);
            PG8_WAIT_V(8); PG8_WAIT_L(0); PG8_BAR; PG8_MMA(1, 0, At, B0); PG8_MMA(1, 1, At, B1); PG8_BAR; PG8_SCHED;
            PG8_LDB(B0, 1, 0); PG8_LDB(B1, 1, 1); PG8_SCHED; PG8_LDA(At, 1, 0); PG8_STAGE(PG8_SA(0, 1), a2 + hstep, voffA);
            PG8_WAIT_V(8); PG8_WAIT_L(0); PG8_BAR; PG8_MMA(0, 0, At, B0); PG8_MMA(0, 1, At, B1); PG8_BAR; PG8_SCHED;
            PG8_LDA(At, 1, 1); PG8_STAGE(PG8_SB(1, 0), b3, voffB); PG8_STAGE(PG8_SB(1, 1), b3 + hstep, voffB); PG8_STAGE(PG8_SA(1, 0), a3, voffA);
            PG8_WAIT_V(8); PG8_WAIT_L(0); PG8_BAR; PG8_MMA(1, 0, At, B0); PG8_MMA(1, 1, At, B1); PG8_BAR; PG8_SCHED;
            } else {
            PG8_LDB(B0, 0, 0); PG8_SCHED; PG8_LDA(At, 0, 0); PG8_STAGE(PG8_SA(1, 1), a1 + hstep, voffA);
            PG8_WAIT_L(8); PG8_BAR; PG8_WAIT_L(0); PG8_MMA(0, 0, At, B0); PG8_BAR; PG8_SCHED;
            PG8_LDB(B1, 0, 1); PG8_STAGE(PG8_SB(0, 0), b2, voffB);
            PG8_BAR; PG8_WAIT_L(0); PG8_MMA(0, 1, At, B1); PG8_BAR;
            PG8_LDA(At, 0, 1); PG8_STAGE(PG8_SA(0, 0), a2, voffA);
            PG8_BAR; PG8_WAIT_L(0); PG8_MMA(1, 0, At, B0); PG8_BAR; PG8_SCHED;
            PG8_STAGE(PG8_SB(0, 1), b2 + hstep, voffB);
            PG8_WAIT_V(6); PG8_BAR; PG8_MMA(1, 1, At, B1); PG8_BAR;
            PG8_LDB(B0, 1, 0); PG8_SCHED; PG8_LDA(At, 1, 0); PG8_STAGE(PG8_SA(0, 1), a2 + hstep, voffA);
            PG8_WAIT_L(8); PG8_BAR; PG8_WAIT_L(0); PG8_MMA(0, 0, At, B0); PG8_BAR; PG8_SCHED;
            PG8_LDB(B1, 1, 1); PG8_STAGE(PG8_SB(1, 0), b3, voffB);
            PG8_BAR; PG8_WAIT_L(0); PG8_MMA(0, 1, At, B1); PG8_BAR;
            PG8_LDA(At, 1, 1); PG8_STAGE(PG8_SA(1, 0), a3, voffA);
            PG8_BAR; PG8_WAIT_L(0); PG8_MMA(1, 0, At, B0); PG8_BAR; PG8_SCHED;
            PG8_STAGE(PG8_SB(1, 1), b3 + hstep, voffB);
            PG8_WAIT_V(6); PG8_BAR; PG8_MMA(1, 1, At, B1); PG8_BAR;
            }
        }
        if constexpr (ALIGN_EPI) { if (wr == 0) PG8_BAR; }
        if constexpr (!Epi::AFTER_DRAIN) { E(acc, cur, wr, wc, fr, fq); S.done(cur); }
        if (!has_next) break;
#pragma unroll
        for (int a = 0; a < 2; ++a)
#pragma unroll
            for (int b = 0; b < 2; ++b)
#pragma unroll
                for (int m = 0; m < 4; ++m)
#pragma unroll
                    for (int n = 0; n < 2; ++n) acc[a][b][m][n] = (f32x4){0.f, 0.f, 0.f, 0.f};
        cur = nxt; cA = nA; cB = nB; ++ui;
        if constexpr (ALIGN_EPI) { if (wr == 1) PG8_BAR; }
    }
    PG8_WAIT_V(0);
    if constexpr (!ALIGN_EPI) { if (wr == 0) PG8_BAR; }
    PG8_BAR;
    if constexpr (Epi::AFTER_DRAIN) { E.fused(acc, cur, wr, wc, fr, fq, lds, wid, lane); S.done(cur); }
#undef PG8_SA
#undef PG8_SB
#undef PG8_STAGE
#undef PG8_LDA
#undef PG8_LDB
#undef PG8_MMA
#undef PG8_WAIT_V
#undef PG8_WAIT_L
#undef PG8_BAR
#undef PG8_SCHED
}
template <class Epi, class Sched, class Rows>
__device__ __forceinline__ void gemm_phase_gather(PG8_LAS unsigned char* lds, const Gemm g, const Sched& S, const Epi& E, const Rows& rows) {
    constexpr bool ALIGN_EPI = true, SP2 = true;
    int tid_ = threadIdx.x; asm volatile("" : "+v"(tid_));
    const int tid = tid_, wid = __builtin_amdgcn_readfirstlane(tid >> 6), lane = tid & 63, wr = wid >> 2, wc = wid & 3, fr = lane & 15, fq = lane >> 4;
    const int K = g.K, nt = K / BK;
    unsigned voffB[2], cofs[2]; int RA[2];
#pragma unroll
    for (int i = 0; i < 2; ++i) { int R, C; stage_rc(tid * 16 + i * 8192, R, C); const int Rb = Epi::PERM ? ((R & ~31) + perm32(R & 31)) : R;
        RA[i] = R; cofs[i] = (unsigned)C * 2u; voffB[i] = (unsigned)(Rb * K + C) * 2u; }
    unsigned vC[2][2], vN[2][2];
#define PG8_LOADOFFS(v, un) do { _Pragma("unroll") for (int _h = 0; _h < 2; ++_h) _Pragma("unroll") for (int _i = 0; _i < 2; ++_i) (v)[_h][_i] = rows.rowoff((un), _h, RA[_i]) + cofs[_i]; } while (0)
    const size_t kstep = (size_t)(BK * 2);
    const size_t hstep = (size_t)HALF * K * 2;
    const size_t tstep = 2 * hstep;
    const unsigned ldsw = (unsigned)wid * 1024u;
    const int aoff = lds_byte(wr * 64 + fr, fq * 8), boff = lds_byte(wc * 32 + fr, fq * 8);
#define PG8_SA(b, h) (((b) * 2 + (h)) * HTB)
#define PG8_SB(b, h) ((4 + (b) * 2 + (h)) * HTB)
#define PG8_STAGE(bufoff, gbase, voff) do { _Pragma("unroll") for (int _i = 0; _i < 2; ++_i) \
        __builtin_amdgcn_global_load_lds((const unsigned*)((const char*)(gbase) + (voff)[_i]), (PG8_LAS unsigned*)(lds + (bufoff) + ldsw + _i * 8192), 16, 0, 0); } while (0)
#define PG8_LDA(dst, b, h) do { _Pragma("unroll") for (int m = 0; m < 4; ++m) _Pragma("unroll") for (int k = 0; k < 2; ++k) dst[m][k] = *(const PG8_LAS bf16x8*)(lds + PG8_SA(b, h) + aoff + m * 2048 + k * 1024); } while (0)
#define PG8_LDB(dst, b, h) do { _Pragma("unroll") for (int n = 0; n < 2; ++n) _Pragma("unroll") for (int k = 0; k < 2; ++k) dst[n][k] = *(const PG8_LAS bf16x8*)(lds + PG8_SB(b, h) + boff + n * 2048 + k * 1024); } while (0)
#define PG8_MMA(ai, bj, At, Bt) do { __builtin_amdgcn_s_setprio(1); _Pragma("unroll") for (int m = 0; m < 4; ++m) _Pragma("unroll") for (int n = 0; n < 2; ++n) _Pragma("unroll") for (int k = 0; k < 2; ++k) \
        acc[ai][bj][m][n] = mfma16_h(Bt[n][k], At[m][k], acc[ai][bj][m][n], 0, 0, 0); __builtin_amdgcn_s_setprio(0); } while (0)
#define PG8_WAIT_V(n) asm volatile("s_waitcnt vmcnt(" #n ")" ::: "memory")
#define PG8_WAIT_L(n) asm volatile("s_waitcnt lgkmcnt(" #n ")" ::: "memory")
#define PG8_BAR __builtin_amdgcn_s_barrier()
#define PG8_SCHED __builtin_amdgcn_sched_barrier(0)
    Unit cur, nxt; int ui = 0;
    if (!S.next(0, cur)) return;
    f32x4 acc[2][2][4][2];
#pragma unroll
    for (int a = 0; a < 2; ++a)
#pragma unroll
        for (int b = 0; b < 2; ++b)
#pragma unroll
            for (int m = 0; m < 4; ++m)
#pragma unroll
                for (int n = 0; n < 2; ++n) acc[a][b][m][n] = (f32x4){0.f, 0.f, 0.f, 0.f};
    bf16x8 At[4][2], B0[2][2], B1[2][2];
    const char* const Ab = (const char*)g.A; const char* cB = (const char*)g.Bt + (size_t)cur.pn * tstep;
    PG8_LOADOFFS(vC, cur);
    S.a_ready(cur);
    if constexpr (SP2) {
        PG8_STAGE(PG8_SB(0, 0), cB, voffB); PG8_STAGE(PG8_SB(0, 1), cB + hstep, voffB); PG8_STAGE(PG8_SA(0, 0), Ab, vC[0]); PG8_STAGE(PG8_SA(0, 1), Ab, vC[1]);
        if (wr == 1) PG8_BAR;
        PG8_WAIT_V(2); PG8_BAR;
        PG8_STAGE(PG8_SB(1, 0), cB + kstep, voffB); PG8_STAGE(PG8_SA(1, 0), Ab + kstep, vC[0]); PG8_STAGE(PG8_SB(1, 1), cB + hstep + kstep, voffB);
        PG8_WAIT_V(6); PG8_BAR;
    }
    for (;;) {
        const bool has_next = S.next(ui + 1, nxt);
        const char* nB = has_next ? (const char*)g.Bt + (size_t)nxt.pn * tstep : cB;
        if (has_next) { PG8_LOADOFFS(vN, nxt); } else { vN[0][0] = vC[0][0]; vN[0][1] = vC[0][1]; vN[1][0] = vC[1][0]; vN[1][1] = vC[1][1]; }
        for (int t = 0; t < nt; t += 2) {
            const bool last = (t == nt - 2);
            const char* a1 = Ab + (size_t)(t + 1) * kstep;
            const char* a2 = last ? Ab : Ab + (size_t)(t + 2) * kstep; const char* b2 = last ? nB : cB + (size_t)(t + 2) * kstep;
            const char* a3 = a2 + kstep; const char* b3 = b2 + kstep;
            unsigned s2h0[2], s2h1[2]; s2h0[0] = last ? vN[0][0] : vC[0][0]; s2h0[1] = last ? vN[0][1] : vC[0][1]; s2h1[0] = last ? vN[1][0] : vC[1][0]; s2h1[1] = last ? vN[1][1] : vC[1][1];
            if (last && has_next) S.a_ready(nxt);
            if constexpr (SP2) {
            PG8_LDB(B0, 0, 0); PG8_LDB(B1, 0, 1); PG8_SCHED; PG8_LDA(At, 0, 0); PG8_STAGE(PG8_SA(1, 1), a1, vC[1]);
            PG8_WAIT_V(8); PG8_WAIT_L(0); PG8_BAR; PG8_MMA(0, 0, At, B0); PG8_MMA(0, 1, At, B1); PG8_BAR; PG8_SCHED;
            PG8_LDA(At, 0, 1); PG8_STAGE(PG8_SB(0, 0), b2, voffB); PG8_STAGE(PG8_SB(0, 1), b2 + hstep, voffB); PG8_STAGE(PG8_SA(0, 0), a2, s2h0);
            PG8_WAIT_V(8); PG8_WAIT_L(0); PG8_BAR; PG8_MMA(1, 0, At, B0); PG8_MMA(1, 1, At, B1); PG8_BAR; PG8_SCHED;
            PG8_LDB(B0, 1, 0); PG8_LDB(B1, 1, 1); PG8_SCHED; PG8_LDA(At, 1, 0); PG8_STAGE(PG8_SA(0, 1), a2, s2h1);
            PG8_WAIT_V(8); PG8_WAIT_L(0); PG8_BAR; PG8_MMA(0, 0, At, B0); PG8_MMA(0, 1, At, B1); PG8_BAR; PG8_SCHED;
            PG8_LDA(At, 1, 1); PG8_STAGE(PG8_SB(1, 0), b3, voffB); PG8_STAGE(PG8_SB(1, 1), b3 + hstep, voffB); PG8_STAGE(PG8_SA(1, 0), a3, s2h0);
            PG8_WAIT_V(8); PG8_WAIT_L(0); PG8_BAR; PG8_MMA(1, 0, At, B0); PG8_MMA(1, 1, At, B1); PG8_BAR; PG8_SCHED;
            }
        }
        if constexpr (ALIGN_EPI) { if (wr == 0) PG8_BAR; }
        if constexpr (!Epi::AFTER_DRAIN) { E(acc, cur, wr, wc, fr, fq); S.done(cur); }
        if (!has_next) break;
#pragma unroll
        for (int a = 0; a < 2; ++a)
#pragma unroll
            for (int b = 0; b < 2; ++b)
#pragma unroll
                for (int m = 0; m < 4; ++m)
#pragma unroll
                    for (int n = 0; n < 2; ++n) acc[a][b][m][n] = (f32x4){0.f, 0.f, 0.f, 0.f};
        cur = nxt; cB = nB; ++ui; vC[0][0] = vN[0][0]; vC[0][1] = vN[0][1]; vC[1][0] = vN[1][0]; vC[1][1] = vN[1][1];
        if constexpr (ALIGN_EPI) { if (wr == 1) PG8_BAR; }
    }
    PG8_WAIT_V(0);
    if constexpr (!ALIGN_EPI) { if (wr == 0) PG8_BAR; }
    PG8_BAR;
    if constexpr (Epi::AFTER_DRAIN) { E.fused(acc, cur, wr, wc, fr, fq, lds, wid, lane); S.done(cur); }
#undef PG8_LOADOFFS
#undef PG8_SA
#undef PG8_SB
#undef PG8_STAGE
#undef PG8_LDA
#undef PG8_LDB
#undef PG8_MMA
#undef PG8_WAIT_V
#undef PG8_WAIT_L
#undef PG8_BAR
#undef PG8_SCHED
}
}

template <int NI, class RowPtr, class Epi>
__device__ __forceinline__ void gemm_tile(unsigned char* lds, const RowPtr& rowptr, const bf16* Bt, const int K, const Epi& epi) {
    const int tid = threadIdx.x, lane = tid & 63, wave = tid >> 6, wm = wave >> 2, wn = wave & 3, fr = lane & 15, fq = lane >> 4;
    const int sr = tid >> 3, cp = tid & 7;
    const int sw = (cp ^ (sr & 7)) << 3;
    const bf16* ap0 = rowptr(sr) + sw;
    const bf16* ap1 = rowptr(sr + 64) + sw;
    const bf16* bp = Bt + (size_t)sr * K + sw;
    const size_t bstep = (size_t)64 * K;
    f32x4 acc[4][NI];
#pragma unroll
    for (int i = 0; i < 4; ++i)
#pragma unroll
        for (int j = 0; j < NI; ++j) acc[i][j] = (f32x4){0.f, 0.f, 0.f, 0.f};
    const int nt = K >> 6;
    {
        unsigned char* Ab = lds; unsigned char* Bb = lds + 16384;
        glds16(ap0, Ab + tid * 16); glds16(ap1, Ab + 8192 + tid * 16);
#pragma unroll
        for (int i = 0; i < NI; ++i) glds16(bp + i * bstep, Bb + i * 8192 + tid * 16);
    }
    const int aoff = (wm * 64 + fr) * 128, boff = (wn * 16 * NI + fr) * 128;
    for (int kt = 0; kt < nt; ++kt) {
        asm volatile("s_waitcnt vmcnt(0)" ::: "memory");
        __syncthreads();
        if (kt + 1 < nt) {
            unsigned char* Ab = lds + ((kt + 1) & 1) * 49152; unsigned char* Bb = Ab + 16384;
            const int ko = (kt + 1) * 64;
            glds16(ap0 + ko, Ab + tid * 16); glds16(ap1 + ko, Ab + 8192 + tid * 16);
#pragma unroll
            for (int i = 0; i < NI; ++i) glds16(bp + i * bstep + ko, Bb + i * 8192 + tid * 16);
        }
        const unsigned char* Ab = lds + (kt & 1) * 49152; const unsigned char* Bb = Ab + 16384;
#pragma unroll
        for (int ks = 0; ks < 2; ++ks) {
            const int so = ((ks * 4 + fq) ^ (fr & 7)) << 4;
            bf16x8 af[4], bfr[NI];
#pragma unroll
            for (int i = 0; i < 4; ++i) af[i] = *(const bf16x8*)(Ab + aoff + i * 2048 + so);
#pragma unroll
            for (int i = 0; i < NI; ++i) bfr[i] = *(const bf16x8*)(Bb + boff + i * 2048 + so);
#pragma unroll
            for (int mi = 0; mi < 4; ++mi)
#pragma unroll
                for (int ni = 0; ni < NI; ++ni) acc[mi][ni] = mfma16_h(bfr[ni], af[mi], acc[mi][ni], 0, 0, 0);
        }
    }
    __syncthreads();
    epi(acc, wm * 64 + fr, wn * 16 * NI + 4 * fq);
}

template <class F>
__device__ __forceinline__ void transpose_item(const float* W, int K, int N, bf16* WT, float* scr, int item, int lane, const F& rowmap) {
    const int nblk = N / 32, kb = item / nblk, nb = item % nblk, k0 = 64 * kb, n0 = 32 * nb;
#pragma unroll 8
    for (int i = 0; i < 32; ++i) { const int kk = 2 * i + (lane >> 5); scr[kk * 33 + (lane & 31)] = W[(size_t)(k0 + kk) * N + n0 + (lane & 31)]; }
    asm volatile("s_waitcnt lgkmcnt(0)" ::: "memory");
    const int c = lane & 7;
#pragma unroll
    for (int j = 0; j < 4; ++j) {
        const int n = (lane >> 3) + 8 * j; const float* s = scr + (8 * c) * 33 + n;
        u32x4 o; o.x = pk2(s[0 * 33], s[1 * 33]); o.y = pk2(s[2 * 33], s[3 * 33]); o.z = pk2(s[4 * 33], s[5 * 33]); o.w = pk2(s[6 * 33], s[7 * 33]);
        *(u32x4*)(WT + (size_t)rowmap(n0 + n) * K + k0 + 8 * c) = o;
    }
    asm volatile("s_waitcnt lgkmcnt(0)" ::: "memory");
}

__device__ __forceinline__ void sincos_d(double x, double& s, double& c) {
    const double k = rint(x * 0.63661977236758134308);
    const double r = (x - k * 1.57079632679489655800) - k * 6.123233995736766036e-17;
    const double r2 = r * r;
    double sp = 1.0 / 121645100408832000.0;
    sp = sp * r2 * (-1.0) + 1.0 / 355687428096000.0;
    sp = sp * r2 * (-1.0) + 1.0 / 1307674368000.0;
    sp = sp * r2 * (-1.0) + 1.0 / 6227020800.0;
    sp = sp * r2 * (-1.0) + 1.0 / 39916800.0;
    sp = sp * r2 * (-1.0) + 1.0 / 362880.0;
    sp = sp * r2 * (-1.0) + 1.0 / 5040.0;
    sp = sp * r2 * (-1.0) + 1.0 / 120.0;
    sp = sp * r2 * (-1.0) + 1.0 / 6.0;
    sp = sp * r2 * (-1.0) + 1.0;
    const double sr = sp * r;
    double cpn = 1.0 / 6402373705728000.0;
    cpn = cpn * r2 * (-1.0) + 1.0 / 20922789888000.0;
    cpn = cpn * r2 * (-1.0) + 1.0 / 87178291200.0;
    cpn = cpn * r2 * (-1.0) + 1.0 / 479001600.0;
    cpn = cpn * r2 * (-1.0) + 1.0 / 3628800.0;
    cpn = cpn * r2 * (-1.0) + 1.0 / 40320.0;
    cpn = cpn * r2 * (-1.0) + 1.0 / 720.0;
    cpn = cpn * r2 * (-1.0) + 1.0 / 24.0;
    cpn = cpn * r2 * (-1.0) + 0.5;
    const double cr = 1.0 - cpn * r2;
    const int q = ((int)k) & 3;
    s = (q == 0) ? sr : (q == 1) ? cr : (q == 2) ? -sr : -cr;
    c = (q == 0) ? cr : (q == 1) ? -sr : (q == 2) ? -cr : sr;
}
__device__ __forceinline__ double exp_small_d(double x) {
    const double y = x * 0.125;
    double p = 1.0 / 479001600.0;
    p = p * y + 1.0 / 39916800.0; p = p * y + 1.0 / 3628800.0; p = p * y + 1.0 / 362880.0; p = p * y + 1.0 / 40320.0;
    p = p * y + 1.0 / 5040.0; p = p * y + 1.0 / 720.0; p = p * y + 1.0 / 120.0; p = p * y + 1.0 / 24.0;
    p = p * y + 1.0 / 6.0; p = p * y + 0.5; p = p * y + 1.0; p = p * y + 1.0;
    p = p * p; p = p * p; p = p * p;
    return p;
}

__device__ __forceinline__ void phase_prep(const Params& P, unsigned char* lds) {
    int tid_ = threadIdx.x; asm volatile("" : "+v"(tid_));
    const int tid = tid_, lane = tid & 63, wave = tid >> 6;
    const int G = gridDim.x;
    const int gw = blockIdx.x * 8 + wave, NGW = G * 8;
    const size_t gtid = (size_t)blockIdx.x * NTHREADS + tid, NGT = (size_t)G * NTHREADS;
    unsigned char* ws = P.ws;
    if (blockIdx.x == 0 && tid < 64) ((int*)(ws + WS_CTL))[tid] = 0;
    {
        const f32x4* x4 = (const f32x4*)P.in[0]; u32x4* o = (u32x4*)(ws + WS_XB);
        const size_t n8 = (size_t)T * D / 8;
        for (size_t i = gtid; i < n8; i += NGT) { const f32x4 v = x4[2 * i], u = x4[2 * i + 1]; u32x4 w; w.x = pk2(v.x, v.y); w.y = pk2(v.z, v.w); w.z = pk2(u.x, u.y); w.w = pk2(u.z, u.w); o[i] = w; }
    }
    {
        float* scr = (float*)(lds + wave * 8704);
        constexpr int I_IN = 16 * 112, I_GLU = 8 * 64, I_COUT = 8 * 32, I_OUT = 16 * 32, I_RG = 16 * 1  , I_G = 16 * 8, I_D = 4 * 32;
        (void)I_RG;
        constexpr int TOTAL = I_IN + I_GLU + I_COUT + I_OUT + 16  ;
        for (int it = gw; it < TOTAL; it += NGW) {
            int r = it;
            if (r < I_IN) {
                transpose_item(P.in[1], D, DIN, (bf16*)(ws + WS_WIN), scr, r, lane,
                               [](int c) { return c < 512 ? c : (c < 1024 ? 512 + (((c - 512) >> 7) << 8) + ((c - 512) & 127) : (c < 1536 ? 512 + (((c - 1024) >> 7) << 8) + 128 + ((c - 1024) & 127) : c)); });
                continue;
            }
            r -= I_IN;
            if (r < I_GLU) { transpose_item(P.in[11], DSSM, 2 * D, (bf16*)(ws + WS_WGLU), scr, r, lane, [](int c) { return c < 1024 ? ((c >> 7) << 8) + (c & 127) : (((c - 1024) >> 7) << 8) + 128 + ((c - 1024) & 127); }); continue; }
            r -= I_GLU;
            if (r < I_COUT) { transpose_item(P.in[17], DCONV, D, (bf16*)(ws + WS_WCOUT), scr, r, lane, [](int c) { return c; }); continue; }
            r -= I_COUT;
            if (r < I_OUT) { transpose_item(P.in[19], D, D, (bf16*)(ws + WS_WOUT), scr, r, lane, [](int c) { return c; }); continue; }
            r -= I_OUT;
            transpose_item(P.in[25], D, NEXP, (bf16*)(ws + WS_WR), scr, r, lane, [](int c) { return 4 + c; });
        }
    }
    {
        bf16* wr = (bf16*)(ws + WS_WR);
        for (size_t i = gtid; i < (size_t)4 * D; i += NGT) { const int n = (int)(i / D), k = (int)(i % D); wr[(size_t)n * D + k] = (bf16)f2bf(P.in[23][(size_t)k * 4 + n]); }
        for (size_t i = gtid; i < (size_t)(256 - 36) * D / 2; i += NGT) ((unsigned*)(wr + (size_t)36 * D))[i] = 0u;
    }
    {
        float* binp = (float*)(ws + WS_TAB + TAB_BINP); float* bglup = (float*)(ws + WS_TAB + TAB_BGLUP);
        for (size_t i = gtid; i < (size_t)DIN; i += NGT) { const int c = (int)i; const int r = c < 512 ? c : (c < 1024 ? 512 + (((c - 512) >> 7) << 8) + ((c - 512) & 127) : (c < 1536 ? 512 + (((c - 1024) >> 7) << 8) + 128 + ((c - 1024) & 127) : c)); binp[r] = P.in[2][c]; }
        for (size_t i = gtid; i < (size_t)2 * D; i += NGT) { const int c = (int)i; const int r = c < 1024 ? ((c >> 7) << 8) + (c & 127) : (((c - 1024) >> 7) << 8) + 128 + ((c - 1024) & 127); bglup[r] = P.in[12][c]; }
    }
    if (gtid < (size_t)NGRP * NST) {
        const int g = (int)gtid >> 6, p = (int)gtid & 63;
        const double lr = (double)P.in[3][g * 64 + p], li = (double)P.in[4][g * 64 + p];
        const double dt = (double)expf(P.in[5][g]);
        const double mag = exp_small_d(lr * dt);
        double sn, cs; sincos_d(li * dt, sn, cs);
        const double ar = mag * cs, ai = mag * sn;
        const double den = lr * lr + li * li;
        const double fr_ = ((ar - 1.0) * lr + ai * li) / den, fi_ = (ai * lr - (ar - 1.0) * li) / den;
        float* atab = (float*)(ws + WS_TAB + TAB_A);
        atab[(g * 64 + p) * 2 + 0] = (float)ar; atab[(g * 64 + p) * 2 + 1] = (float)ai;
        bf16* bb = (bf16*)(ws + WS_TAB + TAB_BB); bf16* cm = (bf16*)(ws + WS_TAB + TAB_CM);
        const int sh = p >> 5, p32 = p & 31;
        for (int h = 0; h < NH; ++h) {
            const double bre = (double)P.in[6][(g * 64 + p) * 16 + h], bim = (double)P.in[7][(g * 64 + p) * 16 + h];
            const double vre = fr_ * bre - fi_ * bim, vim = fr_ * bim + fi_ * bre;
            const int ln = p32 + 32 * (h >> 3), j = h & 7;
            bb[(((size_t)g * 4 + sh * 2 + 0) * 64 + ln) * 8 + j] = (bf16)f2bf((float)vre);
            bb[(((size_t)g * 4 + sh * 2 + 1) * 64 + ln) * 8 + j] = (bf16)f2bf((float)vim);
        }
        for (int ho = 0; ho < NH; ++ho) {
            const float cre = P.in[8][g * 1024 + ho * 64 + p], cim = P.in[9][g * 1024 + ho * 64 + p];
#pragma unroll
            for (int ri = 0; ri < 2; ++ri) {
                const int k = 2 * p + ri, ks = k >> 5, kk = k & 31, ln = ho + 16 * (kk >> 3), j = kk & 7;
                cm[(((size_t)g * 4 + ks) * 64 + ln) * 8 + j] = (bf16)f2bf(ri == 0 ? cre : -cim);
            }
        }
    }
}

__device__ __forceinline__ void expert_transposes(const Params& P, unsigned char* lds) {
    int tid_ = threadIdx.x; asm volatile("" : "+v"(tid_));
    const int tid = tid_, lane = tid & 63, wave = tid >> 6;
    const int gw = blockIdx.x * 8 + wave, NGW = gridDim.x * 8;
    unsigned char* ws = P.ws;
    float* scr = (float*)(lds + wave * 8704);
    constexpr int I_G = 16 * 8, I_D = 4 * 32;
    for (int it = gw; it < NEXP * (2 * I_G + I_D); it += NGW) {
        int r = it;
            if (r < NEXP * I_G) { const int e = r / I_G; transpose_item(P.in[27] + (size_t)e * D * DFF, D, DFF, (bf16*)(ws + WS_WGU) + (size_t)e * 512 * D, scr, r % I_G, lane, [](int c) { return ((c >> 7) << 8) + (c & 127); }); continue; }
            r -= NEXP * I_G;
            if (r < NEXP * I_G) { const int e = r / I_G; transpose_item(P.in[28] + (size_t)e * D * DFF, D, DFF, (bf16*)(ws + WS_WGU) + (size_t)e * 512 * D, scr, r % I_G, lane, [](int c) { return ((c >> 7) << 8) + 128 + (c & 127); }); continue; }
            r -= NEXP * I_G;
            if (r < NEXP * I_D) { const int e = r / I_D; transpose_item(P.in[29] + (size_t)e * DFF * D, DFF, D, (bf16*)(ws + WS_WD) + (size_t)e * D * DFF, scr, r % I_D, lane, [](int c) { return c; }); continue; }
    }
    __syncthreads();
}
struct EpiProj {
    const float* binp; bf16* U; bf16* V; bf16* SGS; bf16* SGC; int row0, col0;
    __device__ __forceinline__ void operator()(const f32x4 (&acc)[4][4], int r_in, int c_in) const {
#pragma unroll
        for (int mi = 0; mi < 4; ++mi) {
            const size_t row = (size_t)(row0 + r_in + mi * 16);
#pragma unroll
            for (int ni = 0; ni < 4; ++ni) {
                const int col = col0 + c_in + ni * 16;
                const f32x4 b = *(const f32x4*)(binp + col);
                const f32x4 v = acc[mi][ni] + b;
                if (col0 < 512) {
                    u32x2 w; w.x = pk2(v.x, v.y); w.y = pk2(v.z, v.w); *(u32x2*)(U + row * 512 + col) = w;
                } else if (col0 < 1536) {
                    const float v0 = v.x * sigmoidf_(v.y), v1 = v.z * sigmoidf_(v.w);
                    *(unsigned*)(V + row * 512 + ((col - 512) >> 1)) = pk2(v0, v1);
                } else if (col0 < 2560) {
                    u32x2 w; w.x = pk2(sigmoidf_(v.x), sigmoidf_(v.y)); w.y = pk2(sigmoidf_(v.z), sigmoidf_(v.w)); *(u32x2*)(SGS + row * 1024 + (col - 1536)) = w;
                } else {
                    u32x2 w; w.x = pk2(sigmoidf_(v.x), sigmoidf_(v.y)); w.y = pk2(sigmoidf_(v.z), sigmoidf_(v.w)); *(u32x2*)(SGC + row * 1024 + (col - 2560)) = w;
                }
            }
        }
    }
};
struct EpiCout {
    const float* bias; const bf16* SGC; bf16* MERGED; int row0, col0;
    __device__ __forceinline__ void operator()(const f32x4 (&acc)[4][4], int r_in, int c_in) const {
#pragma unroll
        for (int mi = 0; mi < 4; ++mi) {
            const size_t row = (size_t)(row0 + r_in + mi * 16);
#pragma unroll
            for (int ni = 0; ni < 4; ++ni) {
                const int col = col0 + c_in + ni * 16;
                const f32x4 v = acc[mi][ni] + *(const f32x4*)(bias + col);
                const u32x2 g = *(const u32x2*)(SGC + row * 1024 + col);
                u32x2 w; w.x = pk2(v.x * bflo(g.x), v.y * bfhi(g.x)); w.y = pk2(v.z * bflo(g.y), v.w * bfhi(g.y));
                *(u32x2*)(MERGED + row * 1024 + col) = w;
            }
        }
    }
};
struct EpiGlu {
    const float* bglup; const bf16* SGS; bf16* MERGED; int row0, col0;
    __device__ __forceinline__ void operator()(const f32x4 (&acc)[4][4], int r_in, int c_in) const {
#pragma unroll
        for (int mi = 0; mi < 4; ++mi) {
            const size_t row = (size_t)(row0 + r_in + mi * 16);
#pragma unroll
            for (int ni = 0; ni < 4; ++ni) {
                const int col = col0 + c_in + ni * 16;
                const f32x4 v = acc[mi][ni] + *(const f32x4*)(bglup + col);
                const int mc = col >> 1;
                const float s0 = v.x * sigmoidf_(v.y), s1 = v.z * sigmoidf_(v.w);
                const unsigned g = *(const unsigned*)(SGS + row * 1024 + mc);
                const unsigned m = *(const unsigned*)(MERGED + row * 1024 + mc);
                *(unsigned*)(MERGED + row * 1024 + mc) = pk2(bflo(m) + bflo(g) * s0, bfhi(m) + bfhi(g) * s1);
            }
        }
    }
};
struct EpiOut {
    const float* bias; const float* X; float* PRE; int row0, col0;
    __device__ __forceinline__ void operator()(const f32x4 (&acc)[4][4], int r_in, int c_in) const {
#pragma unroll
        for (int mi = 0; mi < 4; ++mi) {
            const size_t row = (size_t)(row0 + r_in + mi * 16);
#pragma unroll
            for (int ni = 0; ni < 4; ++ni) {
                const int col = col0 + c_in + ni * 16;
                const f32x4 xv = *(const f32x4*)(X + row * 1024 + col);
                *(f32x4*)(PRE + row * 1024 + col) = acc[mi][ni] + *(const f32x4*)(bias + col) + xv * ALPHA;
            }
        }
    }
};
struct EpiZ {
    float* Z; int row0;
    __device__ __forceinline__ void operator()(const f32x4 (&acc)[4][1], int r_in, int c_in) const {
#pragma unroll
        for (int mi = 0; mi < 4; ++mi) *(f32x4*)(Z + (size_t)(row0 + r_in + mi * 16) * 64 + c_in) = acc[mi][0];
    }
};
struct EpiGU {
    bf16* HID; int prow0, col0;
    __device__ __forceinline__ void operator()(const f32x4 (&acc)[4][4], int r_in, int c_in) const {
#pragma unroll
        for (int mi = 0; mi < 4; ++mi) {
            const size_t row = (size_t)(prow0 + r_in + mi * 16);
#pragma unroll
            for (int ni = 0; ni < 4; ++ni) {
                const int col = col0 + c_in + ni * 16;
                const f32x4 v = acc[mi][ni];
                *(unsigned*)(HID + row * 256 + (col >> 1)) = pk2(siluf_(v.x) * v.y, siluf_(v.z) * v.w);
            }
        }
    }
};
struct EpiDown {
    bf16* YM; const int* toklist; const float* GATE; int idx0, cnt, col0;
    __device__ __forceinline__ void operator()(const f32x4 (&acc)[4][4], int r_in, int c_in) const {
#pragma unroll
        for (int mi = 0; mi < 4; ++mi) {
            const int idx = idx0 + r_in + mi * 16;
            if (idx < cnt) {
                const int ent = toklist[idx];
                const float g = GATE[ent];
#pragma unroll
                for (int ni = 0; ni < 4; ++ni) {
                    const int col = col0 + c_in + ni * 16;
                    const f32x4 v = acc[mi][ni] * g;
                    u32x2 w; w.x = pk2(v.x, v.y); w.y = pk2(v.z, v.w);
                    *(u32x2*)(YM + (size_t)ent * 1024 + col) = w;
                }
            }
        }
    }
};

struct RowsDense { const bf16* base; size_t ld; __device__ __forceinline__ const bf16* operator()(int r) const { return base + (size_t)r * ld; } };
struct RowsGather {
    const bf16* HB; const int* toklist; int idx0, cnt;
    __device__ __forceinline__ const bf16* operator()(int r) const { const int idx = idx0 + r; const int tok = idx < cnt ? (toklist[idx] >> 1) : 0; return HB + (size_t)tok * 1024; }
};

constexpr int S5_WREG = 10752, S5_LBUF = 8 * S5_WREG;
__device__ __forceinline__ void s5_block_item(const Params& P, unsigned char* lds, int item) {
    unsigned char* ws = P.ws;
    int tid_ = threadIdx.x; asm volatile("" : "+v"(tid_));
    const int tid = tid_, lane = tid & 63, wave = __builtin_amdgcn_readfirstlane(tid >> 6);
    unsigned char* sbuf = lds + wave * S5_WREG; unsigned char* ubuf = sbuf + 8704; unsigned char* ybuf = sbuf + 9728;
    f32x4* Lbuf = (f32x4*)(lds + S5_LBUF);
    const int g = item & 31, bp = item >> 5;
    const int p32 = lane & 31, hf = lane >> 5;
    const float* atab = (const float*)(ws + WS_TAB + TAB_A);
    const float ar0 = atab[(g * 64 + p32) * 2], ai0 = atab[(g * 64 + p32) * 2 + 1];
    const float ar1 = atab[(g * 64 + p32 + 32) * 2], ai1 = atab[(g * 64 + p32 + 32) * 2 + 1];
    bf16x8 bb[4], cm[4];
#pragma unroll
    for (int q = 0; q < 4; ++q) {
        bb[q] = *(const bf16x8*)(ws + WS_TAB + TAB_BB + (((size_t)g * 4 + q) * 64 + lane) * 16);
        cm[q] = *(const bf16x8*)(ws + WS_TAB + TAB_CM + (((size_t)g * 4 + q) * 64 + lane) * 16);
    }
    const bf16* U = (const bf16*)(ws + WS_U);
    bf16* YG = (bf16*)(ws + WS_YG);
    const int a_seq = (p32 >> 2) & 1, a_ti = (p32 & 3) + 4 * (p32 >> 3);
    const int tbase = wave * 256;
    const bf16* ua = U + ((size_t)(2 * bp + a_seq) * SEQ + tbase + a_ti) * 512 + g * 16 + 8 * hf;
    const int ho = lane & 15, i4 = 4 * (lane >> 4);
    const float dsk = P.in[10][g * 16 + ho];
    const f32x16 z16 = {0.f, 0.f, 0.f, 0.f, 0.f, 0.f, 0.f, 0.f, 0.f, 0.f, 0.f, 0.f, 0.f, 0.f, 0.f, 0.f};
    float s0r = 0.f, s0i = 0.f, s1r = 0.f, s1i = 0.f;
    {
        bf16x8 afr[16];
#pragma unroll
        for (int blk = 0; blk < 16; ++blk) afr[blk] = *(const bf16x8*)(ua + (size_t)(blk * 16) * 512);
#pragma unroll
        for (int blk = 0; blk < 16; ++blk) {
            const bf16x8 af = afr[blk];
            const f32x16 b0r = mfma32_h(af, bb[0], z16, 0, 0, 0);
            const f32x16 b0i = mfma32_h(af, bb[1], z16, 0, 0, 0);
            const f32x16 b1r = mfma32_h(af, bb[2], z16, 0, 0, 0);
            const f32x16 b1i = mfma32_h(af, bb[3], z16, 0, 0, 0);
#pragma unroll
            for (int i = 0; i < 16; ++i) {
                float n0r = __builtin_fmaf(ar0, s0r, __builtin_fmaf(-ai0, s0i, b0r[i])); asm volatile("" : "+v"(n0r));
                float n0i = __builtin_fmaf(ar0, s0i, __builtin_fmaf(ai0, s0r, b0i[i]));  asm volatile("" : "+v"(n0i));
                float n1r = __builtin_fmaf(ar1, s1r, __builtin_fmaf(-ai1, s1i, b1r[i])); asm volatile("" : "+v"(n1r));
                float n1i = __builtin_fmaf(ar1, s1i, __builtin_fmaf(ai1, s1r, b1i[i]));  asm volatile("" : "+v"(n1i));
                s0r = n0r; s0i = n0i; s1r = n1r; s1i = n1i;
            }
        }
    }
    Lbuf[wave * 64 + lane] = (f32x4){s0r, s0i, s1r, s1i};
    __syncthreads();
    {
        float pr0 = ar0, pi0 = ai0, pr1 = ar1, pi1 = ai1;
#pragma unroll
        for (int i = 0; i < 8; ++i) {
            const float t0r = pr0 * pr0 - pi0 * pi0, t0i = 2.0f * pr0 * pi0, t1r = pr1 * pr1 - pi1 * pi1, t1i = 2.0f * pr1 * pi1;
            pr0 = t0r; pi0 = t0i; pr1 = t1r; pi1 = t1i;
        }
        s0r = 0.f; s0i = 0.f; s1r = 0.f; s1i = 0.f;
        for (int j = 0; j < wave; ++j) {
            const f32x4 L = Lbuf[j * 64 + lane];
            const float n0r = pr0 * s0r - pi0 * s0i + L.x, n0i = pr0 * s0i + pi0 * s0r + L.y;
            const float n1r = pr1 * s1r - pi1 * s1i + L.z, n1i = pr1 * s1i + pi1 * s1r + L.w;
            s0r = n0r; s0i = n0i; s1r = n1r; s1i = n1i;
        }
    }
    {
        bf16x8 af = *(const bf16x8*)ua;
        unsigned char* wrow = sbuf + (hf * 16) * 272 + 4 * p32;
        unsigned char* uw = ubuf + (a_seq * 16 + a_ti) * 32 + hf * 16;
        const int orow = lane >> 1, ohalf = lane & 1;
        bf16* yg_out = YG + ((size_t)(2 * bp + (orow >> 4)) * SEQ + tbase + (orow & 15)) * 512 + g * 16 + ohalf * 8;
        for (int blk = 0; blk < 16; ++blk) {
            const bf16x8 afn = *(const bf16x8*)(ua + (size_t)((blk < 15 ? blk + 1 : blk) * 16) * 512);
            *(bf16x8*)uw = af;
            const f32x16 b0r = mfma32_h(af, bb[0], z16, 0, 0, 0);
            const f32x16 b0i = mfma32_h(af, bb[1], z16, 0, 0, 0);
            const f32x16 b1r = mfma32_h(af, bb[2], z16, 0, 0, 0);
            const f32x16 b1i = mfma32_h(af, bb[3], z16, 0, 0, 0);
#pragma unroll
            for (int i = 0; i < 16; ++i) {
                float n0r = __builtin_fmaf(ar0, s0r, __builtin_fmaf(-ai0, s0i, b0r[i])); asm volatile("" : "+v"(n0r));
                float n0i = __builtin_fmaf(ar0, s0i, __builtin_fmaf(ai0, s0r, b0i[i]));  asm volatile("" : "+v"(n0i));
                float n1r = __builtin_fmaf(ar1, s1r, __builtin_fmaf(-ai1, s1i, b1r[i])); asm volatile("" : "+v"(n1r));
                float n1i = __builtin_fmaf(ar1, s1i, __builtin_fmaf(ai1, s1r, b1i[i]));  asm volatile("" : "+v"(n1i));
                s0r = n0r; s0i = n0i; s1r = n1r; s1i = n1i;
                *(unsigned*)(wrow + i * 272) = pk2(s0r, s0i);
                *(unsigned*)(wrow + i * 272 + 128) = pk2(s1r, s1i);
            }
            asm volatile("s_waitcnt lgkmcnt(0)" ::: "memory");
#pragma unroll
            for (int mb = 0; mb < 2; ++mb) {
                f32x4 y = {0.f, 0.f, 0.f, 0.f};
#pragma unroll
                for (int ks = 0; ks < 4; ++ks) {
                    const bf16x8 sf = *(const bf16x8*)(sbuf + (mb * 16 + (lane & 15)) * 272 + ks * 64 + (lane >> 4) * 16);
                    y = mfma16_h(sf, cm[ks], y, 0, 0, 0);
                }
#pragma unroll
                for (int r = 0; r < 4; ++r) {
                    const int ro = ((mb * 16 + i4 + r) * 32 + ho * 2);
                    const float yv = y[r] + dsk * bf2f(*(const bf16*)(ubuf + ro));
                    *(bf16*)(ybuf + ro) = (bf16)(pk2(geluf_(yv), 0.f) & 0xffffu);
                }
            }
            asm volatile("s_waitcnt lgkmcnt(0)" ::: "memory");
            const u32x4 yo = *(const u32x4*)(ybuf + orow * 32 + ohalf * 16);
            *(u32x4*)(yg_out + (size_t)(blk * 16) * 512) = yo;
            asm volatile("s_waitcnt lgkmcnt(0)" ::: "memory");
            af = afn;
        }
    }
    __syncthreads();
}

__device__ __forceinline__ void conv_phase(const Params& P, unsigned char* lds) {
    unsigned char* ws = P.ws;
    int tid_ = threadIdx.x; asm volatile("" : "+v"(tid_));
    const int tid = tid_, lane = tid & 63, wave = tid >> 6;
    const bf16* V = (const bf16*)(ws + WS_V);
    bf16* CV = (bf16*)(ws + WS_CV);
    unsigned char* vt = lds;
    float* ct = (float*)(lds + 63488);
    const int G = gridDim.x, nitems = T / 32;
    const int ch = tid;
    float w0[CW];
#pragma unroll
    for (int k = 0; k < CW; ++k) w0[k] = P.in[13][k * 512 + ch];
    const float cb0 = P.in[14][ch];
    const f32x4 g0 = *(const f32x4*)(P.in[15] + lane * 4), g1 = *(const f32x4*)(P.in[15] + 256 + lane * 4);
    const f32x4 b0 = *(const f32x4*)(P.in[16] + lane * 4), b1 = *(const f32x4*)(P.in[16] + 256 + lane * 4);
    u32x4 pf[8];
#define CONV_FETCH(item_) do { const int tokb_ = (item_) * 32, tloc_ = tokb_ & (SEQ - 1); \
        _Pragma("unroll") for (int n = 0; n < 8; ++n) { const int q = tid + n * NTHREADS; const int r = q >> 6, c16 = q & 63; \
            pf[n] = (u32x4){0u, 0u, 0u, 0u}; \
            if (q < 62 * 64 && tloc_ - 30 + r >= 0) pf[n] = *(const u32x4*)(V + (size_t)(tokb_ - 30 + r) * 512 + c16 * 8); } } while (0)
    int item = blockIdx.x;
    if (item < nitems) CONV_FETCH(item);
    for (; item < nitems; item += G) {
        const int tokb = item * 32;
#pragma unroll
        for (int n = 0; n < 8; ++n) { const int q = tid + n * NTHREADS; if (q < 62 * 64) *(u32x4*)(vt + (q >> 6) * 1024 + (q & 63) * 16) = pf[n]; }
        __syncthreads();
        if (item + G < nitems) CONV_FETCH(item + G);
#pragma unroll 1
        for (int jc = 0; jc < 4; ++jc) {
            const int base = jc * 8;
            float a0[8];
#pragma unroll
            for (int j = 0; j < 8; ++j) a0[j] = cb0;
#pragma unroll
            for (int r = 0; r < 38; ++r) {
                const float x0 = bf2f(*(const bf16*)(vt + (base + r) * 1024 + ch * 2));
#pragma unroll
                for (int j = 0; j < 8; ++j) {
                    const int k = r - j;
                    if (k >= 0 && k < CW) a0[j] += w0[k] * x0;
                }
            }
#pragma unroll
            for (int j = 0; j < 8; ++j) ct[(base + j) * 512 + ch] = a0[j];
        }
        __syncthreads();
#pragma unroll
        for (int rr = 0; rr < 4; ++rr) {
            const int row = wave * 4 + rr;
            const f32x4 c0 = *(const f32x4*)(ct + row * 512 + lane * 4), c1 = *(const f32x4*)(ct + row * 512 + 256 + lane * 4);
            const float mean = wave_sum((c0.x + c0.y) + (c0.z + c0.w) + (c1.x + c1.y) + (c1.z + c1.w)) * (1.0f / 512.0f);
            const f32x4 d0 = c0 - mean, d1 = c1 - mean;
            const float var = wave_sum((d0.x * d0.x + d0.y * d0.y) + (d0.z * d0.z + d0.w * d0.w) + (d1.x * d1.x + d1.y * d1.y) + (d1.z * d1.z + d1.w * d1.w)) * (1.0f / 512.0f);
            const float rstd = 1.0f / sqrtf(var + LN_EPS);
            const f32x4 y0 = d0 * rstd * g0 + b0, y1 = d1 * rstd * g1 + b1;
            u32x2 o0, o1;
            o0.x = pk2(siluf_(y0.x), siluf_(y0.y)); o0.y = pk2(siluf_(y0.z), siluf_(y0.w));
            o1.x = pk2(siluf_(y1.x), siluf_(y1.y)); o1.y = pk2(siluf_(y1.z), siluf_(y1.w));
            bf16* orow = CV + (size_t)(tokb + row) * 512;
            *(u32x2*)(orow + lane * 4) = o0; *(u32x2*)(orow + 256 + lane * 4) = o1;
        }
        __syncthreads();
    }
#undef CONV_FETCH
}

__device__ __forceinline__ void ln1_rows(const Params& P) {
    const int tid = threadIdx.x, lane = tid & 63, wave = tid >> 6;
    const int gw = blockIdx.x * 8 + wave, NGW = gridDim.x * 8;
    const float* PRE = P.out; bf16* HB = (bf16*)(P.ws + WS_HB);
    const float* lg = P.in[21]; const float* lb = P.in[22];
    f32x4 g[4], b[4];
#pragma unroll
    for (int j = 0; j < 4; ++j) { g[j] = *(const f32x4*)(lg + j * 256 + lane * 4); b[j] = *(const f32x4*)(lb + j * 256 + lane * 4); }
    for (int row = gw; row < T; row += NGW) {
        const float* xr = PRE + (size_t)row * 1024;
        f32x4 v[4]; float s = 0.f;
#pragma unroll
        for (int j = 0; j < 4; ++j) { v[j] = *(const f32x4*)(xr + j * 256 + lane * 4); s += (v[j].x + v[j].y) + (v[j].z + v[j].w); }
        const float mean = wave_sum(s) * (1.0f / 1024.0f); float s2 = 0.f;
#pragma unroll
        for (int j = 0; j < 4; ++j) { v[j] = v[j] - mean; s2 += (v[j].x * v[j].x + v[j].y * v[j].y) + (v[j].z * v[j].z + v[j].w * v[j].w); }
        const float rstd = 1.0f / sqrtf(wave_sum(s2) * (1.0f / 1024.0f) + LN_EPS);
        bf16* orow = HB + (size_t)row * 1024;
#pragma unroll
        for (int j = 0; j < 4; ++j) {
            const f32x4 y = v[j] * rstd * g[j] + b[j];
            u32x2 w; w.x = pk2(y.x, y.y); w.y = pk2(y.z, y.w);
            *(u32x2*)(orow + j * 256 + lane * 4) = w;
        }
    }
}
__device__ __forceinline__ void final_rows(const Params& P) {
    int tid_ = threadIdx.x; asm volatile("" : "+v"(tid_));
    const int tid = tid_, lane = tid & 63, wave = tid >> 6;
    const int gw = blockIdx.x * 8 + wave, NGW = gridDim.x * 8;
    const bf16* HB = (const bf16*)(P.ws + WS_HB); const bf16* YM = (const bf16*)(P.ws + WS_YM);
    const float* lg = P.in[30]; const float* lb = P.in[31];
    f32x4 g[4], b[4];
#pragma unroll
    for (int j = 0; j < 4; ++j) { g[j] = *(const f32x4*)(lg + j * 256 + lane * 4); b[j] = *(const f32x4*)(lb + j * 256 + lane * 4); }
#pragma unroll 2
    for (int row = gw; row < T; row += NGW) {
        f32x4 v[4]; float s = 0.f;
#pragma unroll
        for (int j = 0; j < 4; ++j) {
            const u32x2 h = *(const u32x2*)(HB + (size_t)row * 1024 + j * 256 + lane * 4);
            const u32x2 y0 = *(const u32x2*)(YM + (size_t)(2 * row) * 1024 + j * 256 + lane * 4);
            const u32x2 y1 = *(const u32x2*)(YM + (size_t)(2 * row + 1) * 1024 + j * 256 + lane * 4);
            v[j].x = ALPHA * bflo(h.x) + bflo(y0.x) + bflo(y1.x); v[j].y = ALPHA * bfhi(h.x) + bfhi(y0.x) + bfhi(y1.x);
            v[j].z = ALPHA * bflo(h.y) + bflo(y0.y) + bflo(y1.y); v[j].w = ALPHA * bfhi(h.y) + bfhi(y0.y) + bfhi(y1.y);
            s += (v[j].x + v[j].y) + (v[j].z + v[j].w);
        }
        const float mean = wave_sum(s) * (1.0f / 1024.0f); float s2 = 0.f;
#pragma unroll
        for (int j = 0; j < 4; ++j) { v[j] = v[j] - mean; s2 += (v[j].x * v[j].x + v[j].y * v[j].y) + (v[j].z * v[j].z + v[j].w * v[j].w); }
        const float rstd = 1.0f / sqrtf(wave_sum(s2) * (1.0f / 1024.0f) + LN_EPS);
        float* orow = P.out + (size_t)row * 1024;
#pragma unroll
        for (int j = 0; j < 4; ++j) *(f32x4*)(orow + j * 256 + lane * 4) = v[j] * rstd * g[j] + b[j];
    }
}
struct EpiZlds {
    float* Zs;
    __device__ __forceinline__ void operator()(const f32x4 (&acc)[4][4], int r_in, int c_in) const {
        if (c_in >= 64) return;
#pragma unroll
        for (int mi = 0; mi < 4; ++mi)
#pragma unroll
            for (int ni = 0; ni < 3; ++ni) {
                const int c = c_in + ni * 16;
                if (c < 40) *(f32x4*)(Zs + (r_in + mi * 16) * 40 + c) = acc[mi][ni];
            }
    }
};
__device__ __forceinline__ void ln_route_phase(const Params& P, unsigned char* lds) {
    unsigned char* ws = P.ws;
    int tid_ = threadIdx.x; asm volatile("" : "+v"(tid_));
    const int tid = tid_, lane = tid & 63, wave = tid >> 6, r = lane & 15, q = lane >> 4;
    const bf16* PREB = (const bf16*)(ws + WS_PREB); bf16* HB = (bf16*)(ws + WS_HB);
    int* CNT = (int*)(ws + WS_CTL); int* TOK = (int*)(ws + WS_TOK); float* GATE = (float*)(ws + WS_GATE);
    const float* lg = P.in[21]; const float* lb = P.in[22];
    const float* brg = P.in[24]; const float* bre = P.in[26];
    unsigned char* wl = lds;
    float* gl = (float*)(lds + 74304);
    float* zt = (float*)(lds + 82496 + wave * 3328);
    int* hist = (int*)(lds + 109120); int* base = hist + 32;
    for (int t = blockIdx.x; t < T / 128; t += gridDim.x) {
        asm volatile("" ::: "memory");
        int q8 = q * 8, ro = r * 1024 + q * 8;
        asm volatile("" : "+v"(q8), "+v"(ro));
#pragma unroll
        for (int i = 0; i < 9; ++i) {
            const int h = i * 8 + wave, wrow = h >> 1, half = h & 1;
            glds16((const bf16*)(ws + WS_WR) + wrow * 1024 + half * 512 + lane * 8, wl + wrow * 2064 + half * 1024 + lane * 16);
        }
        glds16(tid < 256 ? lg + tid * 4 : lb + (tid - 256) * 4, (unsigned char*)gl + tid * 16);
        const unsigned char* wrp0 = wl + (ro >> 10) * 2064 + q8 * 2;
        const unsigned char* wrp2 = wl + (32 + ((ro >> 10) & 3)) * 2064 + q8 * 2;
        const float* lgq = gl + q8; const float* lbq = gl + 1024 + q8;
        if (tid < 32) hist[tid] = 0;
        const size_t row = (size_t)t * 128 + wave * 16 + r;
        const bf16* prow = PREB + row * 1024 + q8;
        u32x4 pv[32];
#pragma unroll
        for (int s = 0; s < 32; ++s) pv[s] = *(const u32x4*)(prow + s * 32);
        float sm = 0.f;
#pragma unroll
        for (int s = 0; s < 32; ++s)
            sm += ((bflo(pv[s].x) + bfhi(pv[s].x)) + (bflo(pv[s].y) + bfhi(pv[s].y))) + ((bflo(pv[s].z) + bfhi(pv[s].z)) + (bflo(pv[s].w) + bfhi(pv[s].w)));
        sm += __shfl_xor(sm, 16); sm += __shfl_xor(sm, 32);
        const float mean = sm * (1.0f / 1024.0f);
#pragma unroll
        for (int s = 0; s < 32; ++s) asm volatile("" : "+v"(pv[s]));
        float s2 = 0.f;
#pragma unroll
        for (int s = 0; s < 32; ++s) {
            const float d0 = bflo(pv[s].x) - mean, d1 = bfhi(pv[s].x) - mean, d2 = bflo(pv[s].y) - mean, d3 = bfhi(pv[s].y) - mean;
            const float d4 = bflo(pv[s].z) - mean, d5 = bfhi(pv[s].z) - mean, d6 = bflo(pv[s].w) - mean, d7 = bfhi(pv[s].w) - mean;
            s2 += ((d0 * d0 + d1 * d1) + (d2 * d2 + d3 * d3)) + ((d4 * d4 + d5 * d5) + (d6 * d6 + d7 * d7));
        }
        s2 += __shfl_xor(s2, 16); s2 += __shfl_xor(s2, 32);
        const float rstd = 1.0f / sqrtf(s2 * (1.0f / 1024.0f) + LN_EPS);
#pragma unroll
        for (int s = 0; s < 32; ++s) asm volatile("" : "+v"(pv[s]));
        asm volatile("s_waitcnt vmcnt(0)" ::: "memory");
        __syncthreads();
        f32x4 acc[3];
#pragma unroll
        for (int i = 0; i < 3; ++i) acc[i] = (f32x4){0.f, 0.f, 0.f, 0.f};
        bf16* hrow = HB + row * 1024 + q8;
#pragma unroll
        for (int s = 0; s < 32; ++s) {
            const f32x4 g0 = *(const f32x4*)(lgq + s * 32), g1 = *(const f32x4*)(lgq + s * 32 + 4);
            const f32x4 b0 = *(const f32x4*)(lbq + s * 32), b1 = *(const f32x4*)(lbq + s * 32 + 4);
            const f32x4 v0 = {bflo(pv[s].x), bfhi(pv[s].x), bflo(pv[s].y), bfhi(pv[s].y)}, v1 = {bflo(pv[s].z), bfhi(pv[s].z), bflo(pv[s].w), bfhi(pv[s].w)};
            const f32x4 y0 = (v0 - mean) * rstd * g0 + b0, y1 = (v1 - mean) * rstd * g1 + b1;
            u32x4 w; w.x = pk2(y0.x, y0.y); w.y = pk2(y0.z, y0.w); w.z = pk2(y1.x, y1.y); w.w = pk2(y1.z, y1.w);
            *(u32x4*)(hrow + s * 32) = w;
            const bf16x8 a = __builtin_bit_cast(bf16x8, w);
            acc[0] = mfma16_h(*(const bf16x8*)(wrp0 + s * 64), a, acc[0], 0, 0, 0);
            acc[1] = mfma16_h(*(const bf16x8*)(wrp0 + 16 * 2064 + s * 64), a, acc[1], 0, 0, 0);
            acc[2] = mfma16_h(*(const bf16x8*)(wrp2 + s * 64), a, acc[2], 0, 0, 0);
        }
#pragma unroll
        for (int nt = 0; nt < 3; ++nt) *(f32x4*)(zt + r * 52 + nt * 16 + 4 * q) = acc[nt];
        __syncthreads();
        const size_t tok = (size_t)t * 128 + wave * 16 + lane;
        int e0 = 0, e1 = 0, r0 = 0, r1 = 0;
        if (lane < 16) {
            const float* z = zt + lane * 52;
            float zg[4];
#pragma unroll
            for (int i = 0; i < 4; ++i) zg[i] = z[i] + brg[i];
            int gs = 0; float mx = zg[0];
#pragma unroll
            for (int i = 1; i < 4; ++i) if (zg[i] > mx) { mx = zg[i]; gs = i; }
            float den = 0.f;
#pragma unroll
            for (int i = 0; i < 4; ++i) den += __expf(zg[i] - mx);
            const float pgrp = 1.0f / den;
            float ze[8];
#pragma unroll
            for (int i = 0; i < 8; ++i) ze[i] = z[4 + gs * 8 + i] + bre[gs * 8 + i];
            int i0 = 0; float v0 = ze[0];
#pragma unroll
            for (int i = 1; i < 8; ++i) if (ze[i] > v0) { v0 = ze[i]; i0 = i; }
            int i1 = -1; float v1 = -3.0e38f;
#pragma unroll
            for (int i = 0; i < 8; ++i) if (i != i0 && ze[i] > v1) { v1 = ze[i]; i1 = i; }
            const float sx = __expf(v1 - v0);
            const float g0 = pgrp / (1.0f + sx), g1 = pgrp * sx / (1.0f + sx);
            e0 = gs * 8 + i0; e1 = gs * 8 + i1;
            GATE[tok * 2] = g0; GATE[tok * 2 + 1] = g1;
            r0 = atomicAdd(&hist[e0], 1); r1 = atomicAdd(&hist[e1], 1);
        }
        __syncthreads();
        if (tid < 32) base[tid] = atomicAdd(&CNT[tid], hist[tid]);
        __syncthreads();
        if (lane < 16) {
            TOK[(size_t)e0 * T + base[e0] + r0] = (int)(tok * 2);
            TOK[(size_t)e1 * T + base[e1] + r1] = (int)(tok * 2 + 1);
        }
        __syncthreads();
    }
}

#define LAS __attribute__((address_space(3)))
#define XB_TMO      128
#define XB_XCNT(j)  (256  + 64 * (j))
#define XB_XSUB(j)  (1280 + 64 * (j))
#define XB_XGEN(j)  (2304 + 64 * (j))
#define XB_TOP      3328
#define XB_TOPGEN   3392
#define XCD_BAR_WORDS 3456
#define XB_SPIN_CAP (1u << 20)
__device__ __forceinline__ unsigned xb_ld(unsigned* p)              { return __hip_atomic_load(p, __ATOMIC_RELAXED, __HIP_MEMORY_SCOPE_AGENT); }
__device__ __forceinline__ unsigned xb_add(unsigned* p, unsigned v) { return __hip_atomic_fetch_add(p, v, __ATOMIC_RELAXED, __HIP_MEMORY_SCOPE_AGENT); }
__device__ __forceinline__ unsigned xb_xcc_id() { return (unsigned)__builtin_amdgcn_s_getreg((3 << 11) | 20) & 0xFu; }
#define XB_SPIN(cond, bar) do { unsigned _sp = 0; while (cond) { __builtin_amdgcn_s_sleep(1); \
    if ((++_sp & 255u) == 0u) { if (xb_ld(&(bar)[XB_TMO])) break; if (_sp > XB_SPIN_CAP) { atomicAdd(&(bar)[XB_TMO], 1u); break; } } } } while (0)
struct XcdBarrier { unsigned* bar; unsigned x; volatile LAS unsigned* st; };
__device__ __forceinline__ XcdBarrier xcd_barrier_post(unsigned* bar, volatile LAS unsigned* st) {
    XcdBarrier b; b.bar = bar; b.x = xb_xcc_id(); b.st = st;
    if (threadIdx.x == 0) (void)xb_add(&bar[XB_XCNT(b.x)], 1u);
    return b;
}
__device__ __forceinline__ void xcd_barrier_complete(unsigned* bar, unsigned x, unsigned& nloc, unsigned& nx) {
    const unsigned G = gridDim.x * gridDim.y * gridDim.z;
    unsigned sum, cnt, mine, sp = 0u;
    for (;;) {
        sum = 0u; cnt = 0u; mine = 0u;
#pragma unroll
        for (unsigned j = 0; j < 16; ++j) { const unsigned c = xb_ld(&bar[XB_XCNT(j)]); sum += c; cnt += (c > 0u) ? 1u : 0u; mine = (j == x) ? c : mine; }
        if (sum == G) break;
        __builtin_amdgcn_s_sleep(1);
        if ((++sp & 255u) == 0u) { if (xb_ld(&bar[XB_TMO])) break; if (sp > XB_SPIN_CAP) { atomicAdd(&bar[XB_TMO], 1u); break; } }
    }
    nloc = mine > 0u ? mine : 1u; nx = cnt > 0u ? cnt : 1u;
}
__device__ __forceinline__ void xcd_barrier(const XcdBarrier& b) {
    asm volatile("s_waitcnt vmcnt(0)" ::: "memory");
    __syncthreads();
    if (threadIdx.x == 0) {
        unsigned* bar = b.bar;
        __builtin_amdgcn_s_waitcnt(0);
        unsigned nloc = b.st[0], nx = b.st[1];
        if (nloc == 0u) { xcd_barrier_complete(bar, b.x, nloc, nx); b.st[0] = nloc; b.st[1] = nx; }
        const unsigned old = xb_add(&bar[XB_XSUB(b.x)], 1u);
        const unsigned gen = old / nloc;
        if (old + 1u == (gen + 1u) * nloc) {
            __builtin_amdgcn_fence(__ATOMIC_RELEASE, "agent");
            asm volatile("s_waitcnt vmcnt(0)" ::: "memory");
            const unsigned og = xb_add(&bar[XB_TOP], 1u);
            const unsigned tg = og / nx;
            if (og + 1u == (tg + 1u) * nx) xb_add(&bar[XB_TOPGEN], 1u);
            else XB_SPIN(xb_ld(&bar[XB_TOPGEN]) == tg, bar);
            __builtin_amdgcn_fence(__ATOMIC_ACQUIRE, "agent");
            xb_add(&bar[XB_XGEN(b.x)], 1u);
            asm volatile("s_waitcnt vmcnt(0)" ::: "memory");
        } else {
            XB_SPIN(xb_ld(&bar[XB_XGEN(b.x)]) == gen, bar);
            __builtin_amdgcn_fence(__ATOMIC_ACQUIRE, "agent");
            asm volatile("s_waitcnt vmcnt(0)" ::: "memory");
        }
    }
    __syncthreads();
}

__device__ __forceinline__ void run_phase(const Params& P, unsigned char* lds, int ph) {
    unsigned char* ws = P.ws;
    const int G = gridDim.x, bid = blockIdx.x;
    switch (ph) {
    case 0: phase_prep(P, lds); break;
    case 1: {
        pg8::Gemm g{(const pg8::bf16_t*)(ws + WS_XB), (const pg8::bf16_t*)(ws + WS_WIN), T, DIN, D};
        pg8::StaticOrder S; S.init(T, DIN, G, bid);
        pg8::EpiProj E{(const float*)(ws + WS_TAB + TAB_BINP), (bf16*)(ws + WS_U), (bf16*)(ws + WS_V), (bf16*)(ws + WS_SGS), (bf16*)(ws + WS_SGC)};
        const int grp = (bid >> 3) & 1;
#pragma unroll 1
        for (int it = 0; it < 2; ++it) {
            asm volatile("" ::: "memory");
            if ((it ^ grp) == 0) expert_transposes(P, lds);
            else pg8::gemm_phase<pg8::EpiProj, pg8::StaticOrder, true, true>((PG8_LAS unsigned char*)lds, g, S, E);
            __syncthreads();
        }
    } break;
    case 2: {
        for (int it = bid; it < 256; it += G) s5_block_item(P, lds, it);
        conv_phase(P, lds);
    } break;
    case 3: {
        static_assert(WS_CV == WS_YG + (size_t)T * DSSM * 2 && WS_WCOUT == WS_WGLU + (size_t)2 * D * DSSM * 2 && DSSM == DCONV && T / 256 == 128, "virtual operands must be contiguous");
        pg8::Gemm g{(const pg8::bf16_t*)(ws + WS_YG), (const pg8::bf16_t*)(ws + WS_WGLU), 2 * T, 3 * D, DSSM};
        pg8::TripleOrder S; S.so.init(T, D, G, bid);
        pg8::EpiCG E{{P.in[18], (const bf16*)(ws + WS_SGC), (bf16*)(ws + WS_M1)},
                     {(const float*)(ws + WS_TAB + TAB_BGLUP), (const bf16*)(ws + WS_SGS), (const bf16*)(ws + WS_M1), (bf16*)(ws + WS_MERGED)}};
        pg8::gemm_phase<pg8::EpiCG, pg8::TripleOrder, true, true>((PG8_LAS unsigned char*)lds, g, S, E);
    } break;
    case 5: {
        pg8::Gemm g{(const pg8::bf16_t*)(ws + WS_MERGED), (const pg8::bf16_t*)(ws + WS_WOUT), T, D, D};
        pg8::StaticOrder S; S.init(T, D, G, bid);
        pg8::EpiOut E{P.in[20], (const bf16*)(ws + WS_XB), (bf16*)(ws + WS_PREB), ALPHA};
        pg8::gemm_phase<pg8::EpiOut, pg8::StaticOrder, true, true>((PG8_LAS unsigned char*)lds, g, S, E);
    } break;
    case 6: ln_route_phase(P, lds); break;
    case 9: {
        const int* CNT = (const int*)(ws + WS_CTL);
        PG8_LAS int* tab = (PG8_LAS int*)((PG8_LAS unsigned char*)lds + LDS_MISC + 64);
        if (threadIdx.x == 0) {
            int up = 0, bp = 0;
            for (int e = 0; e < NEXP; ++e) { const int cnt = CNT[e], nb = (cnt + 255) >> 8; tab[e] = up; tab[64 + e] = bp; tab[128 + e] = cnt; up += nb * 2; bp += nb; }
            tab[32] = up; tab[96] = bp;
        }
        __syncthreads();
        pg8::Gemm g{(const pg8::bf16_t*)(ws + WS_HB), (const pg8::bf16_t*)(ws + WS_WGU), 0, NEXP * 512, D};
        pg8::MoeOrder S{tab, G, bid, 1};
        pg8::MoeRows R{tab, (const int*)(ws + WS_TOK), T, (unsigned)(D * 2)};
        pg8::EpiGUP E{(bf16*)(ws + WS_HID)};
        pg8::gemm_phase_gather<pg8::EpiGUP, pg8::MoeOrder, pg8::MoeRows>((PG8_LAS unsigned char*)lds, g, S, E, R);
        __syncthreads();
    } break;
    case 10: {
        const int* CNT = (const int*)(ws + WS_CTL);
        PG8_LAS int* tab = (PG8_LAS int*)((PG8_LAS unsigned char*)lds + LDS_MISC + 64);
        if (threadIdx.x == 0) {
            int up = 0, bp = 0;
            for (int e = 0; e < NEXP; ++e) { const int cnt = CNT[e], nb = (cnt + 255) >> 8; tab[e] = up; tab[64 + e] = bp; tab[128 + e] = cnt; up += nb * 4; bp += nb; }
            tab[32] = up; tab[96] = bp;
        }
        __syncthreads();
        pg8::Gemm g{(const pg8::bf16_t*)(ws + WS_HID), (const pg8::bf16_t*)(ws + WS_WD), 0, NEXP * D, DFF};
        pg8::MoeOrder S{tab, G, bid, 2};
        pg8::EpiDownP E{tab, (const int*)(ws + WS_TOK), (const float*)(ws + WS_GATE), (bf16*)(ws + WS_YM), (bf16*)(ws + WS_Z), T};
        pg8::gemm_phase<pg8::EpiDownP, pg8::MoeOrder, true, true>((PG8_LAS unsigned char*)lds, g, S, E);
    } break;
    case 11: final_rows(P); break;
    default: break;
    }
}

#if ONE_LAUNCH
__global__ void __launch_bounds__(NTHREADS) fwd_kernel(Params P) {
    extern __shared__ __attribute__((aligned(16))) unsigned char lds[];
    if (P.ph_hi < 0) cg::this_grid().sync();
    volatile LAS unsigned* misc = (volatile LAS unsigned*)(LAS unsigned char*)(lds + LDS_MISC);
    if (threadIdx.x < 4) misc[threadIdx.x] = 0u;
    __syncthreads();
    XcdBarrier bar = xcd_barrier_post((unsigned*)(P.ws + WS_CTL) + CTL_BAR, misc);
#define GSYNC() xcd_barrier(bar)
    run_phase(P, lds, 0); GSYNC();
    run_phase(P, lds, 1); GSYNC();
    run_phase(P, lds, 2); GSYNC();
    run_phase(P, lds, 3); GSYNC();
    run_phase(P, lds, 5); GSYNC();
    run_phase(P, lds, 6); GSYNC();
    run_phase(P, lds, 9); GSYNC();
    run_phase(P, lds, 10); GSYNC();
    run_phase(P, lds, 11);
}
#else
template <int PH>
__global__ void __launch_bounds__(NTHREADS) phase_kernel(Params P) {
    extern __shared__ __attribute__((aligned(16))) unsigned char lds[];
    run_phase(P, lds, PH);
}
template <int PH> static void launch_phase(int grid, const Params& p, hipStream_t stream) {
    static bool init = false;
    if (!init) { (void)hipFuncSetAttribute((const void*)phase_kernel<PH>, hipFuncAttributeMaxDynamicSharedMemorySize, LDS_BYTES); init = true; }
    hipLaunchKernelGGL(phase_kernel<PH>, dim3(grid), dim3(NTHREADS), LDS_BYTES, stream, p);
}
#endif

extern "C" void kernel_launch(void* const* d_in, const int* in_sizes, int n_in, void* d_out, int out_size, void* d_ws, size_t ws_size, hipStream_t stream) {
    static int grid = 0;
    if (grid == 0) {
        if (n_in != 32 || in_sizes[0] != T * D || out_size != T * D || ws_size < WS_END) {
            fprintf(stderr, "kernel_launch: unexpected shapes (n_in %d, in0 %d, out %d, ws %zu)\n", n_in, n_in > 0 ? in_sizes[0] : -1, out_size, ws_size);
            grid = -1; return;
        }
        int dev = 0, cus = 0, per_cu = 1;
        (void)hipGetDevice(&dev);
        (void)hipDeviceGetAttribute(&cus, hipDeviceAttributeMultiprocessorCount, dev);
#if ONE_LAUNCH
        (void)hipFuncSetAttribute((const void*)fwd_kernel, hipFuncAttributeMaxDynamicSharedMemorySize, LDS_BYTES);
        (void)hipOccupancyMaxActiveBlocksPerMultiprocessor(&per_cu, (const void*)fwd_kernel, NTHREADS, LDS_BYTES);
        if (per_cu < 1) per_cu = 1;
#endif
        grid = cus * per_cu;
        (void)hipGetLastError();
    }
    if (grid < 0) return;
    if (hipMemsetAsync((char*)d_ws + WS_CTL, 0, CTL_ZERO_BYTES, stream) != hipSuccess) { fprintf(stderr, "kernel_launch: memset failed\n"); return; }
    Params p{};
    for (int i = 0; i < 32; ++i) p.in[i] = (const float*)d_in[i];
    p.out = (float*)d_out; p.ws = (unsigned char*)d_ws;
#if ONE_LAUNCH
    p.ph_lo = 0; p.ph_hi = NPHASE;
    void* args[] = {&p};
    hipError_t e = hipLaunchCooperativeKernel((const void*)fwd_kernel, dim3(grid), dim3(NTHREADS), args, LDS_BYTES, stream);
    if (e != hipSuccess) fprintf(stderr, "cooperative launch failed: %s (grid %d)\n", hipGetErrorString(e), grid);
#else
    p.ph_lo = 0; p.ph_hi = NPHASE;
    launch_phase<0>(grid, p, stream); launch_phase<1>(grid, p, stream); launch_phase<2>(grid, p, stream); launch_phase<3>(grid, p, stream);
    launch_phase<4>(grid, p, stream); launch_phase<5>(grid, p, stream); launch_phase<6>(grid, p, stream); launch_phase<7>(grid, p, stream);
    launch_phase<8>(grid, p, stream); launch_phase<9>(grid, p, stream); launch_phase<10>(grid, p, stream); launch_phase<11>(grid, p, stream);
#endif
}
```
